# Optimizing an MI355X kernel written in HIP

```python
import jax, jax.numpy as jnp
from jax import lax
import numpy as np

D_MODEL = 1024
BATCH = 4
SEQ = 8192
DEPTH = 2

CHUNK = 64
N_MEM = 256
A_GROUPS = 4
A_GROUP_DIM = 128
A_WIDTH = A_GROUPS * A_GROUP_DIM
A_BLOCK = 128
FOX_HEADS = 8
FOX_HEAD_DIM = 64
FOX_WIDTH = FOX_HEADS * FOX_HEAD_DIM
Q_BLOCK = 128
POOL_WINDOWS = (2, 4, 8, 16)
POOL_GROUP_DIM = 128
POOL_WIDTH = len(POOL_WINDOWS) * POOL_GROUP_DIM
CONV_WIDTH = 512
CONV_K = 3
MIX_WIDTH = 1024
EVEN_IN = 2 * A_WIDTH + 3 * FOX_WIDTH + FOX_HEADS
ODD_IN = POOL_WIDTH + 3 * CONV_WIDTH
XA_HEADS = 4
XA_HEAD_DIM = 128
XA_WIDTH = XA_HEADS * XA_HEAD_DIM
D_FF = -(-(8 * D_MODEL) // (3 * 256)) * 256
EPS = 1e-6
N_EVEN = (DEPTH + 1) // 2
N_ODD = DEPTH // 2

kernel_name = "hybrid_streaming_gmlp_fox_pool_conv"


def rms_norm(x, g):
    xf = x.astype(jnp.float32)
    y = xf * lax.rsqrt(jnp.mean(xf * xf, axis=-1, keepdims=True) + EPS)
    return (y * g.astype(jnp.float32)).astype(x.dtype)


def chunk_gmlp(u, v, g_v, w_s, b_s):
    B, S, _ = v.shape
    v = rms_norm(v.reshape(B, S, A_GROUPS, A_GROUP_DIM), g_v.reshape(A_GROUPS, A_GROUP_DIM))
    vb = v.reshape(B, S // A_BLOCK, A_BLOCK, A_GROUPS, A_GROUP_DIM)
    cpos = np.arange(A_BLOCK) // CHUNK
    mask = jnp.asarray(cpos[:, None] >= cpos[None, :]).astype(w_s.dtype)
    w = w_s * mask[None]
    s = jnp.einsum('gts,bnsgc->bntgc', w, vb) + b_s.T[None, None, :, :, None]
    return u * s.reshape(B, S, A_WIDTH)


def forgetting_attention(q, k, v, log_f):
    B, S, H, hd = q.shape
    nb = S // Q_BLOCK
    scale = 1.0 / np.sqrt(hd)
    c = jnp.cumsum(log_f.astype(jnp.float32), axis=1).transpose(0, 2, 1)
    qb = q.reshape(B, nb, Q_BLOCK, H, hd).transpose(1, 0, 2, 3, 4)
    cb = c.reshape(B, H, nb, Q_BLOCK).transpose(2, 0, 1, 3)
    kpos = jnp.arange(S)

    def block(args):
        qi, ci, i = args
        logits = jnp.einsum('bqhd,bkhd->bhqk', qi, k).astype(jnp.float32) * scale
        logits = logits + ci[..., :, None] - c[:, :, None, :]
        qpos = i * Q_BLOCK + jnp.arange(Q_BLOCK)
        allowed = kpos[None, :] <= qpos[:, None]
        logits = jnp.where(allowed[None, None], logits, -jnp.inf)
        p = jax.nn.softmax(logits, axis=-1)
        return jnp.einsum('bhqk,bkhd->bqhd', p.astype(v.dtype), v)

    out = lax.map(block, (qb, cb, jnp.arange(nb)))
    return out.transpose(1, 0, 2, 3, 4).reshape(B, S, H * hd)


def multiscale_pool(z, w_pool, s_pool):
    B, S, _ = z.shape
    zf = z.astype(jnp.float32)
    cs = jnp.cumsum(zf, axis=1)
    pos = jnp.arange(S)
    outs = []
    for g, w in enumerate(POOL_WINDOWS):
        sl = slice(g * POOL_GROUP_DIM, (g + 1) * POOL_GROUP_DIM)
        csg = cs[..., sl]
        lag = jnp.pad(csg, ((0, 0), (w, 0), (0, 0)))[:, :S]
        cnt = jnp.minimum(pos + 1, w).astype(jnp.float32)[None, :, None]
        outs.append((csg - lag) / cnt - zf[..., sl])
    p = jnp.concatenate(outs, axis=-1).astype(z.dtype)
    p = p.reshape(B, S, len(POOL_WINDOWS), POOL_GROUP_DIM)
    y = jnp.einsum('bsgc,gcd->bsgd', p, w_pool).reshape(B, S, POOL_WIDTH)
    return y * s_pool


def short_gated_conv(h, gate_b, gate_c, conv_w):
    S = h.shape[1]
    xg = gate_c * h
    xp = jnp.pad(xg, ((0, 0), (CONV_K - 1, 0), (0, 0)))
    conv = sum(conv_w[j] * xp[:, j:j + S] for j in range(CONV_K))
    return gate_b * conv


def even_mixer(h, w_in, b_f, g_v, w_s, b_s, g_qn, g_kn, w_out):
    B, S, _ = h.shape
    z = h @ w_in
    uv = jax.nn.gelu(z[..., :2 * A_WIDTH])
    u, v = uv[..., :A_WIDTH], uv[..., A_WIDTH:]
    o = 2 * A_WIDTH
    q = z[..., o:o + FOX_WIDTH].reshape(B, S, FOX_HEADS, FOX_HEAD_DIM)
    k = z[..., o + FOX_WIDTH:o + 2 * FOX_WIDTH].reshape(B, S, FOX_HEADS, FOX_HEAD_DIM)
    vv = z[..., o + 2 * FOX_WIDTH:o + 3 * FOX_WIDTH].reshape(B, S, FOX_HEADS, FOX_HEAD_DIM)
    f_logit = z[..., o + 3 * FOX_WIDTH:].astype(jnp.float32) + b_f.astype(jnp.float32)
    log_f = jax.nn.log_sigmoid(f_logit)
    q = rms_norm(q, g_qn)
    k = rms_norm(k, g_kn)
    y_a = chunk_gmlp(u, v, g_v, w_s, b_s)
    y_b = forgetting_attention(q, k, vv, log_f).astype(h.dtype)
    return jnp.concatenate([y_a, y_b], axis=-1) @ w_out


def odd_mixer(h, w_in, w_pool, s_pool, conv_w, w_out):
    z = h @ w_in
    zc = z[..., :POOL_WIDTH]
    o = POOL_WIDTH
    hd = z[..., o:o + CONV_WIDTH]
    gb = z[..., o + CONV_WIDTH:o + 2 * CONV_WIDTH]
    gc = z[..., o + 2 * CONV_WIDTH:]
    y_c = multiscale_pool(zc, w_pool, s_pool)
    y_d = short_gated_conv(hd, gb, gc, conv_w)
    return jnp.concatenate([y_c, y_d], axis=-1) @ w_out


def memory_cross_attention(h, m, w_q, w_kv, w_o, g_qn, g_kn):
    B, S, _ = h.shape
    M = m.shape[1]
    q = rms_norm((h @ w_q).reshape(B, S, XA_HEADS, XA_HEAD_DIM), g_qn)
    kv = m @ w_kv
    k = rms_norm(kv[..., :XA_WIDTH].reshape(B, M, XA_HEADS, XA_HEAD_DIM), g_kn)
    v = kv[..., XA_WIDTH:].reshape(B, M, XA_HEADS, XA_HEAD_DIM)
    logits = jnp.einsum('bshd,bmhd->bhsm', q, k).astype(jnp.float32) / np.sqrt(XA_HEAD_DIM)
    p = jax.nn.softmax(logits, axis=-1).astype(v.dtype)
    o = jnp.einsum('bhsm,bmhd->bshd', p, v).reshape(B, S, XA_WIDTH)
    return o @ w_o


def swiglu(h, w_gate, w_up, w_down):
    return (jax.nn.silu(h @ w_gate) * (h @ w_up)) @ w_down


def setup_inputs(seed: int = 0) -> dict:
    key = jax.random.key(seed)
    ks = jax.random.split(key, 32)
    f32 = jnp.float32

    def nrm(k, shape, scale):
        return jax.random.normal(k, shape, f32) * scale

    def gain(k, shape):
        return 1.0 + 0.05 * jax.random.normal(k, shape, f32)

    L, NE, NO, D = DEPTH, N_EVEN, N_ODD, D_MODEL
    return {
        "x": nrm(ks[0], (BATCH, SEQ, D), 1.0),
        "mem": nrm(ks[1], (BATCH, N_MEM, D), 1.0),
        "g_mix": gain(ks[2], (L, D)),
        "g_xa": gain(ks[3], (L, D)),
        "g_mem": gain(ks[4], (L, D)),
        "xa_wq": nrm(ks[5], (L, D, XA_WIDTH), D ** -0.5),
        "xa_wkv": nrm(ks[6], (L, D, 2 * XA_WIDTH), D ** -0.5),
        "xa_wo": nrm(ks[7], (L, XA_WIDTH, D), XA_WIDTH ** -0.5),
        "xa_gq": gain(ks[8], (L, XA_HEAD_DIM)),
        "xa_gk": gain(ks[9], (L, XA_HEAD_DIM)),
        "g_ffn": gain(ks[10], (L, D)),
        "w_gate": nrm(ks[11], (L, D, D_FF), D ** -0.5),
        "w_up": nrm(ks[12], (L, D, D_FF), D ** -0.5),
        "w_down": nrm(ks[13], (L, D_FF, D), D_FF ** -0.5),
        "e_w_in": nrm(ks[14], (NE, D, EVEN_IN), D ** -0.5),
        "e_b_f": jnp.linspace(1.0, 6.0, FOX_HEADS, dtype=f32)[None] + 0.1 * jax.random.normal(ks[15], (NE, FOX_HEADS), f32),
        "e_g_v": gain(ks[16], (NE, A_WIDTH)),
        "e_w_s": nrm(ks[17], (NE, A_GROUPS, A_BLOCK, A_BLOCK), A_BLOCK ** -0.5),
        "e_b_s": gain(ks[18], (NE, A_GROUPS, A_BLOCK)),
        "e_g_qn": gain(ks[19], (NE, FOX_HEAD_DIM)),
        "e_g_kn": gain(ks[20], (NE, FOX_HEAD_DIM)),
        "e_w_out": nrm(ks[21], (NE, MIX_WIDTH, D), MIX_WIDTH ** -0.5),
        "o_w_in": nrm(ks[22], (NO, D, ODD_IN), D ** -0.5),
        "o_w_pool": nrm(ks[23], (NO, len(POOL_WINDOWS), POOL_GROUP_DIM, POOL_GROUP_DIM), POOL_GROUP_DIM ** -0.5),
        "o_s_pool": gain(ks[24], (NO, POOL_WIDTH)),
        "o_conv_w": nrm(ks[25], (NO, CONV_K, CONV_WIDTH), CONV_K ** -0.5),
        "o_w_out": nrm(ks[26], (NO, MIX_WIDTH, D), MIX_WIDTH ** -0.5),
    }


def reference(x, mem, g_mix, g_xa, g_mem, xa_wq, xa_wkv, xa_wo, xa_gq, xa_gk,
              g_ffn, w_gate, w_up, w_down,
              e_w_in, e_b_f, e_g_v, e_w_s, e_b_s, e_g_qn, e_g_kn, e_w_out,
              o_w_in, o_w_pool, o_s_pool, o_conv_w, o_w_out):
    for layer in range(DEPTH):
        i = layer // 2
        h = rms_norm(x, g_mix[layer])
        if layer % 2 == 0:
            y = even_mixer(h, e_w_in[i], e_b_f[i], e_g_v[i], e_w_s[i], e_b_s[i],
                           e_g_qn[i], e_g_kn[i], e_w_out[i])
        else:
            y = odd_mixer(h, o_w_in[i], o_w_pool[i], o_s_pool[i], o_conv_w[i], o_w_out[i])
        x = x + y
        m = rms_norm(mem, g_mem[layer])
        x = x + memory_cross_attention(rms_norm(x, g_xa[layer]), m, xa_wq[layer], xa_wkv[layer],
                                       xa_wo[layer], xa_gq[layer], xa_gk[layer])
        x = x + swiglu(rms_norm(x, g_ffn[layer]), w_gate[layer], w_up[layer], w_down[layer])
    return x
```

```cpp
#define MK_N_LAUNCHES 15
#include <hip/hip_runtime.h>
#include <cstdio>
#include <cstdint>
namespace pg8 {
#define PG8_LAS __attribute__((address_space(3)))
typedef unsigned short bf16_t;
typedef short bf16x8 __attribute__((ext_vector_type(8)));
typedef float f32x4 __attribute__((ext_vector_type(4)));
typedef unsigned u32x4 __attribute__((ext_vector_type(4)));
constexpr int BM = 256, BK = 64, HALF = 128, HTB = HALF * BK * 2  , STAGE_BYTES = 8 * HTB, NXCD = 8, WGM = 8;

__host__ __device__ __forceinline__ int lds_byte(int r, int c) { const int st = (r >> 4) * 2 + (c >> 5), rr = r & 15, cc = c & 31, ob = rr * 64 + cc * 2; return st * 1024 + (ob ^ (((ob >> 9) & 1) << 5)); }
__host__ __device__ __forceinline__ void stage_rc(int b, int& R, int& C) { const int st = b / 1024, sb = b % 1024, swz = sb ^ (((sb >> 9) & 1) << 5); R = (st >> 1) * 16 + swz / 64; C = (st & 1) * 32 + (swz % 64) / 2; }
__host__ __device__ __forceinline__ int perm32(int rho) { const int n = rho >> 4, i = rho & 15; return 8 * (i >> 2) + 4 * n + (i & 3); }

struct Unit { int pm, pn; };
struct Gemm { const bf16_t* A; const bf16_t* Bt; int M, N, K; };

struct StaticOrder {
    int nM, nN, nwg, G, c;
    __host__ __device__ void init(int M, int N, int G_, int c_) { nM = M / BM; nN = N / BM; nwg = nM * nN; G = G_; c = c_; }
    __host__ __device__ bool next(int i, Unit& u) const {
        const long L = (long)i * G + c; if (L >= nwg) return false;
        int wgid = (int)L; { const int q = nwg / NXCD, r = nwg % NXCD, xcd = wgid % NXCD, off = wgid / NXCD; wgid = (xcd < r ? xcd * (q + 1) : r * (q + 1) + (xcd - r) * q) + off; }
        const int nig = WGM * nN, gid = wgid / nig, fm = gid * WGM, gsz = (nM - fm) < WGM ? (nM - fm) : WGM;
        u.pm = fm + ((wgid % nig) % gsz); u.pn = (wgid % nig) / gsz; return true;
    }
    __device__ __forceinline__ void a_ready(const Unit&) const {}
    __device__ __forceinline__ void done(const Unit&) const {}
};

__device__ __forceinline__ unsigned cvt_pk_bf16(float lo, float hi) { unsigned r; asm volatile("v_cvt_pk_bf16_f32 %0, %1, %2" : "=v"(r) : "v"(lo), "v"(hi)); return r; }
__device__ __forceinline__ u32x4 pack8(const f32x4 a, const f32x4 b) { u32x4 w; w.x = cvt_pk_bf16(a[0], a[1]); w.y = cvt_pk_bf16(a[2], a[3]); w.z = cvt_pk_bf16(b[0], b[1]); w.w = cvt_pk_bf16(b[2], b[3]); return w; }
constexpr float RMS_EPS = 1e-6f;
__device__ __forceinline__ float row_rstd(const float* ssq, int row) {
    const f32x4* p = (const f32x4*)(ssq + (size_t)row * 16);
    const f32x4 a = p[0], b = p[1], c = p[2], d = p[3];
    const float s = (((a[0] + a[1]) + (a[2] + a[3])) + ((b[0] + b[1]) + (b[2] + b[3]))) + (((c[0] + c[1]) + (c[2] + c[3])) + ((d[0] + d[1]) + (d[2] + d[3])));
    return __builtin_amdgcn_rsqf(s * (1.0f / 1024.0f) + RMS_EPS);
}
__device__ __forceinline__ float sigmoid_fast(float t) { return __builtin_amdgcn_rcpf(1.0f + __builtin_amdgcn_exp2f(-1.4426950408889634f * t)); }
__device__ __forceinline__ float gelu_tanh(float x) { const float t = 1.5957691216057308f * (x + 0.044715f * x * x * x); return x * sigmoid_fast(t); }
__device__ __forceinline__ float silu_f(float x) { return x * sigmoid_fast(x); }

struct EpiPlain {
    static constexpr bool PERM = true, AFTER_DRAIN = false;
    bf16_t* O; int ldc; const float* ssq;
    __device__ __forceinline__ void operator()(const f32x4 (&acc)[2][2][4][2], const Unit& u, int wr, int wc, int fr, int fq) const {
        const int row0 = u.pm * BM + wr * 64 + fr, col0 = u.pn * BM + wc * 32 + 8 * fq;
#pragma unroll
        for (int ai = 0; ai < 2; ++ai)
#pragma unroll
            for (int m = 0; m < 4; ++m) { const int row = row0 + ai * HALF + m * 16; const float rs = ssq ? row_rstd(ssq, row) : 1.0f; bf16_t* rowp = O + (size_t)row * ldc + col0;
#pragma unroll
                for (int bj = 0; bj < 2; ++bj) *(u32x4*)(rowp + bj * HALF) = pack8(acc[ai][bj][m][0] * rs, acc[ai][bj][m][1] * rs); }
    }
};
struct EpiIn0 {
    static constexpr bool PERM = true, AFTER_DRAIN = false;
    bf16_t* O; int ldc; const float* ssq; const float* gq; const float* gk; float qscale;
    __device__ __forceinline__ void operator()(const f32x4 (&acc)[2][2][4][2], const Unit& u, int wr, int wc, int fr, int fq) const {
        const int row0 = u.pm * BM + wr * 64 + fr; const int pn = u.pn;
        const bool headed = (pn >= 4 && pn < 8);
        f32x4 gn[2][2];
#pragma unroll
        for (int bj = 0; bj < 2; ++bj)
#pragma unroll
            for (int n = 0; n < 2; ++n) { gn[bj][n] = (f32x4){1.f, 1.f, 1.f, 1.f};
                if (pn == 4 || pn == 5) { const int d = 32 * bj + 8 * fq + 4 * n; const f32x4 a = *(const f32x4*)(gq + d), b = *(const f32x4*)(gk + d); gn[bj][n] = a * b * qscale; } }
#pragma unroll
        for (int ai = 0; ai < 2; ++ai)
#pragma unroll
            for (int m = 0; m < 4; ++m) { const int row = row0 + ai * HALF + m * 16; const float rs = row_rstd(ssq, row);
                f32x4 v[2][2];
#pragma unroll
                for (int bj = 0; bj < 2; ++bj)
#pragma unroll
                    for (int n = 0; n < 2; ++n) v[bj][n] = acc[ai][bj][m][n] * rs;
                if (pn < 4) {
#pragma unroll
                    for (int bj = 0; bj < 2; ++bj)
#pragma unroll
                        for (int n = 0; n < 2; ++n)
#pragma unroll
                            for (int e = 0; e < 4; ++e) v[bj][n][e] = gelu_tanh(v[bj][n][e]);
                } else if (headed) {
                    float ss = 0.f;
#pragma unroll
                    for (int bj = 0; bj < 2; ++bj)
#pragma unroll
                        for (int n = 0; n < 2; ++n) { const f32x4 x = v[bj][n]; ss += (x[0] * x[0] + x[1] * x[1]) + (x[2] * x[2] + x[3] * x[3]); }
                    ss += __shfl_xor(ss, 16); ss += __shfl_xor(ss, 32);
                    const float r = __builtin_amdgcn_rsqf(ss * (1.0f / 64.0f) + RMS_EPS);
#pragma unroll
                    for (int bj = 0; bj < 2; ++bj)
#pragma unroll
                        for (int n = 0; n < 2; ++n) v[bj][n] = v[bj][n] * r * gn[bj][n];
                }
                bf16_t* rowp = O + (size_t)row * ldc + pn * BM + 8 * fq;
#pragma unroll
                for (int bj = 0; bj < 2; ++bj) { const int c = headed ? (64 * wc + 32 * bj) : (128 * bj + 32 * wc); *(u32x4*)(rowp + c) = pack8(v[bj][0], v[bj][1]); } }
    }
};
struct EpiSwiglu {
    static constexpr bool PERM = true, AFTER_DRAIN = false;
    bf16_t* O; int ldc; const float* ssq;
    __device__ __forceinline__ void operator()(const f32x4 (&acc)[2][2][4][2], const Unit& u, int wr, int wc, int fr, int fq) const {
        const int row0 = u.pm * BM + wr * 64 + fr, col0 = u.pn * HALF + wc * 32 + 8 * fq;
#pragma unroll
        for (int ai = 0; ai < 2; ++ai)
#pragma unroll
            for (int m = 0; m < 4; ++m) { const int row = row0 + ai * HALF + m * 16; const float rs = row_rstd(ssq, row);
                f32x4 o[2];
#pragma unroll
                for (int n = 0; n < 2; ++n) { const f32x4 g = acc[ai][0][m][n] * rs, up = acc[ai][1][m][n] * rs;
#pragma unroll
                    for (int e = 0; e < 4; ++e) o[n][e] = silu_f(g[e]) * up[e]; }
                *(u32x4*)(O + (size_t)row * ldc + col0) = pack8(o[0], o[1]); }
    }
};
struct EpiRes {
    static constexpr bool PERM = true, AFTER_DRAIN = false;
    const float* base; float* out; bf16_t* xb; float* ssq; int ldc;
    __device__ __forceinline__ void operator()(const f32x4 (&acc)[2][2][4][2], const Unit& u, int wr, int wc, int fr, int fq) const {
        const int row0 = u.pm * BM + wr * 64 + fr, col0 = u.pn * BM + wc * 32 + 8 * fq;
#pragma unroll
        for (int ai = 0; ai < 2; ++ai)
#pragma unroll
            for (int m = 0; m < 4; ++m) { const int row = row0 + ai * HALF + m * 16; const size_t off = (size_t)row * ldc + col0;
                f32x4 v[2][2]; float ss = 0.f;
#pragma unroll
                for (int bj = 0; bj < 2; ++bj)
#pragma unroll
                    for (int n = 0; n < 2; ++n) { const f32x4 b = *(const f32x4*)(base + off + bj * HALF + 4 * n); const f32x4 x = b + acc[ai][bj][m][n]; v[bj][n] = x;
                        ss += (x[0] * x[0] + x[1] * x[1]) + (x[2] * x[2] + x[3] * x[3]); }
#pragma unroll
                for (int bj = 0; bj < 2; ++bj) { *(f32x4*)(out + off + bj * HALF) = v[bj][0]; *(f32x4*)(out + off + bj * HALF + 4) = v[bj][1]; }
                if (xb) {
#pragma unroll
                    for (int bj = 0; bj < 2; ++bj) *(u32x4*)(xb + off + bj * HALF) = pack8(v[bj][0], v[bj][1]);
                    ss += __shfl_xor(ss, 16); ss += __shfl_xor(ss, 32);
                    if (fq == 0) ssq[(size_t)row * 16 + 4 * u.pn + wc] = ss; }
                if (m & 1) asm volatile("" ::: "memory"); }
    }
};

template <class Epi, class Sched, bool ALIGN_EPI = false, bool SP2 = false>
__device__ __forceinline__ void gemm_phase(PG8_LAS unsigned char* lds, const Gemm g, const Sched& S, const Epi& E, const int tid_in) {
    int tid_ = tid_in; asm volatile("" : "+v"(tid_));
    const int tid = tid_, wid = __builtin_amdgcn_readfirstlane(tid >> 6), lane = tid & 63, wr = wid >> 2, wc = wid & 3, fr = lane & 15, fq = lane >> 4;
    const int K = g.K, nt = K / BK;
    unsigned voffA[2], voffB[2];
#pragma unroll
    for (int i = 0; i < 2; ++i) { int R, C; stage_rc(tid * 16 + i * 8192, R, C); const int Rb = Epi::PERM ? ((R & ~31) + perm32(R & 31)) : R;
        voffA[i] = (unsigned)(R * K + C) * 2u; voffB[i] = (unsigned)(Rb * K + C) * 2u; }
    const size_t kstep = (size_t)(BK * 2);
    const size_t hstep = (size_t)HALF * K * 2;
    const size_t tstep = 2 * hstep;
    const unsigned ldsw = (unsigned)wid * 1024u;
    const int aoff = lds_byte(wr * 64 + fr, fq * 8), boff = lds_byte(wc * 32 + fr, fq * 8);
#define PG8_SA(b, h) (((b) * 2 + (h)) * HTB)
#define PG8_SB(b, h) ((4 + (b) * 2 + (h)) * HTB)
#define PG8_STAGE(bufoff, gbase, voff) do { _Pragma("unroll") for (int _i = 0; _i < 2; ++_i) \
        __builtin_amdgcn_global_load_lds((const unsigned*)((const char*)(gbase) + (voff)[_i]), (PG8_LAS unsigned*)(lds + (bufoff) + ldsw + _i * 8192), 16, 0, 0); } while (0)
#define PG8_LDA(dst, b, h) do { _Pragma("unroll") for (int m = 0; m < 4; ++m) _Pragma("unroll") for (int k = 0; k < 2; ++k) dst[m][k] = *(const PG8_LAS bf16x8*)(lds + PG8_SA(b, h) + aoff + m * 2048 + k * 1024); } while (0)
#define PG8_LDB(dst, b, h) do { _Pragma("unroll") for (int n = 0; n < 2; ++n) _Pragma("unroll") for (int k = 0; k < 2; ++k) dst[n][k] = *(const PG8_LAS bf16x8*)(lds + PG8_SB(b, h) + boff + n * 2048 + k * 1024); } while (0)
#define PG8_MMA(ai, bj, At, Bt) do { __builtin_amdgcn_s_setprio(1); _Pragma("unroll") for (int m = 0; m < 4; ++m) _Pragma("unroll") for (int n = 0; n < 2; ++n) _Pragma("unroll") for (int k = 0; k < 2; ++k) \
        acc[ai][bj][m][n] = __builtin_amdgcn_mfma_f32_16x16x32_bf16(Bt[n][k], At[m][k], acc[ai][bj][m][n], 0, 0, 0); __builtin_amdgcn_s_setprio(0); } while (0)
#define PG8_WAIT_V(n) asm volatile("s_waitcnt vmcnt(" #n ")" ::: "memory")
#define PG8_WAIT_L(n) asm volatile("s_waitcnt lgkmcnt(" #n ")" ::: "memory")
#define PG8_BAR __builtin_amdgcn_s_barrier()
#define PG8_SCHED __builtin_amdgcn_sched_barrier(0)
    Unit cur, nxt; int ui = 0;
    if (!S.next(0, cur)) return;
    f32x4 acc[2][2][4][2];
#pragma unroll
    for (int a = 0; a < 2; ++a)
#pragma unroll
        for (int b = 0; b < 2; ++b)
#pragma unroll
            for (int m = 0; m < 4; ++m)
#pragma unroll
                for (int n = 0; n < 2; ++n) acc[a][b][m][n] = (f32x4){0.f, 0.f, 0.f, 0.f};
    bf16x8 At[4][2], B0[2][2], B1[2][2];
    const char* cA = (const char*)g.A + (size_t)cur.pm * tstep; const char* cB = (const char*)g.Bt + (size_t)cur.pn * tstep;
    S.a_ready(cur);
    if constexpr (SP2) {
        PG8_STAGE(PG8_SB(0, 0), cB, voffB); PG8_STAGE(PG8_SB(0, 1), cB + hstep, voffB); PG8_STAGE(PG8_SA(0, 0), cA, voffA); PG8_STAGE(PG8_SA(0, 1), cA + hstep, voffA);
        if (wr == 1) PG8_BAR;
        PG8_WAIT_V(2); PG8_BAR;
        PG8_STAGE(PG8_SB(1, 0), cB + kstep, voffB); PG8_STAGE(PG8_SA(1, 0), cA + kstep, voffA); PG8_STAGE(PG8_SB(1, 1), cB + hstep + kstep, voffB);
        PG8_WAIT_V(6); PG8_BAR;
    } else {
        PG8_STAGE(PG8_SB(0, 0), cB, voffB); PG8_STAGE(PG8_SA(0, 0), cA, voffA); PG8_STAGE(PG8_SB(0, 1), cB + hstep, voffB); PG8_STAGE(PG8_SA(0, 1), cA + hstep, voffA);
        if (wr == 1) PG8_BAR;
        PG8_WAIT_V(4); PG8_BAR;
        PG8_STAGE(PG8_SB(1, 0), cB + kstep, voffB); PG8_STAGE(PG8_SA(1, 0), cA + kstep, voffA); PG8_STAGE(PG8_SB(1, 1), cB + hstep + kstep, voffB);
        PG8_WAIT_V(6); PG8_BAR;
    }
    for (;;) {
        const bool has_next = S.next(ui + 1, nxt);
        const char* nA = has_next ? (const char*)g.A + (size_t)nxt.pm * tstep : cA; const char* nB = has_next ? (const char*)g.Bt + (size_t)nxt.pn * tstep : cB;
        for (int t = 0; t < nt; t += 2) {
            const bool last = (t == nt - 2);
            const char* a1 = cA + (size_t)(t + 1) * kstep;
            const char* a2 = last ? nA : cA + (size_t)(t + 2) * kstep; const char* b2 = last ? nB : cB + (size_t)(t + 2) * kstep;
            const char* a3 = a2 + kstep; const char* b3 = b2 + kstep;
            if (last && has_next) S.a_ready(nxt);
            if constexpr (SP2) {
            PG8_LDB(B0, 0, 0); PG8_LDB(B1, 0, 1); PG8_SCHED; PG8_LDA(At, 0, 0); PG8_STAGE(PG8_SA(1, 1), a1 + hstep, voffA);
            PG8_WAIT_V(8); PG8_WAIT_L(0); PG8_BAR; PG8_MMA(0, 0, At, B0); PG8_MMA(0, 1, At, B1); PG8_BAR; PG8_SCHED;
            PG8_LDA(At, 0, 1); PG8_STAGE(PG8_SB(0, 0), b2, voffB); PG8_STAGE(PG8_SB(0, 1), b2 + hstep, voffB); PG8_STAGE(PG8_SA(0, 0), a2, voffA);
            PG8_WAIT_V(8); PG8_WAIT_L(0); PG8_BAR; PG8_MMA(1, 0, At, B0); PG8_MMA(1, 1, At, B1); PG8_BAR; PG8_SCHED;
            PG8_LDB(B0, 1, 0); PG8_LDB(B1, 1, 1); PG8_SCHED; PG8_LDA(At, 1, 0); PG8_STAGE(PG8_SA(0, 1), a2 + hstep, voffA);
            PG8_WAIT_V(8); PG8_WAIT_L(0); PG8_BAR; PG8_MMA(0, 0, At, B0); PG8_MMA(0, 1, At, B1); PG8_BAR; PG8_SCHED;
            PG8_LDA(At, 1, 1); PG8_STAGE(PG8_SB(1, 0), b3, voffB); PG8_STAGE(PG8_SB(1, 1), b3 + hstep, voffB); PG8_STAGE(PG8_SA(1, 0), a3, voffA);
            PG8_WAIT_V(8); PG8_WAIT_L(0); PG8_BAR; PG8_MMA(1, 0, At, B0); PG8_MMA(1, 1, At, B1); PG8_BAR; PG8_SCHED;
            } else {
            PG8_LDB(B0, 0, 0); PG8_SCHED; PG8_LDA(At, 0, 0); PG8_STAGE(PG8_SA(1, 1), a1 + hstep, voffA);
            PG8_WAIT_L(8); PG8_BAR; PG8_WAIT_L(0); PG8_MMA(0, 0, At, B0); PG8_BAR; PG8_SCHED;
            PG8_LDB(B1, 0, 1); PG8_STAGE(PG8_SB(0, 0), b2, voffB);
            PG8_BAR; PG8_WAIT_L(0); PG8_MMA(0, 1, At, B1); PG8_BAR;
            PG8_LDA(At, 0, 1); PG8_STAGE(PG8_SA(0, 0), a2, voffA);
            PG8_BAR; PG8_WAIT_L(0); PG8_MMA(1, 0, At, B0); PG8_BAR; PG8_SCHED;
            PG8_STAGE(PG8_SB(0, 1), b2 + hstep, voffB);
            PG8_WAIT_V(6); PG8_BAR; PG8_MMA(1, 1, At, B1); PG8_BAR;
            PG8_LDB(B0, 1, 0); PG8_SCHED; PG8_LDA(At, 1, 0); PG8_STAGE(PG8_SA(0, 1), a2 + hstep, voffA);
            PG8_WAIT_L(8); PG8_BAR; PG8_WAIT_L(0); PG8_MMA(0, 0, At, B0); PG8_BAR; PG8_SCHED;
            PG8_LDB(B1, 1, 1); PG8_STAGE(PG8_SB(1, 0), b3, voffB);
            PG8_BAR; PG8_WAIT_L(0); PG8_MMA(0, 1, At, B1); PG8_BAR;
            PG8_LDA(At, 1, 1); PG8_STAGE(PG8_SA(1, 0), a3, voffA);
            PG8_BAR; PG8_WAIT_L(0); PG8_MMA(1, 0, At, B0); PG8_BAR; PG8_SCHED;
            PG8_STAGE(PG8_SB(1, 1), b3 + hstep, voffB);
            PG8_WAIT_V(6); PG8_BAR; PG8_MMA(1, 1, At, B1); PG8_BAR;
            }
        }
        if constexpr (ALIGN_EPI) { if (wr == 0) PG8_BAR; }
        if constexpr (!Epi::AFTER_DRAIN) { E(acc, cur, wr, wc, fr, fq); S.done(cur); }
        if (!has_next) break;
#pragma unroll
        for (int a = 0; a < 2; ++a)
#pragma unroll
            for (int b = 0; b < 2; ++b)
#pragma unroll
                for (int m = 0; m < 4; ++m)
#pragma unroll
                    for (int n = 0; n < 2; ++n) acc[a][b][m][n] = (f32x4){0.f, 0.f, 0.f, 0.f};
        cur = nxt; cA = nA; cB = nB; ++ui;
        if constexpr (ALIGN_EPI) { if (wr == 1) PG8_BAR; }
    }
    PG8_WAIT_V(0);
    if constexpr (!ALIGN_EPI) { if (wr == 0) PG8_BAR; }
    PG8_BAR;
    if constexpr (Epi::AFTER_DRAIN) { E.fused(acc, cur, wr, wc, fr, fq, lds, wid, lane); S.done(cur); }
#undef PG8_SA
#undef PG8_SB
#undef PG8_STAGE
#undef PG8_LDA
#undef PG8_LDB
#undef PG8_MMA
#undef PG8_WAIT_V
#undef PG8_WAIT_L
#undef PG8_BAR
#undef PG8_SCHED
}
}

#ifndef PG8_SP2
#define PG8_SP2 true
#endif
#ifndef PG8_ALIGN
#define PG8_ALIGN true
#endif
#include <hip/hip_bf16.h>
#include <cmath>
namespace attn_body {
using bf16=__hip_bfloat16;
using bf16x8=__attribute__((ext_vector_type(8)))short;
using s16x4=__attribute__((ext_vector_type(4)))short;
using f32x16=__attribute__((ext_vector_type(16)))float;
using u32x4=__attribute__((ext_vector_type(4)))unsigned;
constexpr int BATCH=4,NHEAD=8,SEQ=8192,D=64,PQ=2560,PO=1024;
constexpr int NW=8,QBLK=32,QB=QBLK*NW,KVBLK=64,NQB=SEQ/QB;
constexpr int ATTN_UNIT_ROWS=QB;
__device__ __forceinline__ int crow(int r,int hi){return (r&3)+8*(r>>2)+4*hi;}
#define SBAR() __builtin_amdgcn_sched_barrier(0)
__device__ __forceinline__ void cmask(f32x16&p0,f32x16&p1,int jb,int qrel,int hi){
  const float NEG=-INFINITY; int kb=64*jb+4*hi;
  #pragma unroll
  for(int r=0;r<16;++r){int kv=kb+(r&3)+8*(r>>2); if(kv>qrel)p0[r]=NEG; if(kv+32>qrel)p1[r]=NEG;}
}

constexpr int NSLOT=3, SLOTB=8192;
constexpr int LDS_K=0, LDS_V=NSLOT*SLOTB, LDS_WS=2*NSLOT*SLOTB, LDS_OST=LDS_WS+NW*64*4, LDS_CT=LDS_OST+NW*4096+2048, LDS_BYTES=LDS_CT+SEQ*4;
constexpr float C2=0.125f*1.4426950408889634f;
__device__ __forceinline__ void glds16(const void*gsrc,unsigned lds_dst){unsigned keep;
  asm volatile("s_mov_b32 %0, m0\n\ts_mov_b32 m0, %2\n\ts_nop 0\n\tglobal_load_lds_dwordx4 %1, off\n\ts_mov_b32 m0, %0":"=&s"(keep):"v"(gsrc),"s"(lds_dst):"memory");}
__device__ __forceinline__ float max3f(float a,float b,float c){float r;asm("v_max3_f32 %0, %1, %2, %3":"=v"(r):"v"(a),"v"(b),"v"(c));return r;}
__device__ __forceinline__ float max2f(float a,float b){float r;asm("v_max_f32_e32 %0, %1, %2":"=v"(r):"v"(a),"v"(b));return r;}
__device__ __forceinline__ float fadd_s(float a,float b){float r;asm("v_add_f32_e32 %0, %1, %2":"=v"(r):"v"(a),"v"(b));return r;}
__device__ __forceinline__ float fsub_s(float a,float b){float r;asm("v_sub_f32_e32 %0, %1, %2":"=v"(r):"v"(a),"v"(b));return r;}
typedef float f32x2_t __attribute__((ext_vector_type(2))); typedef float f32x4_t __attribute__((ext_vector_type(4))); typedef __bf16 bf16x2_t __attribute__((ext_vector_type(2)));
__device__ __forceinline__ unsigned cvtpk_s(float lo,float hi){f32x2_t v={lo,hi};bf16x2_t b=__builtin_convertvector(v,bf16x2_t);return __builtin_bit_cast(unsigned,b);}
#define WAIT_BAR(N) asm volatile("s_waitcnt vmcnt(" #N ") lgkmcnt(0)\n\ts_barrier":::"memory")

__device__ __forceinline__ void qkt(f32x16&p0,f32x16&p1,const char*Kslot,const bf16x8*qr,const f32x16&negm,int r32,int hi){
  const char*kb=Kslot+hi*1024+r32*16;
  #pragma unroll
  for(int d0=0;d0<4;++d0){
    const bf16x8 b0=*reinterpret_cast<const bf16x8*>(kb+d0*2048);
    const bf16x8 b1=*reinterpret_cast<const bf16x8*>(kb+d0*2048+512);
    if(d0==0){p0=__builtin_amdgcn_mfma_f32_32x32x16_bf16(b0,qr[0],negm,0,0,0);p1=__builtin_amdgcn_mfma_f32_32x32x16_bf16(b1,qr[0],negm,0,0,0);}
    else{p0=__builtin_amdgcn_mfma_f32_32x32x16_bf16(b0,qr[d0],p0,0,0,0);p1=__builtin_amdgcn_mfma_f32_32x32x16_bf16(b1,qr[d0],p1,0,0,0);}}
}
typedef __attribute__((address_space(3))) const char* lds_cptr;
typedef short v4i16_t __attribute__((ext_vector_type(4)));
__device__ __forceinline__ void kload8(bf16x8*kf,lds_cptr kp){
  kf[0]=*(const __attribute__((address_space(3))) bf16x8*)(kp);      kf[1]=*(const __attribute__((address_space(3))) bf16x8*)(kp+512);
  kf[2]=*(const __attribute__((address_space(3))) bf16x8*)(kp+2048); kf[3]=*(const __attribute__((address_space(3))) bf16x8*)(kp+2560);
  kf[4]=*(const __attribute__((address_space(3))) bf16x8*)(kp+4096); kf[5]=*(const __attribute__((address_space(3))) bf16x8*)(kp+4608);
  kf[6]=*(const __attribute__((address_space(3))) bf16x8*)(kp+6144); kf[7]=*(const __attribute__((address_space(3))) bf16x8*)(kp+6656);
}
__device__ __forceinline__ void kload2(bf16x8*kf,lds_cptr kp,int j){ kf[2*j]=*(const __attribute__((address_space(3))) bf16x8*)(kp+j*2048); kf[2*j+1]=*(const __attribute__((address_space(3))) bf16x8*)(kp+j*2048+512); }
__device__ __forceinline__ s16x4 vtr(lds_cptr p){ return __builtin_bit_cast(s16x4,__builtin_amdgcn_ds_read_tr16_b64_v4i16((__attribute__((address_space(3))) v4i16_t*)p)); }
__device__ __forceinline__ float rowmax(const f32x16&p0,const f32x16&p1){
  float a=max3f(p0[0],p0[1],p1[0]),b=max3f(p0[2],p0[3],p1[1]);a=max3f(a,p1[2],p1[3]);
  #pragma unroll
  for(int r=4;r<16;r+=4){a=max3f(a,p0[r],p0[r+1]);b=max3f(b,p0[r+2],p0[r+3]);a=max3f(a,p1[r],p1[r+1]);b=max3f(b,p1[r+2],p1[r+3]);}
  const float m=max2f(a,b);
  auto rr=__builtin_amdgcn_permlane32_swap(__float_as_uint(m),__float_as_uint(m),false,false);
  return max2f(__uint_as_float(rr[0]),__uint_as_float(rr[1]));
}
__device__ __forceinline__ void pv(f32x16*o,int vb,bf16x8 pa0,bf16x8 pa1,bf16x8 pa2,bf16x8 pa3){
  #pragma unroll
  for(int d0=0;d0<2;++d0){s16x4 lo[4],hi[4];
    #pragma unroll
    for(int ks=0;ks<4;++ks){
      asm volatile("ds_read_b64_tr_b16 %0,%1 offset:%c2":"=&v"(lo[ks]):"v"(vb),"i"(d0*4096+ks*1024):"memory");
      asm volatile("ds_read_b64_tr_b16 %0,%1 offset:%c2":"=&v"(hi[ks]):"v"(vb),"i"(d0*4096+ks*1024+512):"memory");}
    asm volatile("s_waitcnt lgkmcnt(0)":::"memory");SBAR();
    #define PK(k) (bf16x8){lo[k][0],lo[k][1],lo[k][2],lo[k][3],hi[k][0],hi[k][1],hi[k][2],hi[k][3]}
    o[d0]=__builtin_amdgcn_mfma_f32_32x32x16_bf16(pa0,PK(0),o[d0],0,0,0);
    o[d0]=__builtin_amdgcn_mfma_f32_32x32x16_bf16(pa1,PK(1),o[d0],0,0,0);
    o[d0]=__builtin_amdgcn_mfma_f32_32x32x16_bf16(pa2,PK(2),o[d0],0,0,0);
    o[d0]=__builtin_amdgcn_mfma_f32_32x32x16_bf16(pa3,PK(3),o[d0],0,0,0);
    #undef PK
  }
}

#ifndef ATTN_STORE16
#define ATTN_STORE16(p,v) (*(u32x4*)(p)=(v))
#endif
template<int THRL> __device__ __forceinline__ void attn_unit(int b,int h,int qb,const bf16*Q,const bf16*__restrict__ K,const bf16*__restrict__ V,bf16*O,const float*__restrict__ CT,char*shm,const int tid_in){
  int tid_=tid_in; asm volatile("":"+v"(tid_)); const int tid=tid_,lane=tid&63,r32=lane&31,hi=lane>>5; const int wid=__builtin_amdgcn_readfirstlane(tid>>6);
  const long rowbase=(long)b*SEQ; const int q0=qb*QB;
  const bf16*Qw=Q+(rowbase+q0+wid*QBLK)*PQ+h*D;
  const bf16*Kh=K+rowbase*PQ+h*D,*Vh=V+rowbase*PQ+h*D;
  const unsigned lds0=(unsigned)(uintptr_t)shm;
  float*wsf=(float*)(shm+LDS_WS)+wid*64;
  const bf16*ksrc=Kh+(long)lane*PQ+wid*8;
  const bf16*vsrc=Vh+(long)(16*(wid&3)+(lane>>2))*PQ+(wid>>2)*32+(lane&3)*8;
  const unsigned kdst=lds0+LDS_K+wid*1024, vdst=lds0+LDS_V+wid*1024;
  #define DMA_K(t,slot) glds16(ksrc+(long)(t)*KVBLK*PQ,(unsigned)__builtin_amdgcn_readfirstlane(kdst+(slot)))
  #define DMA_V(t,slot) glds16(vsrc+(long)(t)*KVBLK*PQ,(unsigned)__builtin_amdgcn_readfirstlane(vdst+(slot)))
  const int vb0=(int)(lds0+LDS_V)+((lane>>4)&1)*32+(lane&3)*8+(4*hi+((lane&15)>>2))*64;
  const char*Kbase=shm+LDS_K; bf16x8 kf[8];
  const lds_cptr shm3=(lds_cptr)shm; const lds_cptr kp0=shm3+LDS_K+hi*1024+r32*16; const lds_cptr vp0=shm3+LDS_V+((lane>>4)&1)*32+(lane&3)*8+(4*hi+((lane&15)>>2))*64;
  const int NT=(q0+QB)/KVBLK;
  const float*ctg=CT+(long)(b*NHEAD+h)*SEQ;
  { typedef __attribute__((address_space(3))) u32x4 lv4; const u32x4*src=(const u32x4*)ctg; lv4*dst=(lv4*)(shm3+LDS_CT); const int n4=(q0+QB)/4;
    for(int i=tid;i<n4;i+=NW*64)dst[i]=src[i]; }
  const float ctl=ctg[q0+wid*QBLK+r32];
  const __attribute__((address_space(3))) float*ctab=(const __attribute__((address_space(3))) float*)(shm3+LDS_CT)+4*hi;
  DMA_K(0,0);DMA_V(0,0);DMA_K(1,SLOTB);
  bf16x8 qr[4];
  #pragma unroll
  for(int d0=0;d0<4;++d0)qr[d0]=*reinterpret_cast<const bf16x8*>(&Qw[(long)r32*PQ+d0*16+hi*8]);
  float mhat=0.f,l_reg=0.f;f32x16 o[2];o[0]=f32x16{};o[1]=f32x16{};f32x16 negm;
  _Pragma("unroll") for(int r=0;r<16;++r)negm[r]=ctl; asm volatile("":"+v"(negm));
  #define CBIAS(C0,C1,t) do{ const __attribute__((address_space(3))) float*tb_=ctab+64*(t); \
    _Pragma("unroll") for(int g_=0;g_<4;++g_){ const f32x4_t a_=*(const __attribute__((address_space(3))) f32x4_t*)(tb_+8*g_), b_=*(const __attribute__((address_space(3))) f32x4_t*)(tb_+32+8*g_); \
      _Pragma("unroll") for(int e_=0;e_<4;++e_){ C0[4*g_+e_]-=a_[e_]; C1[4*g_+e_]-=b_[e_]; } } }while(0)
  const int qrel=wid*QBLK+r32;
  #define CMASK(P0,P1,t) do{int jb_=(t)-(NT-4); if(jb_>=0)cmask(P0,P1,jb_,qrel,hi);}while(0)
  bool resc=false;
  #define START(P0,P1) do{ const float rm=rowmax(P0,P1); resc=false; \
    { const float dl=rm; mhat=fadd_s(mhat,dl); \
      _Pragma("unroll") for(int r=0;r<16;++r){P0[r]=fsub_s(P0[r],dl);P1[r]=fsub_s(P1[r],dl);} \
      _Pragma("unroll") for(int r=0;r<16;++r)negm[r]=ctl-mhat; asm volatile("":"+v"(negm)); } \
    _Pragma("unroll") for(int r=0;r<16;++r)P0[r]=__builtin_amdgcn_exp2f(P0[r]); }while(0)
  #define RESC() do{ if(resc){ asm volatile("s_waitcnt lgkmcnt(0)":::"memory"); \
      _Pragma("unroll") for(int d_=0;d_<2;++d_) _Pragma("unroll") for(int r=0;r<16;++r)o[d_][r]*=wsf[crow(r,hi)]; } }while(0)
  f32x16 pA0,pA1,pB0,pB1;
  int sl_prev=0,sl_cur=0,sl_next=SLOTB;
  #define ROT() do{sl_prev=sl_cur;sl_cur=sl_next;sl_next=(sl_next==(NSLOT-1)*SLOTB)?0:sl_next+SLOTB;}while(0)
  DMA_K(2,2*SLOTB);
  WAIT_BAR(3);
  qkt(pA0,pA1,Kbase,qr,negm,r32,hi);asm volatile("s_nop 15\n\ts_nop 7":"+v"(pA0),"+v"(pA1));CBIAS(pA0,pA1,0);asm volatile("s_nop 1":"+v"(pA0),"+v"(pA1));CMASK(pA0,pA1,0);
  START(pA0,pA1);
  _Pragma("unroll") for(int r=0;r<16;++r)pA1[r]=__builtin_amdgcn_exp2f(pA1[r]);
  WAIT_BAR(0);
  DMA_K(3,0);DMA_V(1,SLOTB);
  ROT();
  kload8(kf,kp0+sl_cur);
  WAIT_BAR(2);
  s16x4 vlo[8],vhi[8]; u32x4 pw0,pw1,pw2,pw3;
  #define PKW(P,B) cvtpk_s(P[B],P[B+1])
  #define PAF(k) __builtin_bit_cast(bf16x8,pw##k)
  #define VFR(i) (bf16x8){vlo[i][0],vlo[i][1],vlo[i][2],vlo[i][3],vhi[i][0],vhi[i][1],vhi[i][2],vhi[i][3]}
  #define PIN(x) asm volatile("":"+v"(x))
  #define MX3(a,b,c) __builtin_fmaxf(__builtin_fmaxf((a),(b)),(c))
  #define GAPA(MF,A0,A1,A2,A3,W0,W1,PW) do{ MF; sacc+=A0; sacc+=A1; sacc+=A2; sacc+=A3; PIN(sacc); W0; W1; PIN(PW); SBAR(); }while(0)
  #define EX(v) __builtin_amdgcn_exp2f(v)
  #define GAPB(MF,X,B) do{ MF; X[B]=EX(X[B]); X[B+1]=EX(X[B+1]); X[B+2]=EX(X[B+2]); X[B+3]=EX(X[B+3]); PIN(X); SBAR(); }while(0)
  #define VRD(i) do{ vlo[i]=vtr(vp_+(((i)>>2)*4096+((i)&3)*1024)); vhi[i]=vtr(vp_+(((i)>>2)*4096+((i)&3)*1024+512)); }while(0)
  #define KRD(G,j) do{ if(G){ kload2(kf,kp0+sl_next,j); SBAR(); } }while(0)
  #define STEP(C0,C1,P0,P1,t,GK,GV,GL) do{ SBAR(); \
    const lds_cptr vp_=vp0+sl_prev; \
    VRD(0); SBAR(); float sacc=(P0[0]+P0[1]); \
    GAPA(C0=__builtin_amdgcn_mfma_f32_32x32x16_bf16(kf[0],qr[0],negm,0,0,0), P0[2],P0[3],P0[4],P0[5],     pw0[0]=PKW(P0,0), pw0[1]=PKW(P0,2), pw0); \
    VRD(4); SBAR(); GAPA(C1=__builtin_amdgcn_mfma_f32_32x32x16_bf16(kf[1],qr[0],negm,0,0,0), P0[6],P0[7],P0[8],P0[9],     pw0[2]=PKW(P0,4), pw0[3]=PKW(P0,6), pw0); \
    VRD(1); SBAR(); GAPA(C0=__builtin_amdgcn_mfma_f32_32x32x16_bf16(kf[2],qr[1],C0,0,0,0),   P0[10],P0[11],P0[12],P0[13], pw1[0]=PKW(P0,8), pw1[1]=PKW(P0,10), pw1); \
    VRD(5); SBAR(); GAPA(C1=__builtin_amdgcn_mfma_f32_32x32x16_bf16(kf[3],qr[1],C1,0,0,0),   P0[14],P0[15],P1[0],P1[1],   pw1[2]=PKW(P0,12),pw1[3]=PKW(P0,14), pw1); \
    VRD(2); SBAR(); GAPA(C0=__builtin_amdgcn_mfma_f32_32x32x16_bf16(kf[4],qr[2],C0,0,0,0),   P1[2],P1[3],P1[4],P1[5],     pw2[0]=PKW(P1,0), pw2[1]=PKW(P1,2), pw2); \
    VRD(6); SBAR(); GAPA(C1=__builtin_amdgcn_mfma_f32_32x32x16_bf16(kf[5],qr[2],C1,0,0,0),   P1[6],P1[7],P1[8],P1[9],     pw2[2]=PKW(P1,4), pw2[3]=PKW(P1,6), pw2); \
    VRD(3); SBAR(); GAPA(C0=__builtin_amdgcn_mfma_f32_32x32x16_bf16(kf[6],qr[3],C0,0,0,0),   P1[10],P1[11],P1[12],P1[13], pw3[0]=PKW(P1,8), pw3[1]=PKW(P1,10), pw3); \
    VRD(7); SBAR(); GAPA(C1=__builtin_amdgcn_mfma_f32_32x32x16_bf16(kf[7],qr[3],C1,0,0,0),   P1[14],P1[15],0.f,0.f,       pw3[2]=PKW(P1,12),pw3[3]=PKW(P1,14), pw3); \
    l_reg+=sacc; \
    if(GK){DMA_K((t)+3,sl_cur);} if(GV){DMA_V((t)+1,sl_next);} \
    CBIAS(C0,C1,t); CMASK(C0,C1,t); \
    { float a=MX3(C0[0],C0[1],C1[0]),b=MX3(C0[2],C0[3],C1[1]); a=MX3(a,C1[2],C1[3]); \
      _Pragma("unroll") for(int r=4;r<16;r+=4){a=MX3(a,C0[r],C0[r+1]);b=MX3(b,C0[r+2],C0[r+3]);a=MX3(a,C1[r],C1[r+1]);b=MX3(b,C1[r+2],C1[r+3]);} \
      float rm=__builtin_fmaxf(a,b); { auto rr=__builtin_amdgcn_permlane32_swap(__float_as_uint(rm),__float_as_uint(rm),false,false); rm=__builtin_fmaxf(__uint_as_float(rr[0]),__uint_as_float(rr[1])); } \
      resc=false; \
      if(__builtin_expect(__any(rm>(float)THRL),0)){ const float dl=__builtin_fmaxf(rm,0.f); mhat+=dl; \
        _Pragma("unroll") for(int r=0;r<16;++r){C0[r]-=dl;C1[r]-=dl;} \
        _Pragma("unroll") for(int r=0;r<16;++r)negm[r]=ctl-mhat; asm volatile("":"+v"(negm)); \
        const float f=__builtin_amdgcn_exp2f(-dl); l_reg*=f; if(hi==0)wsf[r32]=f; resc=true; } } \
    SBAR(); \
    GAPB(o[0]=__builtin_amdgcn_mfma_f32_32x32x16_bf16(PAF(0),VFR(0),o[0],0,0,0), C0,0); \
    GAPB(o[1]=__builtin_amdgcn_mfma_f32_32x32x16_bf16(PAF(0),VFR(4),o[1],0,0,0), C0,4); \
    KRD(GL,0); GAPB(o[0]=__builtin_amdgcn_mfma_f32_32x32x16_bf16(PAF(1),VFR(1),o[0],0,0,0), C0,8); \
    KRD(GL,1); GAPB(o[1]=__builtin_amdgcn_mfma_f32_32x32x16_bf16(PAF(1),VFR(5),o[1],0,0,0), C0,12); \
    KRD(GL,2); GAPB(o[0]=__builtin_amdgcn_mfma_f32_32x32x16_bf16(PAF(2),VFR(2),o[0],0,0,0), C1,0); \
    KRD(GL,3); GAPB(o[1]=__builtin_amdgcn_mfma_f32_32x32x16_bf16(PAF(2),VFR(6),o[1],0,0,0), C1,4); \
    GAPB(o[0]=__builtin_amdgcn_mfma_f32_32x32x16_bf16(PAF(3),VFR(3),o[0],0,0,0), C1,8); \
    GAPB(o[1]=__builtin_amdgcn_mfma_f32_32x32x16_bf16(PAF(3),VFR(7),o[1],0,0,0), C1,12); \
    }while(0)
  int t=1;
  #undef CMASK
  #define CMASK(P0,P1,t) do{}while(0)
  for(;t+5<NT;t+=2){
    STEP(pB0,pB1,pA0,pA1,t,true,true,true);     WAIT_BAR(2); RESC(); ROT();
    STEP(pA0,pA1,pB0,pB1,t+1,true,true,true);   WAIT_BAR(2); RESC(); ROT();
  }
  #undef CMASK
  #define CMASK(P0,P1,t) do{int jb_=(t)-(NT-4); if(jb_>=0)cmask(P0,P1,jb_,qrel,hi);}while(0)
  #define ENDW(tt) do{ if((tt)+3<NT){WAIT_BAR(2);} else if((tt)+2<NT){WAIT_BAR(1);} else {WAIT_BAR(0);} }while(0)
  for(;t+1<NT;t+=2){
    STEP(pB0,pB1,pA0,pA1,t,(t+3<NT),(t+1<NT),(t+1<NT));       ENDW(t);   RESC(); ROT();
    STEP(pA0,pA1,pB0,pB1,t+1,(t+4<NT),(t+2<NT),(t+2<NT));     ENDW(t+1); RESC(); ROT();
  }
  STEP(pB0,pB1,pA0,pA1,NT-1,false,false,false); RESC();
  { float sacc=pB0[0]+pB0[1]; _Pragma("unroll") for(int r=2;r<16;++r)sacc+=pB0[r]; _Pragma("unroll") for(int r=0;r<16;++r)sacc+=pB1[r]; l_reg+=sacc;
    pw0=(u32x4){PKW(pB0,0),PKW(pB0,2),PKW(pB0,4),PKW(pB0,6)};pw1=(u32x4){PKW(pB0,8),PKW(pB0,10),PKW(pB0,12),PKW(pB0,14)};pw2=(u32x4){PKW(pB1,0),PKW(pB1,2),PKW(pB1,4),PKW(pB1,6)};pw3=(u32x4){PKW(pB1,8),PKW(pB1,10),PKW(pB1,12),PKW(pB1,14)};
    SBAR(); pv(o,vb0+sl_cur,PAF(0),PAF(1),PAF(2),PAF(3)); }
  #undef PKW
  #undef PAF
  #undef VFR
  #undef PIN
  #undef MX3
  #undef GAPA
  #undef GAPB
  #undef EX
  #undef VRD
  #undef KRD
  #undef STEP
  #undef ENDW
  {auto rr=__builtin_amdgcn_permlane32_swap(__float_as_uint(l_reg),__float_as_uint(l_reg),false,false);l_reg=__uint_as_float(rr[0])+__uint_as_float(rr[1]);}
  if(hi==0)wsf[32+r32]=l_reg;asm volatile("s_waitcnt lgkmcnt(0)":::"memory");
  float rli[16];
  #pragma unroll
  for(int r=0;r<16;++r)rli[r]=__builtin_amdgcn_rcpf(wsf[32+crow(r,hi)]);
  bf16*Ow=O+(rowbase+q0+wid*QBLK)*PO+h*D;
  { bf16*stg=(bf16*)(shm+LDS_OST)+wid*2048;
    #pragma unroll
    for(int r=0;r<16;++r){const int orow=crow(r,hi);
      #pragma unroll
      for(int d0=0;d0<2;++d0)stg[orow*64+d0*32+r32]=__float2bfloat16(o[d0][r]*rli[r]);}
    asm volatile("s_waitcnt lgkmcnt(0)":::"memory");
    #pragma unroll
    for(int i=0;i<4;++i){const int row=i*8+(lane>>3),ch=lane&7; const u32x4 v=*(const u32x4*)(stg+row*64+ch*8); ATTN_STORE16(Ow+(long)row*PO+ch*8,v);} }
  asm volatile("s_waitcnt lgkmcnt(0)\n\ts_barrier":::"memory");
  #undef DMA_K
  #undef DMA_V
  #undef CMASK
  #undef CBIAS
  #undef START
  #undef RESC
  #undef ROT
}
constexpr int ATTN_LDS_BYTES=LDS_BYTES;
struct AttnTensors { const bf16* Q; const bf16* K; const bf16* V; bf16* O; const float* CT; };
struct AttnUnit { int bh; int qb; };
struct StaticOrder {
  int vcu;
  __device__ __forceinline__ explicit StaticOrder(int grid,int block):vcu((block%8)*(grid/8)+block/8){}
  __device__ __forceinline__ bool next(int i,AttnUnit&u)const{ if(i>=4)return false; const int s=vcu&7; u.bh=vcu>>3; u.qb=(i==0)?s:(i==1)?15-s:(i==2)?16+s:31-s; return true; }
  __device__ __forceinline__ void a_ready(const AttnUnit&)const{}
  __device__ __forceinline__ void done(const AttnUnit&)const{}
};
template<class Sched,int THRL=8> __device__ __forceinline__ void attn_phase(char*lds,const AttnTensors&T,const Sched&S,const int tid_in){
  AttnUnit u;
  for(int i=0;S.next(i,u);++i){ S.a_ready(u); attn_unit<THRL>(u.bh/NHEAD,u.bh%NHEAD,u.qb,T.Q,T.K,T.V,T.O,T.CT,lds,tid_in); S.done(u); }
}
#undef SBAR
#undef WAIT_BAR
}

constexpr int NWAVES = 8;
#ifndef MK_N_LAUNCHES
#define MK_N_LAUNCHES 1
#endif
enum Phase { PH_PRO = 0, PH_IN0, PH_MIX0, PH_OUT0, PH_XQ0, PH_XO0, PH_UP0, PH_DN0, PH_IN1, PH_MIX1, PH_OUT1, PH_XQ1, PH_XO1, PH_UP1, PH_DN1, N_PHASES };
constexpr int N_LAUNCHES = MK_N_LAUNCHES;
static_assert(N_LAUNCHES == 1 || N_LAUNCHES == N_PHASES, "MK_N_LAUNCHES is 1 or 15");

constexpr int BATCH = 4, SEQ = 8192, D = 1024, T = BATCH * SEQ;
constexpr int NMEM = 256, MROWS = BATCH * NMEM;
constexpr int EVEN_IN = 2568, N_IN0 = 2560, N_IN1 = 2048, DFF = 2816, XAW = 512;
constexpr float EPS = 1e-6f, LOG2E = 1.4426950408889634f;
constexpr float FOX_C2 = 0.125f * LOG2E;
constexpr float XA_C2 = 0.08838834764831845f * LOG2E;

constexpr size_t MiB = 1u << 20;
constexpr size_t WS_CTL = 0, CTL_ZERO_BYTES = 1 * MiB;
constexpr size_t WS_WIN0 = 2 * MiB, WS_WOUT0 = 7 * MiB, WS_WIN1 = 9 * MiB, WS_WOUT1 = 13 * MiB;
constexpr size_t WS_LAYER = 15 * MiB, LAYER_STRIDE = 21 * MiB, L_WQ = 0, L_WKV = 1 * MiB, L_WO = 3 * MiB, L_WGU = 4 * MiB, L_WD = 15 * MiB;
constexpr size_t WS_WSP = 57 * MiB;
constexpr size_t WS_MEMN = 58 * MiB, WS_KVRAW = 60 * MiB, WS_KN = 64 * MiB, WS_VT = 66 * MiB;
constexpr size_t WS_LOGF = 68 * MiB, WS_CUM = 69 * MiB, WS_SSQ = 70 * MiB;
constexpr size_t WS_XB = 72 * MiB, WS_Y = 136 * MiB, WS_XQ = WS_Y, WS_XO = WS_Y + 32 * MiB, WS_BIG = 200 * MiB, WS_END = 376 * MiB;
constexpr int CW_TMO = 0, CW_CODE = 1;
constexpr int CW_BAR = 4096;

constexpr int RING_OFF = 0, RING_BYTES = 131072;
constexpr int XA_KROW = 272, XA_VROW = 528, XA_KBYTES = 256 * XA_KROW, XA_VBYTES = 128 * XA_VROW;
constexpr int LDSCTL_OFF = 139264, MISC_OFF = LDSCTL_OFF + 320;
constexpr int LDS_BYTES = 147456;
static_assert(XA_KBYTES + XA_VBYTES <= LDSCTL_OFF && MISC_OFF + 128 <= LDS_BYTES, "LDS map");
#define GAS __attribute__((address_space(1)))
#define LAS __attribute__((address_space(3)))
typedef unsigned short bf16;
typedef unsigned v4u __attribute__((ext_vector_type(4)));
typedef float f32x4 __attribute__((ext_vector_type(4)));
typedef short bf16x8 __attribute__((ext_vector_type(8)));
typedef GAS unsigned gu32;
typedef GAS unsigned long long gu64;
#define RLX_AGENT __ATOMIC_RELAXED, __HIP_MEMORY_SCOPE_AGENT
#define LDS_WAIT() asm volatile("s_waitcnt lgkmcnt(0)" ::: "memory")
#define VM_WAIT() asm volatile("s_waitcnt vmcnt(0)" ::: "memory")
__device__ __forceinline__ unsigned long long rt() { return __builtin_amdgcn_s_memrealtime(); }
__device__ __forceinline__ unsigned f2bf(float f) { unsigned u = __builtin_bit_cast(unsigned, f); return (u + 0x7fffu + ((u >> 16) & 1u)) >> 16; }
__device__ __forceinline__ unsigned pk2(float lo, float hi) { return f2bf(lo) | (f2bf(hi) << 16); }

#define XB_TMO      128
#define XB_XCNT(j)  (256  + 64 * (j))
#define XB_XSUB(j)  (1280 + 64 * (j))
#define XB_XGEN(j)  (2304 + 64 * (j))
#define XB_TOP      3328
#define XB_TOPGEN   3392
#define XCD_BAR_WORDS 3456
#define XB_SPIN_CAP (1u << 18)

__device__ __forceinline__ unsigned xb_ld(unsigned* p)              { return __hip_atomic_load(p, __ATOMIC_RELAXED, __HIP_MEMORY_SCOPE_AGENT); }
__device__ __forceinline__ unsigned xb_add(unsigned* p, unsigned v) { return __hip_atomic_fetch_add(p, v, __ATOMIC_RELAXED, __HIP_MEMORY_SCOPE_AGENT); }
__device__ __forceinline__ unsigned xb_xcc_id() { return (unsigned)__builtin_amdgcn_s_getreg((3 << 11) | 20) & 0xFu; }
#define XB_SPIN(cond, bar) do { unsigned _sp = 0; while (cond) { __builtin_amdgcn_s_sleep(1); \
    if ((++_sp & 255u) == 0u) { if (xb_ld(&(bar)[XB_TMO])) break; if (_sp > XB_SPIN_CAP) { atomicAdd(&(bar)[XB_TMO], 1u); break; } } } } while (0)

struct XcdBarrier {
    unsigned* bar; unsigned x;
    volatile LAS unsigned* st;
};

__device__ __forceinline__ XcdBarrier xcd_barrier_post(unsigned* bar, volatile LAS unsigned* st, const int tid_in) {
    XcdBarrier b; b.bar = bar; b.x = xb_xcc_id(); b.st = st;
    if (tid_in == 0) (void)xb_add(&bar[XB_XCNT(b.x)], 1u);
    return b;
}
__device__ __forceinline__ void xcd_barrier_complete(unsigned* bar, unsigned x, unsigned& nloc, unsigned& nx) {
    const unsigned G = gridDim.x * gridDim.y * gridDim.z;
    unsigned sum, cnt, mine, sp = 0u;
    for (;;) {
        sum = 0u; cnt = 0u; mine = 0u;
#pragma unroll
        for (unsigned j = 0; j < 16; ++j) { const unsigned c = xb_ld(&bar[XB_XCNT(j)]); sum += c; cnt += (c > 0u) ? 1u : 0u; mine = (j == x) ? c : mine; }
        if (sum == G) break;
        __builtin_amdgcn_s_sleep(1);
        if ((++sp & 255u) == 0u) { if (xb_ld(&bar[XB_TMO])) break; if (sp > XB_SPIN_CAP) { atomicAdd(&bar[XB_TMO], 1u); break; } }
    }
    nloc = mine > 0u ? mine : 1u; nx = cnt > 0u ? cnt : 1u;
}

__device__ __forceinline__ void xcd_barrier(const XcdBarrier& b, const int tid_in) {
    asm volatile("s_waitcnt vmcnt(0)" ::: "memory");
    __syncthreads();
    int t0_ = tid_in; asm volatile("" : "+v"(t0_));
    if (t0_ == 0) {
        unsigned* bar = b.bar; asm volatile("" : "+v"(bar));
        __builtin_amdgcn_s_waitcnt(0);
        unsigned nloc = b.st[0], nx = b.st[1];
        if (nloc == 0u) { xcd_barrier_complete(bar, b.x, nloc, nx); b.st[0] = nloc; b.st[1] = nx; }
        const unsigned old = xb_add(&bar[XB_XSUB(b.x)], 1u);
        const unsigned gen = old / nloc;
        if (old + 1u == (gen + 1u) * nloc) {
            __builtin_amdgcn_fence(__ATOMIC_RELEASE, "agent");
            asm volatile("s_waitcnt vmcnt(0)" ::: "memory");
            const unsigned og = xb_add(&bar[XB_TOP], 1u);
            const unsigned tg = og / nx;
            if (og + 1u == (tg + 1u) * nx) xb_add(&bar[XB_TOPGEN], 1u);
            else XB_SPIN(xb_ld(&bar[XB_TOPGEN]) == tg, bar);
            __builtin_amdgcn_fence(__ATOMIC_ACQUIRE, "agent");
            xb_add(&bar[XB_XGEN(b.x)], 1u);
            asm volatile("s_waitcnt vmcnt(0)" ::: "memory");
        } else {
            XB_SPIN(xb_ld(&bar[XB_XGEN(b.x)]) == gen, bar);
            __builtin_amdgcn_fence(__ATOMIC_ACQUIRE, "agent");
            asm volatile("s_waitcnt vmcnt(0)" ::: "memory");
        }
    }
    __syncthreads();
}

typedef float f32x16 __attribute__((ext_vector_type(16)));
typedef unsigned u32x2 __attribute__((ext_vector_type(2)));
__device__ __forceinline__ float bf2f(short s) { return __builtin_bit_cast(float, (unsigned)(unsigned short)s << 16); }
__device__ __forceinline__ float bfu2f(unsigned u16) { return __builtin_bit_cast(float, u16 << 16); }
__device__ __forceinline__ float rsq(float x) { return __builtin_amdgcn_rsqf(x); }

typedef const float* cfp_t;
struct Frame {
    LAS unsigned char* lds;
    volatile LAS unsigned* MISC;
    gu32* ctl;
    int tid, lane, wave;
    int vcu, G;
    const __attribute__((address_space(4))) cfp_t* in;
    const float* x; float* out;
    unsigned char* ws;
    bf16 *XB, *Y, *XQ, *XO, *BIG, *MEMN, *KVRAW, *KN, *VT, *WSP;
    float *LOGF, *CUM, *SSQ;
};
__device__ __forceinline__ bf16* lw(Frame& F, int l, size_t off) { return (bf16*)(F.ws + WS_LAYER + (size_t)l * LAYER_STRIDE + off); }

__device__ __forceinline__ float wave_sum(float v) {
#pragma unroll
    for (int o = 1; o < 64; o <<= 1) v += __shfl_xor(v, o);
    return v;
}
__device__ __forceinline__ void p0_transpose_item(const float* W, int ldn, const float* ks, bf16* WT, int ldk, int koff, int k0, int n0, int drow0, LAS float* scr, int lane) {
#pragma unroll 8
    for (int i = 0; i < 32; ++i) { const int kk = 2 * i + (lane >> 5); float w = W[(size_t)(k0 + kk) * ldn + n0 + (lane & 31)]; if (ks) w *= ks[k0 + kk]; scr[kk * 33 + (lane & 31)] = w; }
    LDS_WAIT(); asm volatile("" ::: "memory");
    const int c = lane & 7;
#pragma unroll
    for (int j = 0; j < 4; ++j) { const int n = (lane >> 3) + 8 * j; const LAS float* s = scr + (8 * c) * 33 + n;
        v4u o; o.x = pk2(s[0 * 33], s[1 * 33]); o.y = pk2(s[2 * 33], s[3 * 33]); o.z = pk2(s[4 * 33], s[5 * 33]); o.w = pk2(s[6 * 33], s[7 * 33]);
        *(GAS v4u*)(WT + (size_t)(drow0 + n) * ldk + koff + k0 + 8 * c) = o; }
    LDS_WAIT(); asm volatile("" ::: "memory");
}
__device__ __forceinline__ bool p0_job(int& r, const float* src, int ldn, int K, int N, const float* ks, bf16* dst, int ldk, int koff, int map, LAS float* scr, int lane) {
    const int nblk = N / 32, items = (K / 64) * nblk;
    if (r >= items) { r -= items; return false; }
    const int kb = r / nblk, nb = r % nblk, n0 = 32 * nb; int drow0 = n0;
    if (map == 1) { if (n0 >= 1024 && n0 < 2048) { const int tile = n0 >> 8, ll = n0 & 255; drow0 = tile * 256 + 128 * ((ll >> 5) & 1) + 32 * (ll >> 6); } }
    else if (map == 2) drow0 = 256 * (n0 >> 7) + (n0 & 127);
    else if (map == 3) drow0 = 256 * (n0 >> 7) + 128 + (n0 & 127);
    p0_transpose_item(src, ldn, ks, dst, ldk, koff, 64 * kb, n0, drow0, scr, lane);
    return true;
}
__device__ __forceinline__ void p0_prologue(Frame& F) {
    LAS float* scr = (LAS float*)(F.lds + RING_OFF + F.wave * 16384);
    const int gw = F.vcu * NWAVES + F.wave, NGW = F.G * NWAVES, lane = F.lane;
    const __attribute__((address_space(4))) cfp_t* in = F.in;
    constexpr int I_IN0 = 16 * 80, I_SQ = 16 * 32, I_IN1 = 16 * 64, I_O1 = 8 * 32, I_Q = 16 * 16, I_KV = 16 * 32, I_XO = 8 * 32, I_G = 16 * 88, I_DN = 44 * 32;
    constexpr int NITEMS = I_IN0 + I_SQ + I_IN1 + I_O1 + 2 * (I_Q + I_KV + I_XO + 2 * I_G + I_DN);
    for (int it = gw; it < NITEMS; it += NGW) {
        int r = it;
        if (p0_job(r, in[14], EVEN_IN, D, N_IN0, in[2], (bf16*)(F.ws + WS_WIN0), D, 0, 1, scr, lane)) continue;
        if (p0_job(r, in[21], D, D, D, nullptr, (bf16*)(F.ws + WS_WOUT0), D, 0, 0, scr, lane)) continue;
        if (p0_job(r, in[22], N_IN1, D, N_IN1, in[2] + D, (bf16*)(F.ws + WS_WIN1), D, 0, 0, scr, lane)) continue;
        if (p0_job(r, in[26] + (size_t)512 * D, D, 512, D, nullptr, (bf16*)(F.ws + WS_WOUT1), D, 512, 0, scr, lane)) continue;
        bool done = false;
#pragma unroll
        for (int l = 0; l < 2; ++l) {
            if (done) break;
            if (p0_job(r, in[5] + (size_t)l * D * XAW, XAW, D, XAW, in[3] + l * D, lw(F, l, L_WQ), D, 0, 0, scr, lane)) { done = true; break; }
            if (p0_job(r, in[6] + (size_t)l * D * D, D, D, D, in[4] + l * D, lw(F, l, L_WKV), D, 0, 0, scr, lane)) { done = true; break; }
            if (p0_job(r, in[7] + (size_t)l * XAW * D, D, XAW, D, nullptr, lw(F, l, L_WO), XAW, 0, 0, scr, lane)) { done = true; break; }
            if (p0_job(r, in[11] + (size_t)l * D * DFF, DFF, D, DFF, in[10] + l * D, lw(F, l, L_WGU), D, 0, 2, scr, lane)) { done = true; break; }
            if (p0_job(r, in[12] + (size_t)l * D * DFF, DFF, D, DFF, in[10] + l * D, lw(F, l, L_WGU), D, 0, 3, scr, lane)) { done = true; break; }
            if (p0_job(r, in[13] + (size_t)l * DFF * D, D, DFF, D, nullptr, lw(F, l, L_WD), DFF, 0, 0, scr, lane)) { done = true; break; }
        }
    }
    for (int it = gw; it < 512 * 16; it += NGW) {
        const int kk = it >> 4, n0 = (it & 15) * 64, g = kk >> 7;
        const float* wp = in[23] + (size_t)kk * 128; const float* sp = in[24] + g * 128; const float* wo = in[26] + (size_t)(g * 128) * D + n0 + lane;
        float acc = 0.f;
#pragma unroll 8
        for (int d = 0; d < 128; ++d) acc += (wp[d] * sp[d]) * wo[(size_t)d * D];
        ((bf16*)(F.ws + WS_WOUT1))[(size_t)(n0 + lane) * D + kk] = (bf16)f2bf(acc);
    }
    for (int i = gw * 64 + lane; i < 4 * 128 * 128; i += NGW * 64) { const int t = (i >> 7) & 127, s = i & 127; const float w = in[17][i]; F.WSP[i] = (bf16)f2bf((t >> 6) >= (s >> 6) ? w : 0.f); }
    for (int row = gw; row < MROWS; row += NGW) {
        const GAS f32x4* xr = (const GAS f32x4*)(in[1] + (size_t)row * D) + lane;
        f32x4 v[4]; float s = 0.f;
#pragma unroll
        for (int j = 0; j < 4; ++j) { v[j] = xr[64 * j]; s += (v[j].x * v[j].x + v[j].y * v[j].y) + (v[j].z * v[j].z + v[j].w * v[j].w); }
        const float rstd = rsq(wave_sum(s) * (1.f / D) + EPS);
        GAS unsigned long long* o8 = (GAS unsigned long long*)(F.MEMN + (size_t)row * D) + lane;
#pragma unroll
        for (int j = 0; j < 4; ++j) o8[64 * j] = (unsigned long long)pk2(v[j].x * rstd, v[j].y * rstd) | ((unsigned long long)pk2(v[j].z * rstd, v[j].w * rstd) << 32);
    }
    {
        float wf[8][16];
#pragma unroll
        for (int jj = 0; jj < 4; ++jj)
#pragma unroll
            for (int e = 0; e < 4; ++e) { const int k = 4 * lane + 256 * jj + e; const float g = in[2][k]; const float* p = in[14] + (size_t)k * EVEN_IN + N_IN0;
                const f32x4 a = *(const f32x4*)p, b = *(const f32x4*)(p + 4);
                wf[0][jj * 4 + e] = a.x * g; wf[1][jj * 4 + e] = a.y * g; wf[2][jj * 4 + e] = a.z * g; wf[3][jj * 4 + e] = a.w * g;
                wf[4][jj * 4 + e] = b.x * g; wf[5][jj * 4 + e] = b.y * g; wf[6][jj * 4 + e] = b.z * g; wf[7][jj * 4 + e] = b.w * g; }
        const float bfl = in[15][lane & 7];
        for (int row = gw; row < T; row += NGW) {
            const GAS f32x4* xr = (const GAS f32x4*)(F.x + (size_t)row * D) + lane;
            f32x4 v[4]; float s = 0.f;
#pragma unroll
            for (int j = 0; j < 4; ++j) { v[j] = xr[64 * j]; s += (v[j].x * v[j].x + v[j].y * v[j].y) + (v[j].z * v[j].z + v[j].w * v[j].w); }
            s = wave_sum(s);
            const float rstd = rsq(s * (1.f / D) + EPS);
            if (lane < 16) F.SSQ[(size_t)row * 16 + lane] = (lane == 0) ? s : 0.f;
            GAS unsigned long long* o8 = (GAS unsigned long long*)(F.XB + (size_t)row * D) + lane;
#pragma unroll
            for (int j = 0; j < 4; ++j) o8[64 * j] = (unsigned long long)pk2(v[j].x, v[j].y) | ((unsigned long long)pk2(v[j].z, v[j].w) << 32);
            float mine = 0.f;
#pragma unroll
            for (int j2 = 0; j2 < 8; ++j2) { float a = 0.f;
#pragma unroll
                for (int jj = 0; jj < 4; ++jj) a += (v[jj].x * wf[j2][jj * 4 + 0] + v[jj].y * wf[j2][jj * 4 + 1]) + (v[jj].z * wf[j2][jj * 4 + 2] + v[jj].w * wf[j2][jj * 4 + 3]);
                a = wave_sum(a); mine = (lane == j2) ? a : mine; }
            if (lane < 8) { const float fl = mine * rstd + bfl; const float lf = fminf(fl, 0.f) - log1pf(expf(-fabsf(fl)));
                F.LOGF[((size_t)(row / SEQ) * 8 + lane) * SEQ + (row % SEQ)] = lf * LOG2E; }
        }
    }
}
__device__ __forceinline__ void cumsum_seq(Frame& F, int bh) {
    const int tid = F.tid, lane = F.lane;
    const f32x4* src = (const f32x4*)(F.LOGF + (size_t)bh * SEQ + tid * 16);
    f32x4 q[4];
#pragma unroll
    for (int i = 0; i < 4; ++i) q[i] = src[i];
    float run = 0.f;
#pragma unroll
    for (int i = 0; i < 4; ++i) { q[i].x += run; q[i].y += q[i].x; q[i].z += q[i].y; q[i].w += q[i].z; run = q[i].w; }
    float incl = run;
#pragma unroll
    for (int o = 1; o < 64; o <<= 1) { const float t = __shfl_up(incl, o); if (lane >= o) incl += t; }
    LAS float* sc = (LAS float*)F.lds;
    __syncthreads();
    if (lane == 63) sc[F.wave] = incl;
    __syncthreads();
    float woff = 0.f;
#pragma unroll
    for (int w = 0; w < NWAVES; ++w) woff += (w < F.wave) ? sc[w] : 0.f;
    const float off = woff + (incl - run);
    f32x4* dst = (f32x4*)(F.CUM + (size_t)bh * SEQ + tid * 16);
#pragma unroll
    for (int i = 0; i < 4; ++i) dst[i] = q[i] + off;
    __syncthreads();
}
__device__ __forceinline__ void xa_kv_finalize(Frame& F, int item) {
    const int tid = F.tid, l = item >> 4, b = (item >> 2) & 3, h = item & 3;
    const int kvr = tid >> 1, half = tid & 1;
    const bf16* kp = F.KVRAW + (size_t)l * MROWS * D + (size_t)(b * NMEM + kvr) * D + h * 128 + 64 * half;
    const size_t obase = (size_t)((l * 4 + b) * 4 + h) * (NMEM * 128);
    bf16x8 x[8]; float ss = 0.f;
#pragma unroll
    for (int i = 0; i < 8; ++i) { x[i] = *(const GAS bf16x8*)(kp + 8 * i);
#pragma unroll
        for (int e = 0; e < 8; ++e) { const float f = bf2f(x[i][e]); ss += f * f; } }
    ss += __shfl_xor(ss, 1);
    const float rstd = rsq(ss * (1.f / 128.f) + EPS);
    const float* gk = F.in[9] + l * 128 + 64 * half;
    bf16* ko = F.KN + obase + (size_t)kvr * 128 + 64 * half;
#pragma unroll
    for (int i = 0; i < 8; ++i) { v4u o;
        o.x = pk2(bf2f(x[i][0]) * rstd * gk[8 * i + 0], bf2f(x[i][1]) * rstd * gk[8 * i + 1]); o.y = pk2(bf2f(x[i][2]) * rstd * gk[8 * i + 2], bf2f(x[i][3]) * rstd * gk[8 * i + 3]);
        o.z = pk2(bf2f(x[i][4]) * rstd * gk[8 * i + 4], bf2f(x[i][5]) * rstd * gk[8 * i + 5]); o.w = pk2(bf2f(x[i][6]) * rstd * gk[8 * i + 6], bf2f(x[i][7]) * rstd * gk[8 * i + 7]);
        *(GAS v4u*)(ko + 8 * i) = o; }
    const bf16* vp = kp + XAW;
    const int pk = (kvr & ~12) | ((kvr & 4) << 1) | ((kvr & 8) >> 1);
    bf16* vo = F.VT + obase + pk;
#pragma unroll
    for (int i = 0; i < 8; ++i) { const bf16x8 v = *(const GAS bf16x8*)(vp + 8 * i);
#pragma unroll
        for (int e = 0; e < 8; ++e) vo[(size_t)(64 * half + 8 * i + e) * NMEM] = (bf16)(unsigned short)v[e]; }
}
__device__ __forceinline__ void gmlp_unit(Frame& F, int blk, int g) {
    const int tid = F.tid, lane = F.lane, wid = F.wave, r32 = lane & 31, hi = lane >> 5;
    LAS unsigned char* vT = F.lds;
    const int r0 = blk * 128;
    const bf16* Z = F.BIG;
    __syncthreads();
    { const int row = tid >> 2, q = tid & 3;
      const bf16* vp = Z + (size_t)(r0 + row) * N_IN0 + 512 + g * 128 + 32 * q;
      bf16x8 x[4]; float ss = 0.f;
#pragma unroll
      for (int i = 0; i < 4; ++i) { x[i] = *(const GAS bf16x8*)(vp + 8 * i);
#pragma unroll
          for (int e = 0; e < 8; ++e) { const float f = bf2f(x[i][e]); ss += f * f; } }
      ss += __shfl_xor(ss, 1); ss += __shfl_xor(ss, 2);
      const float rstd = rsq(ss * (1.f / 128.f) + EPS);
      const float* gv = F.in[16] + g * 128 + 32 * q;
#pragma unroll
      for (int i = 0; i < 4; ++i)
#pragma unroll
          for (int e = 0; e < 8; ++e) { const int c = 32 * q + 8 * i + e; *(LAS unsigned short*)(vT + c * 272 + row * 2) = (unsigned short)f2bf(bf2f(x[i][e]) * rstd * gv[8 * i + e]); }
    }
    __syncthreads();
    const int tb = wid & 3, chh = wid >> 2;
    f32x16 acc[2]; acc[0] = f32x16{}; acc[1] = f32x16{};
    const bf16* Wg = F.WSP + (size_t)g * 128 * 128 + (size_t)(32 * tb + r32) * 128 + 8 * hi;
#pragma unroll
    for (int ks = 0; ks < 8; ++ks) { const bf16x8 bfr = *(const GAS bf16x8*)(Wg + 16 * ks);
#pragma unroll
        for (int c2 = 0; c2 < 2; ++c2) { const bf16x8 a = *(const LAS bf16x8*)(vT + (32 * (2 * chh + c2) + r32) * 272 + (16 * ks + 8 * hi) * 2);
            acc[c2] = __builtin_amdgcn_mfma_f32_32x32x16_bf16(a, bfr, acc[c2], 0, 0, 0); } }
    const int t = 32 * tb + r32; const float bs = F.in[18][g * 128 + t];
    const bf16* up = Z + (size_t)(r0 + t) * N_IN0 + g * 128; bf16* yp = F.Y + (size_t)(r0 + t) * D + g * 128;
#pragma unroll
    for (int c2 = 0; c2 < 2; ++c2)
#pragma unroll
        for (int g4 = 0; g4 < 4; ++g4) { const int c0 = 32 * (2 * chh + c2) + 8 * g4 + 4 * hi; const u32x2 u = *(const GAS u32x2*)(up + c0);
            u32x2 o; o.x = pk2(bfu2f(u.x & 0xffffu) * (acc[c2][4 * g4 + 0] + bs), bfu2f(u.x >> 16) * (acc[c2][4 * g4 + 1] + bs));
            o.y = pk2(bfu2f(u.y & 0xffffu) * (acc[c2][4 * g4 + 2] + bs), bfu2f(u.y >> 16) * (acc[c2][4 * g4 + 3] + bs));
            *(GAS u32x2*)(yp + c0) = o; }
}
__device__ __forceinline__ void mix1_phase(Frame& F) {
    const bf16* Z = F.BIG;
    const int tid = F.tid;
    for (int it = F.vcu; it < T / 128; it += F.G) {
        const int rc = it * 4 + (tid >> 7), cc = tid & 127, t0 = rc * 32, pos0 = t0 % SEQ;
        if (cc < 64) {
            const int w = 2 << (cc >> 4); const bf16* zp = Z + (size_t)t0 * N_IN1 + 8 * cc; bf16* yp = F.Y + (size_t)t0 * D + 8 * cc;
            float s[8];
#pragma unroll
            for (int e = 0; e < 8; ++e) s[e] = 0.f;
            for (int j = 1; j < w; ++j) if (pos0 - j >= 0) { const bf16x8 z = *(const GAS bf16x8*)(zp - (size_t)j * N_IN1);
#pragma unroll
                for (int e = 0; e < 8; ++e) s[e] += bf2f(z[e]); }
            for (int i = 0; i < 32; ++i) { const int pos = pos0 + i; const bf16x8 z = *(const GAS bf16x8*)(zp + (size_t)i * N_IN1);
                float zf[8];
#pragma unroll
                for (int e = 0; e < 8; ++e) { zf[e] = bf2f(z[e]); s[e] += zf[e]; }
                const float inv = 1.0f / (float)((pos + 1 < w) ? pos + 1 : w);
                v4u o; o.x = pk2(s[0] * inv - zf[0], s[1] * inv - zf[1]); o.y = pk2(s[2] * inv - zf[2], s[3] * inv - zf[3]); o.z = pk2(s[4] * inv - zf[4], s[5] * inv - zf[5]); o.w = pk2(s[6] * inv - zf[6], s[7] * inv - zf[7]);
                *(GAS v4u*)(yp + (size_t)i * D) = o;
                if (pos + 1 >= w) { const bf16x8 zo = *(const GAS bf16x8*)(zp + (long)(i - w + 1) * N_IN1);
#pragma unroll
                    for (int e = 0; e < 8; ++e) s[e] -= bf2f(zo[e]); } }
        } else {
            const int c8 = (cc - 64) * 8; const bf16* hp = Z + (size_t)t0 * N_IN1 + 512 + c8; bf16* yp = F.Y + (size_t)t0 * D + 512 + c8;
            const float* cw = F.in[25];
            float w0[8], w1[8], w2[8], x1[8], x2[8];
#pragma unroll
            for (int e = 0; e < 8; ++e) { w0[e] = cw[c8 + e]; w1[e] = cw[512 + c8 + e]; w2[e] = cw[1024 + c8 + e]; x1[e] = 0.f; x2[e] = 0.f; }
            if (pos0 >= 2) { const bf16x8 h2 = *(const GAS bf16x8*)(hp - 2 * (size_t)N_IN1), c2 = *(const GAS bf16x8*)(hp - 2 * (size_t)N_IN1 + 1024), h1 = *(const GAS bf16x8*)(hp - (size_t)N_IN1), c1 = *(const GAS bf16x8*)(hp - (size_t)N_IN1 + 1024);
#pragma unroll
                for (int e = 0; e < 8; ++e) { x2[e] = bf2f(h2[e]) * bf2f(c2[e]); x1[e] = bf2f(h1[e]) * bf2f(c1[e]); } }
            for (int i = 0; i < 32; ++i) { const bf16* p = hp + (size_t)i * N_IN1; const bf16x8 hv = *(const GAS bf16x8*)p, gb = *(const GAS bf16x8*)(p + 512), gc = *(const GAS bf16x8*)(p + 1024);
                float y[8];
#pragma unroll
                for (int e = 0; e < 8; ++e) { const float x0 = bf2f(gc[e]) * bf2f(hv[e]); y[e] = bf2f(gb[e]) * (w0[e] * x2[e] + w1[e] * x1[e] + w2[e] * x0); x2[e] = x1[e]; x1[e] = x0; }
                v4u o; o.x = pk2(y[0], y[1]); o.y = pk2(y[2], y[3]); o.z = pk2(y[4], y[5]); o.w = pk2(y[6], y[7]);
                *(GAS v4u*)(yp + (size_t)i * D) = o; }
        }
    }
}
__device__ __forceinline__ void xa_attn_unit(Frame& F, int l, int pm, int pn) {
    const int tid = F.tid, lane = F.lane, wid = F.wave, r32 = lane & 31, hi = lane >> 5;
    const int b = pm / (SEQ / 256);
    LAS unsigned char* Kl = F.lds; LAS unsigned char* Vl = F.lds + XA_KBYTES;
    const size_t q = (size_t)pm * 256 + wid * 32 + r32;
    for (int hh = 0; hh < 2; ++hh) {
        const int h = 2 * pn + hh;
        const bf16* Kg = F.KN + (size_t)((l * 4 + b) * 4 + h) * (NMEM * 128);
        const bf16* Vg = F.VT + (size_t)((l * 4 + b) * 4 + h) * (NMEM * 128);
        __syncthreads();
#pragma unroll
        for (int i = 0; i < 8; ++i) { const int id = tid + 512 * i, row = id >> 4, ch = id & 15; const v4u x = *(const GAS v4u*)(Kg + row * 128 + ch * 8); *(LAS v4u*)(Kl + row * XA_KROW + ch * 16) = x; }
#pragma unroll
        for (int i = 0; i < 8; ++i) { const int id = tid + 512 * i, row = id >> 5, ch = id & 31; const v4u x = *(const GAS v4u*)(Vg + row * 256 + ch * 8); *(LAS v4u*)(Vl + row * XA_VROW + ch * 16) = x; }
        __syncthreads();
        const bf16* Qp = F.XQ + q * XAW + h * 128 + 8 * hi;
        bf16x8 qf[8]; float ss = 0.f;
#pragma unroll
        for (int ks = 0; ks < 8; ++ks) { qf[ks] = *(const GAS bf16x8*)(Qp + 16 * ks);
#pragma unroll
            for (int e = 0; e < 8; ++e) { const float f = bf2f(qf[ks][e]); ss += f * f; } }
        ss += __shfl_xor(ss, 32);
        const float sc = rsq(ss * (1.f / 128.f) + EPS) * XA_C2;
        const float* gq = F.in[8] + l * 128 + 8 * hi;
#pragma unroll
        for (int ks = 0; ks < 8; ++ks) { const f32x4 ga = *(const f32x4*)(gq + 16 * ks), gb = *(const f32x4*)(gq + 16 * ks + 4);
            v4u w; w.x = pk2(bf2f(qf[ks][0]) * sc * ga.x, bf2f(qf[ks][1]) * sc * ga.y); w.y = pk2(bf2f(qf[ks][2]) * sc * ga.z, bf2f(qf[ks][3]) * sc * ga.w);
            w.z = pk2(bf2f(qf[ks][4]) * sc * gb.x, bf2f(qf[ks][5]) * sc * gb.y); w.w = pk2(bf2f(qf[ks][6]) * sc * gb.z, bf2f(qf[ks][7]) * sc * gb.w);
            qf[ks] = __builtin_bit_cast(bf16x8, w); }
        f32x16 s[8];
#pragma unroll
        for (int kvb = 0; kvb < 8; ++kvb) { s[kvb] = f32x16{};
#pragma unroll
            for (int ks = 0; ks < 8; ++ks) { const bf16x8 a = *(const LAS bf16x8*)(Kl + (32 * kvb + r32) * XA_KROW + (16 * ks + 8 * hi) * 2);
                s[kvb] = __builtin_amdgcn_mfma_f32_32x32x16_bf16(a, qf[ks], s[kvb], 0, 0, 0); }
            __builtin_amdgcn_sched_barrier(0); }
        float m = -INFINITY;
#pragma unroll
        for (int kvb = 0; kvb < 8; ++kvb)
#pragma unroll
            for (int r = 0; r < 16; ++r) m = fmaxf(m, s[kvb][r]);
        m = fmaxf(m, __shfl_xor(m, 32));
        float lsum = 0.f;
        bf16x8 pf[8][2];
#pragma unroll
        for (int kvb = 0; kvb < 8; ++kvb) {
#pragma unroll
            for (int r = 0; r < 16; ++r) { const float p = __builtin_amdgcn_exp2f(s[kvb][r] - m); s[kvb][r] = p; lsum += p; }
#pragma unroll
            for (int s2 = 0; s2 < 2; ++s2) { v4u w; w.x = pk2(s[kvb][8 * s2 + 0], s[kvb][8 * s2 + 1]); w.y = pk2(s[kvb][8 * s2 + 2], s[kvb][8 * s2 + 3]); w.z = pk2(s[kvb][8 * s2 + 4], s[kvb][8 * s2 + 5]); w.w = pk2(s[kvb][8 * s2 + 6], s[kvb][8 * s2 + 7]);
                pf[kvb][s2] = __builtin_bit_cast(bf16x8, w); } }
        lsum += __shfl_xor(lsum, 32);
        f32x16 o[4];
#pragma unroll
        for (int db = 0; db < 4; ++db) { o[db] = f32x16{};
#pragma unroll
            for (int kvb = 0; kvb < 8; ++kvb)
#pragma unroll
                for (int s2 = 0; s2 < 2; ++s2) { const bf16x8 a = *(const LAS bf16x8*)(Vl + (32 * db + r32) * XA_VROW + (32 * kvb + 16 * s2 + 8 * hi) * 2);
                    o[db] = __builtin_amdgcn_mfma_f32_32x32x16_bf16(a, pf[kvb][s2], o[db], 0, 0, 0); }
            __builtin_amdgcn_sched_barrier(0); }
        const float inv = 1.0f / lsum;
        bf16* Op = F.XO + q * XAW + h * 128;
#pragma unroll
        for (int db = 0; db < 4; ++db)
#pragma unroll
            for (int g4 = 0; g4 < 4; ++g4) { const int d0 = 32 * db + 8 * g4 + 4 * hi; u32x2 w; w.x = pk2(o[db][4 * g4 + 0] * inv, o[db][4 * g4 + 1] * inv); w.y = pk2(o[db][4 * g4 + 2] * inv, o[db][4 * g4 + 3] * inv);
                *(GAS u32x2*)(Op + d0) = w; }
    }
}

struct Args { cfp_t in[27]; float* out; unsigned char* ws; int ph_lo, ph_hi, li, pad; };
#define MKFRAME() do { int t_; asm volatile("v_mbcnt_lo_u32_b32 %0, -1, 0\n\tv_mbcnt_hi_u32_b32 %0, -1, %0\n\tv_lshl_add_u32 %0, %1, 6, %0" : "=&v"(t_) : "s"(wave_s));     \
    const __attribute__((address_space(4))) Args* ap_ = (const __attribute__((address_space(4))) Args*)__builtin_amdgcn_kernarg_segment_ptr(); asm volatile("" : "+s"(ap_)); unsigned char* ws_ = ap_->ws; \
    F.lds = (LAS unsigned char*)lds; F.MISC = (volatile LAS unsigned*)(F.lds + MISC_OFF); \
    F.tid = t_; F.lane = F.tid & 63; F.wave = __builtin_amdgcn_readfirstlane(F.tid >> 6); \
    F.G = gridDim.x; { const int bx = blockIdx.x; F.vcu = (F.G % 8 == 0) ? (bx % 8) * (F.G / 8) + bx / 8 : bx; } \
    F.ws = ws_; F.in = ap_->in; F.x = ap_->in[0]; F.out = ap_->out; F.ctl = (gu32*)(ws_ + WS_CTL); \
    F.XB = (bf16*)(ws_ + WS_XB); F.Y = (bf16*)(ws_ + WS_Y); F.XQ = (bf16*)(ws_ + WS_XQ); F.XO = (bf16*)(ws_ + WS_XO); F.BIG = (bf16*)(ws_ + WS_BIG); \
    F.MEMN = (bf16*)(ws_ + WS_MEMN); F.KVRAW = (bf16*)(ws_ + WS_KVRAW); F.KN = (bf16*)(ws_ + WS_KN); F.VT = (bf16*)(ws_ + WS_VT); F.WSP = (bf16*)(ws_ + WS_WSP); \
    F.LOGF = (float*)(ws_ + WS_LOGF); F.CUM = (float*)(ws_ + WS_CUM); F.SSQ = (float*)(ws_ + WS_SSQ); } while (0)
#define GRID_BAR() do { if (N_LAUNCHES == 1) { XcdBarrier b_; b_.bar = (unsigned*)(F.ctl + CW_BAR); b_.x = xb_xcc_id(); b_.st = F.MISC + 8; xcd_barrier(b_, F.tid); } } while (0)
#define IN(k) (lo <= (k) && (k) < hi)
#define BOTH(k) (IN(k) && IN((k) + 1))
template <int l> __device__ __forceinline__ void layer_phases(const int lo, const int hi, const int wave_s) {
    extern __shared__ __attribute__((aligned(16))) unsigned char lds[];
    Frame F; unsigned char* ws;
        const int pb = (l == 0) ? PH_IN0 : PH_IN1;
        if (IN(pb)) { MKFRAME(); ws = F.ws;
            if (l == 0) {
                if (blockIdx.x < 32) cumsum_seq(F, blockIdx.x);
                { pg8::Gemm g{F.XB, (const bf16*)(ws + WS_WIN0), T, N_IN0, D}; pg8::StaticOrder S; S.init(T, N_IN0, F.G, (int)blockIdx.x);
                  pg8::EpiIn0 E{F.BIG, N_IN0, F.SSQ, F.in[19], F.in[20], FOX_C2};
                  pg8::gemm_phase<pg8::EpiIn0, pg8::StaticOrder, PG8_ALIGN, PG8_SP2>(F.lds + RING_OFF, g, S, E, F.tid); }
#pragma unroll 1
                for (int l2 = 0; l2 < 2; ++l2) {
                    pg8::Gemm g{F.MEMN, lw(F, l2, L_WKV), MROWS, D, D}; pg8::StaticOrder S; S.init(MROWS, D, F.G, (int)((blockIdx.x + F.G - 16 * l2) % F.G));
                    pg8::EpiPlain E{F.KVRAW + (size_t)l2 * MROWS * D, D, nullptr};
                    pg8::gemm_phase<pg8::EpiPlain, pg8::StaticOrder, PG8_ALIGN, PG8_SP2>(F.lds + RING_OFF, g, S, E, F.tid); }
            } else {
                pg8::Gemm g{F.XB, (const bf16*)(ws + WS_WIN1), T, N_IN1, D}; pg8::StaticOrder S; S.init(T, N_IN1, F.G, (int)blockIdx.x);
                pg8::EpiPlain E{F.BIG, N_IN1, F.SSQ};
                pg8::gemm_phase<pg8::EpiPlain, pg8::StaticOrder, PG8_ALIGN, PG8_SP2>(F.lds + RING_OFF, g, S, E, F.tid);
            }
            if (BOTH(pb)) GRID_BAR();
        }
        if (IN(pb + 1)) { MKFRAME(); ws = F.ws;
            if (l == 0) {
                if (blockIdx.x < 32) xa_kv_finalize(F, blockIdx.x);
                for (int u = F.vcu; u < (T / 128) * 4; u += F.G) gmlp_unit(F, u >> 2, u & 3);
                __syncthreads();
                const attn_body::AttnTensors AT{(const attn_body::bf16*)(F.BIG + 1024), (const attn_body::bf16*)(F.BIG + 1536), (const attn_body::bf16*)(F.BIG + 2048), (attn_body::bf16*)(F.Y + 512), F.CUM};
                const attn_body::StaticOrder S((int)F.G, (int)blockIdx.x);
                attn_body::attn_phase<attn_body::StaticOrder>((char*)lds + RING_OFF, AT, S, F.tid);
            } else {
                mix1_phase(F);
            }
            if (BOTH(pb + 1)) GRID_BAR();
        }
        if (IN(pb + 2)) { MKFRAME(); ws = F.ws;
            pg8::Gemm g{F.Y, (const bf16*)(ws + (l == 0 ? WS_WOUT0 : WS_WOUT1)), T, D, D}; pg8::StaticOrder S; S.init(T, D, F.G, (int)blockIdx.x);
            pg8::EpiRes E{l == 0 ? F.x : F.out, F.out, F.XB, F.SSQ, D};
            pg8::gemm_phase<pg8::EpiRes, pg8::StaticOrder, PG8_ALIGN, PG8_SP2>(F.lds + RING_OFF, g, S, E, F.tid);
            if (BOTH(pb + 2)) GRID_BAR();
        }
        if (IN(pb + 3)) { MKFRAME(); ws = F.ws;
            pg8::Gemm g{F.XB, lw(F, l, L_WQ), T, XAW, D}; pg8::StaticOrder S; S.init(T, XAW, F.G, (int)blockIdx.x);
            pg8::EpiPlain E{F.XQ, XAW, F.SSQ};
            pg8::gemm_phase<pg8::EpiPlain, pg8::StaticOrder, PG8_ALIGN, PG8_SP2>(F.lds + RING_OFF, g, S, E, F.tid);
            VM_WAIT(); __syncthreads();
            __builtin_amdgcn_fence(__ATOMIC_ACQUIRE, "agent"); VM_WAIT(); __syncthreads();
            pg8::Unit u;
            for (int i = 0; S.next(i, u); ++i) xa_attn_unit(F, l, u.pm, u.pn);
            if (BOTH(pb + 3)) GRID_BAR();
        }
        if (IN(pb + 4)) { MKFRAME(); ws = F.ws;
            pg8::Gemm g{F.XO, lw(F, l, L_WO), T, D, XAW}; pg8::StaticOrder S; S.init(T, D, F.G, (int)blockIdx.x);
            pg8::EpiRes E{F.out, F.out, F.XB, F.SSQ, D};
            pg8::gemm_phase<pg8::EpiRes, pg8::StaticOrder, PG8_ALIGN, PG8_SP2>(F.lds + RING_OFF, g, S, E, F.tid);
            if (BOTH(pb + 4)) GRID_BAR();
        }
        if (IN(pb + 5)) { MKFRAME(); ws = F.ws;
            pg8::Gemm g{F.XB, lw(F, l, L_WGU), T, 2 * DFF, D}; pg8::StaticOrder S; S.init(T, 2 * DFF, F.G, (int)blockIdx.x);
            pg8::EpiSwiglu E{F.BIG, DFF, F.SSQ};
            pg8::gemm_phase<pg8::EpiSwiglu, pg8::StaticOrder, PG8_ALIGN, PG8_SP2>(F.lds + RING_OFF, g, S, E, F.tid);
            if (BOTH(pb + 5)) GRID_BAR();
        }
        if (IN(pb + 6)) { MKFRAME(); ws = F.ws;
            pg8::Gemm g{F.BIG, lw(F, l, L_WD), T, D, DFF}; pg8::StaticOrder S; S.init(T, D, F.G, (int)blockIdx.x);
            pg8::EpiRes E{F.out, F.out, l == 0 ? F.XB : nullptr, F.SSQ, D};
            pg8::gemm_phase<pg8::EpiRes, pg8::StaticOrder, PG8_ALIGN, PG8_SP2>(F.lds + RING_OFF, g, S, E, F.tid);
            if (BOTH(pb + 6)) GRID_BAR();
        }
    }
__global__ void __launch_bounds__(NWAVES * 64, 2) mk_fwd(Args args) {
    extern __shared__ __attribute__((aligned(16))) unsigned char lds[];
    int wave_s = __builtin_amdgcn_readfirstlane((int)threadIdx.x >> 6); asm volatile("" : "+s"(wave_s));
    Frame F;
    MKFRAME();
    for (int u = F.tid; u < (LDS_BYTES - LDSCTL_OFF) / 4; u += NWAVES * 64) ((LAS unsigned*)(F.lds + LDSCTL_OFF))[u] = 0u;
    __syncthreads();
    if (N_LAUNCHES == 1) (void)xcd_barrier_post((unsigned*)(F.ctl + CW_BAR), F.MISC + 8, F.tid);
    const int lo = args.ph_lo, hi = args.ph_hi;
    if (IN(PH_PRO)) { MKFRAME(); p0_prologue(F); if (BOTH(PH_PRO)) GRID_BAR(); }
    layer_phases<0>(lo, hi, wave_s);
    layer_phases<1>(lo, hi, wave_s);
}
#undef MKFRAME
#undef IN
#undef BOTH
#undef GRID_BAR

extern "C" void kernel_launch(void* const* d_in, const int* in_sizes, int n_in, void* d_out, int out_size, void* d_ws, size_t ws_size, hipStream_t stream) {
    static int grid = 0;
    if (grid == 0) {
        if (n_in != 27 || in_sizes[0] != T * D || out_size != T * D || ws_size < WS_END) { fprintf(stderr, "kernel_launch: built for 27 inputs, x and out of %d floats, >= %zu bytes of workspace; got n_in %d, in0 %d, out %d, ws %zu; nothing launched\n", T * D, (size_t)WS_END, n_in, n_in > 0 ? in_sizes[0] : -1, out_size, ws_size); grid = -1; return; }
        int dev = 0, cus = 0, per_cu = 0;
        if (hipGetDevice(&dev) != hipSuccess || hipDeviceGetAttribute(&cus, hipDeviceAttributeMultiprocessorCount, dev) != hipSuccess) { fprintf(stderr, "kernel_launch: hipGetDevice / hipDeviceGetAttribute failed; nothing launched\n"); grid = -1; return; }
        if (hipFuncSetAttribute((const void*)mk_fwd, hipFuncAttributeMaxDynamicSharedMemorySize, LDS_BYTES) != hipSuccess) { fprintf(stderr, "kernel_launch: hipFuncSetAttribute failed\n"); grid = -1; return; }
        if (hipOccupancyMaxActiveBlocksPerMultiprocessor(&per_cu, (const void*)mk_fwd, NWAVES * 64, LDS_BYTES) != hipSuccess || per_cu < 1)
            fprintf(stderr, "kernel_launch: note: the occupancy query reports %d workgroups per CU\n", per_cu);
        (void)hipGetLastError();
        grid = cus;
        if (grid != 256) fprintf(stderr, "kernel_launch: %d CUs; the attention schedule is built for 256\n", grid);
    }
    if (grid < 0) return;
    if (hipMemsetAsync((char*)d_ws + WS_CTL, 0, CTL_ZERO_BYTES, stream) != hipSuccess) { fprintf(stderr, "kernel_launch: hipMemsetAsync of the control words failed; nothing launched\n"); return; }
    Args a{};
    for (int i = 0; i < 27; ++i) a.in[i] = (const float*)d_in[i];
    a.out = (float*)d_out; a.ws = (unsigned char*)d_ws;
    for (int li = 0; li < N_LAUNCHES; ++li) {
        a.ph_lo = (N_LAUNCHES == 1) ? 0 : li; a.ph_hi = (N_LAUNCHES == 1) ? N_PHASES : li + 1; a.li = li;
        hipLaunchKernelGGL(mk_fwd, dim3(grid), dim3(NWAVES * 64), LDS_BYTES, stream, a);
        const hipError_t le = hipPeekAtLastError();
        if (le != hipSuccess) { fprintf(stderr, "kernel_launch: launch %d failed: %s\n", li, hipGetErrorName(le)); break; }
    }
}
```

```cpp
#include <hip/hip_runtime.h>
#include <cstdio>
#include <cstdint>
namespace pg8 {
#define PG8_LAS __attribute__((address_space(3)))
typedef unsigned short bf16_t;
typedef short bf16x8 __attribute__((ext_vector_type(8)));
typedef float f32x4 __attribute__((ext_vector_type(4)));
typedef float f32x2 __attribute__((ext_vector_type(2)));
typedef unsigned u32x4 __attribute__((ext_vector_type(4)));
typedef unsigned u32x2 __attribute__((ext_vector_type(2)));
typedef int i32x4 __attribute__((ext_vector_type(4)));
typedef int i32x8 __attribute__((ext_vector_type(8)));
constexpr int BM = 256, BK = 64, HALF = 128, HTB = HALF * BK * 2  , STAGE_BYTES = 8 * HTB, NXCD = 8, WGM = 8;

__host__ __device__ __forceinline__ int lds_byte(int r, int c) { const int st = (r >> 4) * 2 + (c >> 5), rr = r & 15, cc = c & 31, ob = rr * 64 + cc * 2; return st * 1024 + (ob ^ (((ob >> 9) & 1) << 5)); }
__host__ __device__ __forceinline__ void stage_rc(int b, int& R, int& C) { const int st = b / 1024, sb = b % 1024, swz = sb ^ (((sb >> 9) & 1) << 5); R = (st >> 1) * 16 + swz / 64; C = (st & 1) * 32 + (swz % 64) / 2; }
__host__ __device__ __forceinline__ int perm32(int rho) { const int n = rho >> 4, i = rho & 15; return 8 * (i >> 2) + 4 * n + (i & 3); }

struct Unit { int pm, pn; };
struct Gemm { const bf16_t* A; const bf16_t* Bt; int M, N, K; };

struct StaticOrder {
    int nM, nN, nwg, G, c;
    __host__ __device__ __forceinline__ void init(int M, int N, int G_, int c_) { nM = M / BM; nN = N / BM; nwg = nM * nN; G = G_; c = c_; }
    __host__ __device__ __forceinline__ bool next(int i, Unit& u) const {
        const long L = (long)i * G + c; if (L >= nwg) return false;
        int wgid = (int)L; { const int q = nwg / NXCD, r = nwg % NXCD, xcd = wgid % NXCD, off = wgid / NXCD; wgid = (xcd < r ? xcd * (q + 1) : r * (q + 1) + (xcd - r) * q) + off; }
        const int nig = WGM * nN, gid = wgid / nig, fm = gid * WGM, gsz = (nM - fm) < WGM ? (nM - fm) : WGM;
        u.pm = fm + ((wgid % nig) % gsz); u.pn = (wgid % nig) / gsz; return true;
    }
    __device__ __forceinline__ void a_ready(const Unit&) const {}
    __device__ __forceinline__ void done(const Unit&) const {}
};
struct OneUnit { Unit u;
    __device__ __forceinline__ bool next(int i, Unit& o) const { if (i != 0) return false; o = u; return true; }
    __device__ __forceinline__ void a_ready(const Unit&) const {}
    __device__ __forceinline__ void done(const Unit&) const {}
};

__device__ __forceinline__ unsigned cvt_pk_bf16(float lo, float hi) { unsigned r; asm volatile("v_cvt_pk_bf16_f32 %0, %1, %2" : "=v"(r) : "v"(lo), "v"(hi)); return r; }
__device__ __forceinline__ u32x4 pack8(const f32x4 a, const f32x4 b) { u32x4 w; w.x = cvt_pk_bf16(a[0], a[1]); w.y = cvt_pk_bf16(a[2], a[3]); w.z = cvt_pk_bf16(b[0], b[1]); w.w = cvt_pk_bf16(b[2], b[3]); return w; }
constexpr float RMS_EPS = 1e-6f;
__device__ __forceinline__ float row_rstd(const float* ssq, int row) {
    const f32x4* p = (const f32x4*)(ssq + (size_t)row * 16);
    const f32x4 a = p[0], b = p[1], c = p[2], d = p[3];
    const float s = (((a[0] + a[1]) + (a[2] + a[3])) + ((b[0] + b[1]) + (b[2] + b[3]))) + (((c[0] + c[1]) + (c[2] + c[3])) + ((d[0] + d[1]) + (d[2] + d[3])));
    return __builtin_amdgcn_rsqf(s * (1.0f / 1024.0f) + RMS_EPS);
}
struct RsTab { const PG8_LAS float* t;
    __device__ __forceinline__ int slot(int pm) const { int s = 0;
#pragma unroll
        for (int k = 1; k < 4; ++k) s = (__builtin_bit_cast(int, t[k]) == pm) ? k : s; return s; }
    __device__ __forceinline__ float get(int slot, int r) const { return t[16 + 256 * slot + r]; }
};
__device__ __forceinline__ void ssq4(f32x2& s2, const f32x4 x) { const f32x2 lo = {x[0], x[1]}, hi = {x[2], x[3]}; s2 += lo * lo; s2 += hi * hi; }
__device__ __forceinline__ float sigmoid_fast(float t) { return __builtin_amdgcn_rcpf(1.0f + __builtin_amdgcn_exp2f(-1.4426950408889634f * t)); }
__device__ __forceinline__ float gelu_tanh(float x) { const float t = 1.5957691216057308f * (x + 0.044715f * x * x * x); return x * sigmoid_fast(t); }
__device__ __forceinline__ float silu_f(float x) { return x * sigmoid_fast(x); }

struct EpiPlain {
    static constexpr bool PERM = true, AFTER_DRAIN = false, F8 = false; static constexpr int NVM = 16;
    bf16_t* O; int ldc; const PG8_LAS float* rst;
    __device__ __forceinline__ void operator()(const f32x4 (&acc)[2][2][4][2], const Unit& u, int wr, int wc, int fr, int fq) const {
        const int row0 = u.pm * BM + wr * 64 + fr, col0 = u.pn * BM + wc * 32 + 8 * fq;
        const RsTab R{rst}; const int rsl = rst ? R.slot(u.pm) : 0;
#pragma unroll
        for (int ai = 0; ai < 2; ++ai)
#pragma unroll
            for (int m = 0; m < 4; ++m) { const int row = row0 + ai * HALF + m * 16; const float rs = rst ? R.get(rsl, ai * HALF + wr * 64 + m * 16 + fr) : 1.0f; bf16_t* rowp = O + (size_t)row * ldc + col0;
#pragma unroll
                for (int bj = 0; bj < 2; ++bj) *(u32x4*)(rowp + bj * HALF) = pack8(acc[ai][bj][m][0] * rs, acc[ai][bj][m][1] * rs); }
    }
};
struct EpiIn0 {
    static constexpr bool PERM = true, AFTER_DRAIN = false, F8 = false; static constexpr int NVM = 16;
    bf16_t* O; int ldc; const PG8_LAS float* rst; const float* gq; const float* gk; float qscale;
    __device__ __forceinline__ void operator()(const f32x4 (&acc)[2][2][4][2], const Unit& u, int wr, int wc, int fr, int fq) const {
        const int row0 = u.pm * BM + wr * 64 + fr; const int pn = u.pn;
        const bool headed = (pn >= 4 && pn < 8);
        const RsTab R{rst}; const int rsl = R.slot(u.pm);
        f32x4 gn[2][2];
#pragma unroll
        for (int bj = 0; bj < 2; ++bj)
#pragma unroll
            for (int n = 0; n < 2; ++n) { gn[bj][n] = (f32x4){1.f, 1.f, 1.f, 1.f};
                if (pn == 4 || pn == 5) { const int d = 32 * bj + 8 * fq + 4 * n; const f32x4 a = *(const f32x4*)(gq + d), b = *(const f32x4*)(gk + d); gn[bj][n] = a * b * qscale; } }
#pragma unroll
        for (int ai = 0; ai < 2; ++ai)
#pragma unroll
            for (int m = 0; m < 4; ++m) { const int row = row0 + ai * HALF + m * 16; const float rs = R.get(rsl, ai * HALF + wr * 64 + m * 16 + fr);
                f32x4 v[2][2];
#pragma unroll
                for (int bj = 0; bj < 2; ++bj)
#pragma unroll
                    for (int n = 0; n < 2; ++n) v[bj][n] = acc[ai][bj][m][n] * rs;
                if (pn < 4) {
#pragma unroll
                    for (int bj = 0; bj < 2; ++bj)
#pragma unroll
                        for (int n = 0; n < 2; ++n) { const f32x4 x = v[bj][n]; const f32x4 in = (x * x) * 0.044715f + 1.0f; const f32x4 tt = (x * in) * (-1.5957691216057308f * 1.4426950408889634f);
                            f32x4 ex;
#pragma unroll
                            for (int e = 0; e < 4; ++e) ex[e] = __builtin_amdgcn_exp2f(tt[e]);
                            const f32x4 d = ex + 1.0f; f32x4 r;
#pragma unroll
                            for (int e = 0; e < 4; ++e) r[e] = __builtin_amdgcn_rcpf(d[e]);
                            v[bj][n] = x * r; }
                } else if (headed) {
                    f32x2 s2 = {0.f, 0.f};
#pragma unroll
                    for (int bj = 0; bj < 2; ++bj)
#pragma unroll
                        for (int n = 0; n < 2; ++n) ssq4(s2, v[bj][n]);
                    float ss = s2[0] + s2[1];
                    ss += __shfl_xor(ss, 16); ss += __shfl_xor(ss, 32);
                    const float r = __builtin_amdgcn_rsqf(ss * (1.0f / 64.0f) + RMS_EPS);
#pragma unroll
                    for (int bj = 0; bj < 2; ++bj)
#pragma unroll
                        for (int n = 0; n < 2; ++n) v[bj][n] = v[bj][n] * r * gn[bj][n];
                }
                bf16_t* rowp = O + (size_t)row * ldc + pn * BM + 8 * fq;
#pragma unroll
                for (int bj = 0; bj < 2; ++bj) { const int c = headed ? (64 * wc + 32 * bj) : (128 * bj + 32 * wc); *(u32x4*)(rowp + c) = pack8(v[bj][0], v[bj][1]); } }
    }
};
struct EpiIn1 {
    static constexpr bool PERM = true, AFTER_DRAIN = false, F8 = false; static constexpr int NVM = 8;
    bf16_t* O; int ldc; const PG8_LAS float* rst;
    __device__ __forceinline__ void operator()(const f32x4 (&acc)[2][2][4][2], const Unit& u, int wr, int wc, int fr, int fq) const {
        const int row0 = u.pm * BM + wr * 64 + fr; const int pn = u.pn;
        const RsTab R{rst}; const int rsl = R.slot(u.pm);
        const bool pair = (pn >= 2 && pn < 6);
        const int cbase = pair ? 512 + 128 * (pn - 2) + wc * 32 + 8 * fq : (pn < 2 ? 256 * pn : 1024 + 256 * (pn - 6)) + wc * 32 + 8 * fq;
#pragma unroll
        for (int ai = 0; ai < 2; ++ai)
#pragma unroll
            for (int m = 0; m < 4; ++m) { const int row = row0 + ai * HALF + m * 16; const float rs = R.get(rsl, ai * HALF + wr * 64 + m * 16 + fr); bf16_t* rowp = O + (size_t)row * ldc + cbase;
                if (pair) { const float r2 = rs * rs; *(u32x4*)rowp = pack8(acc[ai][0][m][0] * acc[ai][1][m][0] * r2, acc[ai][0][m][1] * acc[ai][1][m][1] * r2); }
                else {
#pragma unroll
                    for (int bj = 0; bj < 2; ++bj) *(u32x4*)(rowp + bj * HALF) = pack8(acc[ai][bj][m][0] * rs, acc[ai][bj][m][1] * rs); } }
    }
};
__device__ __forceinline__ float clamp_f8(float v) { return __builtin_amdgcn_fmed3f(v, -448.0f, 448.0f); }
__device__ __forceinline__ unsigned pk4_f8(float a, float b, float c, float d) { int r = __builtin_amdgcn_cvt_pk_fp8_f32(clamp_f8(a), clamp_f8(b), 0, false); r = __builtin_amdgcn_cvt_pk_fp8_f32(clamp_f8(c), clamp_f8(d), r, true); return (unsigned)r; }
template <bool OUT8> struct EpiSwigluT {
    static constexpr bool PERM = true, AFTER_DRAIN = false, F8 = false; static constexpr int NVM = 8;
    bf16_t* O; int ldc; const PG8_LAS float* rst; float hscale;
    __device__ __forceinline__ void operator()(const f32x4 (&acc)[2][2][4][2], const Unit& u, int wr, int wc, int fr, int fq) const {
        const int row0 = u.pm * BM + wr * 64 + fr, col0 = u.pn * HALF + wc * 32 + 8 * fq;
        const RsTab R{rst}; const int rsl = R.slot(u.pm);
#pragma unroll
        for (int ai = 0; ai < 2; ++ai)
#pragma unroll
            for (int m = 0; m < 4; ++m) { const int row = row0 + ai * HALF + m * 16; const float rs = R.get(rsl, ai * HALF + wr * 64 + m * 16 + fr);
                const float c1 = -1.4426950408889634f * rs, rs2 = OUT8 ? rs * rs * hscale : rs * rs;
                f32x4 o[2];
#pragma unroll
                for (int n = 0; n < 2; ++n) { const f32x4 g = acc[ai][0][m][n], up = acc[ai][1][m][n];
                    const f32x4 t = g * c1; f32x4 ex;
#pragma unroll
                    for (int e = 0; e < 4; ++e) ex[e] = __builtin_amdgcn_exp2f(t[e]);
                    const f32x4 d = ex + 1.0f; f32x4 r;
#pragma unroll
                    for (int e = 0; e < 4; ++e) r[e] = __builtin_amdgcn_rcpf(d[e]);
                    o[n] = ((g * up) * rs2) * r; }
                if constexpr (OUT8) { u32x2 w; w.x = pk4_f8(o[0][0], o[0][1], o[0][2], o[0][3]); w.y = pk4_f8(o[1][0], o[1][1], o[1][2], o[1][3]);
                    __builtin_nontemporal_store(w, (u32x2*)((unsigned char*)O + (size_t)row * ldc + col0)); }
                else __builtin_nontemporal_store(pack8(o[0], o[1]), (u32x4*)(O + (size_t)row * ldc + col0)); }
    }
};
__device__ __forceinline__ f32x4 bf_lo4(const u32x4 w) { return (f32x4){__builtin_bit_cast(float, w.x << 16), __builtin_bit_cast(float, w.x & 0xffff0000u), __builtin_bit_cast(float, w.y << 16), __builtin_bit_cast(float, w.y & 0xffff0000u)}; }
__device__ __forceinline__ f32x4 bf_hi4(const u32x4 w) { return (f32x4){__builtin_bit_cast(float, w.z << 16), __builtin_bit_cast(float, w.z & 0xffff0000u), __builtin_bit_cast(float, w.w << 16), __builtin_bit_cast(float, w.w & 0xffff0000u)}; }
typedef __bf16 bf16x2_t __attribute__((ext_vector_type(2)));
__device__ __forceinline__ float dot2bf(unsigned w, float c) { const bf16x2_t v = __builtin_bit_cast(bf16x2_t, w); return __builtin_amdgcn_fdot2_f32_bf16(v, v, c, false); }
template <bool F8_> struct EpiResT {
    static constexpr bool PERM = true, AFTER_DRAIN = false, F8 = F8_; static constexpr int NVM = 16;
    const float* base32; bf16_t* xb; float* out32; float* ssq; int ldc; float ascale;
    __device__ __forceinline__ void operator()(const f32x4 (&acc)[2][2][4][2], const Unit& u, int wr, int wc, int fr, int fq) const {
        const int row0 = u.pm * BM + wr * 64 + fr, col0 = u.pn * BM + wc * 32 + 8 * fq;
        u32x4 pre[2][4][2];
        if (!base32) {
#pragma unroll
            for (int ai = 0; ai < 2; ++ai)
#pragma unroll
                for (int m = 0; m < 4; ++m)
#pragma unroll
                    for (int bj = 0; bj < 2; ++bj) pre[ai][m][bj] = *(const u32x4*)(xb + (size_t)(row0 + ai * HALF + m * 16) * ldc + col0 + bj * HALF);
        }
#pragma unroll
        for (int ai = 0; ai < 2; ++ai) {
#pragma unroll
            for (int m = 0; m < 4; ++m) { const int row = row0 + ai * HALF + m * 16; const size_t off = (size_t)row * ldc + col0;
                f32x4 v[2][2]; float ss = 0.f;
#pragma unroll
                for (int bj = 0; bj < 2; ++bj) {
                    f32x4 b0, b1;
                    if (base32) { b0 = *(const f32x4*)(base32 + off + bj * HALF); b1 = *(const f32x4*)(base32 + off + bj * HALF + 4); }
                    else { b0 = bf_lo4(pre[ai][m][bj]); b1 = bf_hi4(pre[ai][m][bj]); }
                    if constexpr (F8_) { v[bj][0] = b0 + acc[ai][bj][m][0] * ascale; v[bj][1] = b1 + acc[ai][bj][m][1] * ascale; } else { v[bj][0] = b0 + acc[ai][bj][m][0]; v[bj][1] = b1 + acc[ai][bj][m][1]; }
                }
                if (out32) {
#pragma unroll
                    for (int bj = 0; bj < 2; ++bj) { *(f32x4*)(out32 + off + bj * HALF) = v[bj][0]; *(f32x4*)(out32 + off + bj * HALF + 4) = v[bj][1]; }
                } else {
                    float sq = 0.f;
#pragma unroll
                    for (int bj = 0; bj < 2; ++bj) { const u32x4 w = pack8(v[bj][0], v[bj][1]); *(u32x4*)(xb + off + bj * HALF) = w;
                        sq = dot2bf(w.x, sq); sq = dot2bf(w.y, sq); sq = dot2bf(w.z, sq); sq = dot2bf(w.w, sq); }
                    ss = sq;
                    ss += __shfl_xor(ss, 16); ss += __shfl_xor(ss, 32);
                    if (fq == 0) ssq[(size_t)row * 16 + 4 * u.pn + wc] = ss; }
            }
            asm volatile("" ::: "memory");
        }
    }
};
using EpiRes = EpiResT<false>;

#ifndef PG8_ZOPAQUE
#define PG8_ZOPAQUE 1
#endif
#ifndef PG8_F8SCALE
#define PG8_F8SCALE 0
#endif
__device__ __forceinline__ i32x8 cat8(const bf16x8 a, const bf16x8 b) { const i32x4 x = __builtin_bit_cast(i32x4, a), y = __builtin_bit_cast(i32x4, b); return __builtin_shufflevector(x, y, 0, 1, 2, 3, 4, 5, 6, 7); }
template <class Epi, class Sched, bool ALIGN_EPI = false, bool SP2 = false>
__device__ __forceinline__ void gemm_phase(PG8_LAS unsigned char* lds, const Gemm g, const Sched& S, const Epi& E, const int tid_in, const int epi_reps = 1) {
    int tid_ = tid_in; asm volatile("" : "+v"(tid_));
    const int tid = tid_, wid = __builtin_amdgcn_readfirstlane(tid >> 6), lane = tid & 63, wr = wid >> 2, wc = wid & 3, fr = lane & 15, fq = lane >> 4;
    const int K = g.K, nt = K / BK;
    unsigned voffA[2], voffB[2];
#pragma unroll
    for (int i = 0; i < 2; ++i) { int R, C; stage_rc(tid * 16 + i * 8192, R, C); const int Rb = Epi::PERM ? ((R & ~31) + perm32(R & 31)) : R;
        voffA[i] = (unsigned)(R * K + C) * 2u; voffB[i] = (unsigned)(Rb * K + C) * 2u; }
    const size_t kstep = (size_t)(BK * 2);
    const size_t hstep = (size_t)HALF * K * 2;
    const size_t tstep = 2 * hstep;
    const unsigned ldsw = (unsigned)wid * 1024u;
    const unsigned ldsb = (unsigned)__builtin_amdgcn_readfirstlane((int)((unsigned)(uintptr_t)lds + ldsw));
    const int aoff = lds_byte(wr * 64 + fr, fq * 8), boff = lds_byte(wc * 32 + fr, fq * 8);
#define PG8_SA(b, h) (((b) * 2 + (h)) * HTB)
#define PG8_SB(b, h) ((4 + (b) * 2 + (h)) * HTB)
#define PG8_STAGE(bufoff, gbase, voff) do { _Pragma("unroll") for (int _i = 0; _i < 2; ++_i) { unsigned keep_; \
        asm volatile("s_nop 4\n\ts_mov_b32 %0, m0\n\ts_mov_b32 m0, %2\n\ts_nop 0\n\tglobal_load_lds_dwordx4 %1, %3\n\ts_mov_b32 m0, %0" : "=&s"(keep_) \
            : "v"((voff)[_i]), "s"(ldsb + (unsigned)((bufoff) + _i * 8192)), "s"((const char*)(gbase)) : "memory"); } } while (0)
#define PG8_LDA(dst, b, h) do { _Pragma("unroll") for (int m = 0; m < 4; ++m) _Pragma("unroll") for (int k = 0; k < 2; ++k) dst[m][k] = *(const PG8_LAS bf16x8*)(lds + PG8_SA(b, h) + aoff + m * 2048 + k * 1024); } while (0)
#define PG8_LDB(dst, b, h) do { _Pragma("unroll") for (int n = 0; n < 2; ++n) _Pragma("unroll") for (int k = 0; k < 2; ++k) dst[n][k] = *(const PG8_LAS bf16x8*)(lds + PG8_SB(b, h) + boff + n * 2048 + k * 1024); } while (0)
#define PG8_MMA(ai, bj, At, Bt) do { __builtin_amdgcn_s_setprio(1); _Pragma("unroll") for (int m = 0; m < 4; ++m) _Pragma("unroll") for (int n = 0; n < 2; ++n) { \
        if constexpr (Epi::F8) acc[ai][bj][m][n] = __builtin_amdgcn_mfma_scale_f32_16x16x128_f8f6f4(cat8(Bt[n][0], Bt[n][1]), cat8(At[m][0], At[m][1]), acc[ai][bj][m][n], 0, 0, 0, PG8_F8SCALE, 0, PG8_F8SCALE); \
        else { _Pragma("unroll") for (int k = 0; k < 2; ++k) acc[ai][bj][m][n] = __builtin_amdgcn_mfma_f32_16x16x32_bf16(Bt[n][k], At[m][k], acc[ai][bj][m][n], 0, 0, 0); } } __builtin_amdgcn_s_setprio(0); } while (0)
#define PG8_WAIT_V(n) asm volatile("s_waitcnt vmcnt(" #n ")" ::: "memory")
#define PG8_WAIT_L(n) asm volatile("s_waitcnt lgkmcnt(" #n ")" ::: "memory")
#define PG8_WAIT_VF() asm volatile("s_waitcnt vmcnt(%0)" :: "n"(8 + Epi::NVM) : "memory")
#define PG8_TRIP_SP2(W12) do { \
            PG8_LDB(B0, 0, 0); PG8_LDB(B1, 0, 1); PG8_SCHED; PG8_LDA(At, 0, 0); PG8_STAGE(PG8_SA(1, 1), a1 + hstep, voffA); \
            W12; PG8_WAIT_L(0); PG8_BAR; PG8_MMA(0, 0, At, B0); PG8_MMA(0, 1, At, B1); PG8_BAR; PG8_SCHED; \
            PG8_LDA(At, 0, 1); PG8_STAGE(PG8_SB(0, 0), b2, voffB); PG8_STAGE(PG8_SB(0, 1), b2 + hstep, voffB); PG8_STAGE(PG8_SA(0, 0), a2, voffA); \
            W12; PG8_WAIT_L(0); PG8_BAR; PG8_MMA(1, 0, At, B0); PG8_MMA(1, 1, At, B1); PG8_BAR; PG8_SCHED; \
            PG8_LDB(B0, 1, 0); PG8_LDB(B1, 1, 1); PG8_SCHED; PG8_LDA(At, 1, 0); PG8_STAGE(PG8_SA(0, 1), a2 + hstep, voffA); \
            PG8_WAIT_V(8); PG8_WAIT_L(0); PG8_BAR; PG8_MMA(0, 0, At, B0); PG8_MMA(0, 1, At, B1); PG8_BAR; PG8_SCHED; \
            PG8_LDA(At, 1, 1); PG8_STAGE(PG8_SB(1, 0), b3, voffB); PG8_STAGE(PG8_SB(1, 1), b3 + hstep, voffB); PG8_STAGE(PG8_SA(1, 0), a3, voffA); \
            PG8_WAIT_V(8); PG8_WAIT_L(0); PG8_BAR; PG8_MMA(1, 0, At, B0); PG8_MMA(1, 1, At, B1); PG8_BAR; PG8_SCHED; } while (0)
#define PG8_BAR __builtin_amdgcn_s_barrier()
#define PG8_SCHED __builtin_amdgcn_sched_barrier(0)
    Unit cur, nxt; int ui = 0;
    if (!S.next(0, cur)) return;
    f32x4 acc[2][2][4][2];
#pragma unroll
    for (int a = 0; a < 2; ++a)
#pragma unroll
        for (int b = 0; b < 2; ++b)
#pragma unroll
            for (int m = 0; m < 4; ++m)
#pragma unroll
                for (int n = 0; n < 2; ++n) acc[a][b][m][n] = (f32x4){0.f, 0.f, 0.f, 0.f};
    bf16x8 At[4][2], B0[2][2], B1[2][2];
    const char* cA = (const char*)g.A + (size_t)cur.pm * tstep; const char* cB = (const char*)g.Bt + (size_t)cur.pn * tstep;
    S.a_ready(cur);
    if constexpr (SP2) {
        PG8_STAGE(PG8_SB(0, 0), cB, voffB); PG8_STAGE(PG8_SB(0, 1), cB + hstep, voffB); PG8_STAGE(PG8_SA(0, 0), cA, voffA); PG8_STAGE(PG8_SA(0, 1), cA + hstep, voffA);
        if (wr == 1) PG8_BAR;
        PG8_WAIT_V(2); PG8_BAR;
        PG8_STAGE(PG8_SB(1, 0), cB + kstep, voffB); PG8_STAGE(PG8_SA(1, 0), cA + kstep, voffA); PG8_STAGE(PG8_SB(1, 1), cB + hstep + kstep, voffB);
        PG8_WAIT_V(6); PG8_BAR;
    } else {
        PG8_STAGE(PG8_SB(0, 0), cB, voffB); PG8_STAGE(PG8_SA(0, 0), cA, voffA); PG8_STAGE(PG8_SB(0, 1), cB + hstep, voffB); PG8_STAGE(PG8_SA(0, 1), cA + hstep, voffA);
        if (wr == 1) PG8_BAR;
        PG8_WAIT_V(4); PG8_BAR;
        PG8_STAGE(PG8_SB(1, 0), cB + kstep, voffB); PG8_STAGE(PG8_SA(1, 0), cA + kstep, voffA); PG8_STAGE(PG8_SB(1, 1), cB + hstep + kstep, voffB);
        PG8_WAIT_V(6); PG8_BAR;
    }
    for (;;) {
        const bool has_next = S.next(ui + 1, nxt);
        const char* nA = has_next ? (const char*)g.A + (size_t)nxt.pm * tstep : cA; const char* nB = has_next ? (const char*)g.Bt + (size_t)nxt.pn * tstep : cB;
        int t = 0;
        if constexpr (SP2) { if (ui > 0) {
            const char* a1 = cA + kstep; const char* a2 = cA + 2 * kstep; const char* b2 = cB + 2 * kstep; const char* a3 = a2 + kstep; const char* b3 = b2 + kstep;
            PG8_TRIP_SP2(PG8_WAIT_VF()); t = 2; } }
        for (; t < nt; t += 2) {
            const bool last = (t == nt - 2);
            const char* a1 = cA + (size_t)(t + 1) * kstep;
            const char* a2 = last ? nA : cA + (size_t)(t + 2) * kstep; const char* b2 = last ? nB : cB + (size_t)(t + 2) * kstep;
            const char* a3 = a2 + kstep; const char* b3 = b2 + kstep;
            if (last && has_next) S.a_ready(nxt);
            if constexpr (SP2) {
            PG8_LDB(B0, 0, 0); PG8_LDB(B1, 0, 1); PG8_SCHED; PG8_LDA(At, 0, 0); PG8_STAGE(PG8_SA(1, 1), a1 + hstep, voffA);
            PG8_WAIT_V(8); PG8_WAIT_L(0); PG8_BAR; PG8_MMA(0, 0, At, B0); PG8_MMA(0, 1, At, B1); PG8_BAR; PG8_SCHED;
            PG8_LDA(At, 0, 1); PG8_STAGE(PG8_SB(0, 0), b2, voffB); PG8_STAGE(PG8_SB(0, 1), b2 + hstep, voffB); PG8_STAGE(PG8_SA(0, 0), a2, voffA);
            PG8_WAIT_V(8); PG8_WAIT_L(0); PG8_BAR; PG8_MMA(1, 0, At, B0); PG8_MMA(1, 1, At, B1); PG8_BAR; PG8_SCHED;
            PG8_LDB(B0, 1, 0); PG8_LDB(B1, 1, 1); PG8_SCHED; PG8_LDA(At, 1, 0); PG8_STAGE(PG8_SA(0, 1), a2 + hstep, voffA);
            PG8_WAIT_V(8); PG8_WAIT_L(0); PG8_BAR; PG8_MMA(0, 0, At, B0); PG8_MMA(0, 1, At, B1); PG8_BAR; PG8_SCHED;
            PG8_LDA(At, 1, 1); PG8_STAGE(PG8_SB(1, 0), b3, voffB); PG8_STAGE(PG8_SB(1, 1), b3 + hstep, voffB); PG8_STAGE(PG8_SA(1, 0), a3, voffA);
            PG8_WAIT_V(8); PG8_WAIT_L(0); PG8_BAR; PG8_MMA(1, 0, At, B0); PG8_MMA(1, 1, At, B1); PG8_BAR; PG8_SCHED;
            } else {
            PG8_LDB(B0, 0, 0); PG8_SCHED; PG8_LDA(At, 0, 0); PG8_STAGE(PG8_SA(1, 1), a1 + hstep, voffA);
            PG8_WAIT_L(8); PG8_BAR; PG8_WAIT_L(0); PG8_MMA(0, 0, At, B0); PG8_BAR; PG8_SCHED;
            PG8_LDB(B1, 0, 1); PG8_STAGE(PG8_SB(0, 0), b2, voffB);
            PG8_BAR; PG8_WAIT_L(0); PG8_MMA(0, 1, At, B1); PG8_BAR;
            PG8_LDA(At, 0, 1); PG8_STAGE(PG8_SA(0, 0), a2, voffA);
            PG8_BAR; PG8_WAIT_L(0); PG8_MMA(1, 0, At, B0); PG8_BAR; PG8_SCHED;
            PG8_STAGE(PG8_SB(0, 1), b2 + hstep, voffB);
            PG8_WAIT_V(6); PG8_BAR; PG8_MMA(1, 1, At, B1); PG8_BAR;
            PG8_LDB(B0, 1, 0); PG8_SCHED; PG8_LDA(At, 1, 0); PG8_STAGE(PG8_SA(0, 1), a2 + hstep, voffA);
            PG8_WAIT_L(8); PG8_BAR; PG8_WAIT_L(0); PG8_MMA(0, 0, At, B0); PG8_BAR; PG8_SCHED;
            PG8_LDB(B1, 1, 1); PG8_STAGE(PG8_SB(1, 0), b3, voffB);
            PG8_BAR; PG8_WAIT_L(0); PG8_MMA(0, 1, At, B1); PG8_BAR;
            PG8_LDA(At, 1, 1); PG8_STAGE(PG8_SA(1, 0), a3, voffA);
            PG8_BAR; PG8_WAIT_L(0); PG8_MMA(1, 0, At, B0); PG8_BAR; PG8_SCHED;
            PG8_STAGE(PG8_SB(1, 1), b3 + hstep, voffB);
            PG8_WAIT_V(6); PG8_BAR; PG8_MMA(1, 1, At, B1); PG8_BAR;
            }
        }
        if constexpr (ALIGN_EPI) { if (wr == 0) PG8_BAR; }
        if constexpr (!Epi::AFTER_DRAIN) { int ln_; asm volatile("v_mbcnt_lo_u32_b32 %0, -1, 0\n\tv_mbcnt_hi_u32_b32 %0, -1, %0" : "=v"(ln_)); const int fr_ = ln_ & 15, fq_ = ln_ >> 4;
            for (int er_ = 0; er_ < epi_reps; ++er_) E(acc, cur, wr, wc, fr_, fq_); S.done(cur); }
        if (!has_next) break;
        { float z_ = 0.f; if (PG8_ZOPAQUE) asm volatile("" : "+v"(z_));
#pragma unroll
        for (int a = 0; a < 2; ++a)
#pragma unroll
            for (int b = 0; b < 2; ++b)
#pragma unroll
                for (int m = 0; m < 4; ++m)
#pragma unroll
                    for (int n = 0; n < 2; ++n) acc[a][b][m][n] = (f32x4){z_, z_, z_, z_}; }
        cur = nxt; cA = nA; cB = nB; ++ui;
        if constexpr (ALIGN_EPI) { if (wr == 1) PG8_BAR; }
    }
    PG8_WAIT_V(0);
    if constexpr (!ALIGN_EPI) { if (wr == 0) PG8_BAR; }
    PG8_BAR;
    if constexpr (Epi::AFTER_DRAIN) { E.fused(acc, cur, wr, wc, fr, fq, lds, wid, lane); S.done(cur); }
#undef PG8_SA
#undef PG8_SB
#undef PG8_STAGE
#undef PG8_LDA
#undef PG8_LDB
#undef PG8_MMA
#undef PG8_WAIT_V
#undef PG8_WAIT_L
#undef PG8_WAIT_VF
#undef PG8_TRIP_SP2
#undef PG8_BAR
#undef PG8_SCHED
}
}

#ifndef PG8_SP2
#define PG8_SP2 true
#endif
#ifndef PG8_ALIGN
#define PG8_ALIGN true
#endif
#include <hip/hip_bf16.h>
#include <cmath>
namespace attn_body {
using bf16=__hip_bfloat16;
using bf16x8=__attribute__((ext_vector_type(8)))short;
using s16x4=__attribute__((ext_vector_type(4)))short;
using f32x16=__attribute__((ext_vector_type(16)))float;
using u32x4=__attribute__((ext_vector_type(4)))unsigned;
constexpr int BATCH=4,NHEAD=8,SEQ=8192,D=64,PQ=2560,PO=1024;
constexpr int NW=8,QBLK=32,QB=QBLK*NW,KVBLK=64,NQB=SEQ/QB;
constexpr int ATTN_UNIT_ROWS=QB;
__device__ __forceinline__ int crow(int r,int hi){return (r&3)+8*(r>>2)+4*hi;}
#define SBAR() __builtin_amdgcn_sched_barrier(0)
__device__ __forceinline__ void cmask(f32x16&p0,f32x16&p1,int jb,int qrel,int hi){
  const float NEG=-INFINITY; int kb=64*jb+4*hi;
  #pragma unroll
  for(int r=0;r<16;++r){int kv=kb+(r&3)+8*(r>>2); if(kv>qrel)p0[r]=NEG; if(kv+32>qrel)p1[r]=NEG;}
}

constexpr int NSLOT=3, SLOTB=8192;
constexpr int LDS_K=0, LDS_V=NSLOT*SLOTB, LDS_WS=2*NSLOT*SLOTB, LDS_OST=LDS_WS+NW*64*4, LDS_CT=LDS_OST+NW*4096+2048, LDS_BYTES=LDS_CT+SEQ*4;
constexpr float C2=0.125f*1.4426950408889634f;
__device__ __forceinline__ void glds16(const void*sbase,unsigned voff,unsigned lds_dst){unsigned keep;
  asm volatile("s_nop 4\n\ts_mov_b32 %0, m0\n\ts_mov_b32 m0, %2\n\ts_nop 0\n\tglobal_load_lds_dwordx4 %1, %3\n\ts_mov_b32 m0, %0":"=&s"(keep):"v"(voff),"s"(lds_dst),"s"(sbase):"memory");}
__device__ __forceinline__ float max3f(float a,float b,float c){float r;asm("v_max3_f32 %0, %1, %2, %3":"=v"(r):"v"(a),"v"(b),"v"(c));return r;}
__device__ __forceinline__ float max2f(float a,float b){float r;asm("v_max_f32_e32 %0, %1, %2":"=v"(r):"v"(a),"v"(b));return r;}
__device__ __forceinline__ float fadd_s(float a,float b){float r;asm("v_add_f32_e32 %0, %1, %2":"=v"(r):"v"(a),"v"(b));return r;}
__device__ __forceinline__ float fsub_s(float a,float b){float r;asm("v_sub_f32_e32 %0, %1, %2":"=v"(r):"v"(a),"v"(b));return r;}
typedef float f32x2_t __attribute__((ext_vector_type(2))); typedef float f32x4_t __attribute__((ext_vector_type(4))); typedef __bf16 bf16x2_t __attribute__((ext_vector_type(2)));
__device__ __forceinline__ unsigned cvtpk_s(float lo,float hi){f32x2_t v={lo,hi};bf16x2_t b=__builtin_convertvector(v,bf16x2_t);return __builtin_bit_cast(unsigned,b);}
#define WAIT_BAR(N) asm volatile("s_waitcnt vmcnt(" #N ") lgkmcnt(0)\n\ts_barrier":::"memory")

__device__ __forceinline__ void qkt(f32x16&p0,f32x16&p1,const char*Kslot,const bf16x8*qr,const f32x16&negm,int r32,int hi){
  const char*kb=Kslot+hi*1024+r32*16;
  #pragma unroll
  for(int d0=0;d0<4;++d0){
    const bf16x8 b0=*reinterpret_cast<const bf16x8*>(kb+d0*2048);
    const bf16x8 b1=*reinterpret_cast<const bf16x8*>(kb+d0*2048+512);
    if(d0==0){p0=__builtin_amdgcn_mfma_f32_32x32x16_bf16(b0,qr[0],negm,0,0,0);p1=__builtin_amdgcn_mfma_f32_32x32x16_bf16(b1,qr[0],negm,0,0,0);}
    else{p0=__builtin_amdgcn_mfma_f32_32x32x16_bf16(b0,qr[d0],p0,0,0,0);p1=__builtin_amdgcn_mfma_f32_32x32x16_bf16(b1,qr[d0],p1,0,0,0);}}
}
typedef __attribute__((address_space(3))) const char* lds_cptr;
typedef short v4i16_t __attribute__((ext_vector_type(4)));
__device__ __forceinline__ void kload8(bf16x8*kf,lds_cptr kp){
  kf[0]=*(const __attribute__((address_space(3))) bf16x8*)(kp);      kf[1]=*(const __attribute__((address_space(3))) bf16x8*)(kp+512);
  kf[2]=*(const __attribute__((address_space(3))) bf16x8*)(kp+2048); kf[3]=*(const __attribute__((address_space(3))) bf16x8*)(kp+2560);
  kf[4]=*(const __attribute__((address_space(3))) bf16x8*)(kp+4096); kf[5]=*(const __attribute__((address_space(3))) bf16x8*)(kp+4608);
  kf[6]=*(const __attribute__((address_space(3))) bf16x8*)(kp+6144); kf[7]=*(const __attribute__((address_space(3))) bf16x8*)(kp+6656);
}
__device__ __forceinline__ void kload2(bf16x8*kf,lds_cptr kp,int j){ kf[2*j]=*(const __attribute__((address_space(3))) bf16x8*)(kp+j*2048); kf[2*j+1]=*(const __attribute__((address_space(3))) bf16x8*)(kp+j*2048+512); }
__device__ __forceinline__ s16x4 vtr(lds_cptr p){ return __builtin_bit_cast(s16x4,__builtin_amdgcn_ds_read_tr16_b64_v4i16((__attribute__((address_space(3))) v4i16_t*)p)); }
__device__ __forceinline__ float rowmax(const f32x16&p0,const f32x16&p1){
  float a=max3f(p0[0],p0[1],p1[0]),b=max3f(p0[2],p0[3],p1[1]);a=max3f(a,p1[2],p1[3]);
  #pragma unroll
  for(int r=4;r<16;r+=4){a=max3f(a,p0[r],p0[r+1]);b=max3f(b,p0[r+2],p0[r+3]);a=max3f(a,p1[r],p1[r+1]);b=max3f(b,p1[r+2],p1[r+3]);}
  const float m=max2f(a,b);
  auto rr=__builtin_amdgcn_permlane32_swap(__float_as_uint(m),__float_as_uint(m),false,false);
  return max2f(__uint_as_float(rr[0]),__uint_as_float(rr[1]));
}
__device__ __forceinline__ void pv(f32x16*o,int vb,bf16x8 pa0,bf16x8 pa1,bf16x8 pa2,bf16x8 pa3){
  #pragma unroll
  for(int d0=0;d0<2;++d0){s16x4 lo[4],hi[4];
    #pragma unroll
    for(int ks=0;ks<4;++ks){
      asm volatile("ds_read_b64_tr_b16 %0,%1 offset:%c2":"=&v"(lo[ks]):"v"(vb),"i"(d0*4096+ks*1024):"memory");
      asm volatile("ds_read_b64_tr_b16 %0,%1 offset:%c2":"=&v"(hi[ks]):"v"(vb),"i"(d0*4096+ks*1024+512):"memory");}
    asm volatile("s_waitcnt lgkmcnt(0)":::"memory");SBAR();
    #define PK(k) (bf16x8){lo[k][0],lo[k][1],lo[k][2],lo[k][3],hi[k][0],hi[k][1],hi[k][2],hi[k][3]}
    o[d0]=__builtin_amdgcn_mfma_f32_32x32x16_bf16(pa0,PK(0),o[d0],0,0,0);
    o[d0]=__builtin_amdgcn_mfma_f32_32x32x16_bf16(pa1,PK(1),o[d0],0,0,0);
    o[d0]=__builtin_amdgcn_mfma_f32_32x32x16_bf16(pa2,PK(2),o[d0],0,0,0);
    o[d0]=__builtin_amdgcn_mfma_f32_32x32x16_bf16(pa3,PK(3),o[d0],0,0,0);
    #undef PK
  }
}

#ifndef ATTN_STORE16
#define ATTN_STORE16(p,v) (*(u32x4*)(p)=(v))
#endif
template<int THRL> __device__ __forceinline__ void attn_unit(int b,int h,int qb,const bf16*Q,const bf16*__restrict__ K,const bf16*__restrict__ V,bf16*O,const float*__restrict__ CT,const float TH,char*shm,const int tid_in){
  int tid_=tid_in; asm volatile("":"+v"(tid_)); const int tid=tid_,lane=tid&63,r32=lane&31,hi=lane>>5; const int wid=__builtin_amdgcn_readfirstlane(tid>>6);
  const long rowbase=(long)b*SEQ; const int q0=qb*QB;
  const bf16*Qw=Q+(rowbase+q0+wid*QBLK)*PQ+h*D;
  const float*ctg=CT+(long)(b*NHEAD+h)*SEQ;
  int t0;
  { const int NTf=(q0+QB)/KVBLK; const float cq0=ctg[q0];
    const bool k0=(lane>=NTf-4)||!(cq0-ctg[64*lane+63]<-TH);
    const int l1=lane+64; const bool k1=(l1>=NTf-4)||!(cq0-ctg[64*(l1<NTf?l1:NTf-1)+63]<-TH);
    const unsigned long long m0=__ballot(k0),m1=__ballot(k1);
    const int first=m0?__builtin_ctzll(m0):64+(m1?__builtin_ctzll(m1):63);
    t0=__builtin_amdgcn_readfirstlane(first)&~1; if(t0>NTf-4)t0=NTf-4; }
  const int tbase=t0*KVBLK;
  const bf16*Kh=K+(rowbase+tbase)*PQ+h*D,*Vh=V+(rowbase+tbase)*PQ+h*D;
  const unsigned lds0=(unsigned)(uintptr_t)shm;
  float*wsf=(float*)(shm+LDS_WS)+wid*64;
  const unsigned koff=(unsigned)(lane*PQ+wid*8)*2u;
  const unsigned voff=(unsigned)((16*(wid&3)+(lane>>2))*PQ+(wid>>2)*32+(lane&3)*8)*2u;
  const unsigned kdst=lds0+LDS_K+wid*1024, vdst=lds0+LDS_V+wid*1024;
  #define DMA_K(t,slot) glds16(Kh+(long)(t)*KVBLK*PQ,koff,(unsigned)__builtin_amdgcn_readfirstlane(kdst+(slot)))
  #define DMA_V(t,slot) glds16(Vh+(long)(t)*KVBLK*PQ,voff,(unsigned)__builtin_amdgcn_readfirstlane(vdst+(slot)))
  const int vb0=(int)(lds0+LDS_V)+((lane>>4)&1)*32+(lane&3)*8+(4*hi+((lane&15)>>2))*64;
  const char*Kbase=shm+LDS_K; bf16x8 kf[8];
  const lds_cptr shm3=(lds_cptr)shm; const lds_cptr kp0=shm3+LDS_K+hi*1024+r32*16; const lds_cptr vp0=shm3+LDS_V+((lane>>4)&1)*32+(lane&3)*8+(4*hi+((lane&15)>>2))*64;
  const int NT=(q0+QB)/KVBLK-t0;
  { typedef __attribute__((address_space(3))) u32x4 lv4; const u32x4*src=(const u32x4*)(ctg+tbase); lv4*dst=(lv4*)(shm3+LDS_CT); const int n4=(q0+QB-tbase)/4;
    for(int i=tid;i<n4;i+=NW*64)dst[i]=src[i]; }
  const float ctl=ctg[q0+wid*QBLK+r32];
  const __attribute__((address_space(3))) float*ctab=(const __attribute__((address_space(3))) float*)(shm3+LDS_CT)+4*hi;
  DMA_K(0,0);DMA_V(0,0);DMA_K(1,SLOTB);
  bf16x8 qr[4];
  #pragma unroll
  for(int d0=0;d0<4;++d0)qr[d0]=*reinterpret_cast<const bf16x8*>(&Qw[(long)r32*PQ+d0*16+hi*8]);
  float mhat=-ctl,l_reg=0.f;     f32x16 o[2];o[0]=f32x16{};o[1]=f32x16{};f32x16 negm;
  _Pragma("unroll") for(int r=0;r<16;++r)negm[r]=ctl; asm volatile("":"+v"(negm));
  #define CBIAS(C0,C1,t) do{ const __attribute__((address_space(3))) float*tb_=ctab+64*(t); \
    _Pragma("unroll") for(int g_=0;g_<4;++g_){ const f32x4_t a_=*(const __attribute__((address_space(3))) f32x4_t*)(tb_+8*g_), b_=*(const __attribute__((address_space(3))) f32x4_t*)(tb_+32+8*g_); \
      _Pragma("unroll") for(int e_=0;e_<4;++e_){ C0[4*g_+e_]-=a_[e_]; C1[4*g_+e_]-=b_[e_]; } } }while(0)
  const int qrel=wid*QBLK+r32;
  #define CMASK(P0,P1,t) do{int jb_=(t)-(NT-4); if(jb_>=0)cmask(P0,P1,jb_,qrel,hi);}while(0)
  bool resc=false;
  #define START(P0,P1) do{ const float rm=rowmax(P0,P1); resc=false; \
    { const float dl=rm; mhat=fadd_s(mhat,dl); \
      _Pragma("unroll") for(int r=0;r<16;++r){P0[r]=fsub_s(P0[r],dl);P1[r]=fsub_s(P1[r],dl);} \
      _Pragma("unroll") for(int r=0;r<16;++r)negm[r]=-mhat; asm volatile("":"+v"(negm)); } \
    _Pragma("unroll") for(int r=0;r<16;++r)P0[r]=__builtin_amdgcn_exp2f(P0[r]); }while(0)
  #define RESC() do{ if(resc){ asm volatile("s_waitcnt lgkmcnt(0)":::"memory"); \
      _Pragma("unroll") for(int d_=0;d_<2;++d_) _Pragma("unroll") for(int r=0;r<16;++r)o[d_][r]*=wsf[crow(r,hi)]; } }while(0)
  f32x16 pA0,pA1,pB0,pB1;
  int sl_prev=0,sl_cur=0,sl_next=SLOTB;
  #define ROT() do{sl_prev=sl_cur;sl_cur=sl_next;sl_next=(sl_next==(NSLOT-1)*SLOTB)?0:sl_next+SLOTB;}while(0)
  DMA_K(2,2*SLOTB);
  WAIT_BAR(3);
  qkt(pA0,pA1,Kbase,qr,negm,r32,hi);asm volatile("s_nop 15\n\ts_nop 7":"+v"(pA0),"+v"(pA1));CBIAS(pA0,pA1,0);asm volatile("s_nop 1":"+v"(pA0),"+v"(pA1));CMASK(pA0,pA1,0);
  START(pA0,pA1);
  _Pragma("unroll") for(int r=0;r<16;++r)pA1[r]=__builtin_amdgcn_exp2f(pA1[r]);
  WAIT_BAR(0);
  DMA_K(3,0);DMA_V(1,SLOTB);
  ROT();
  kload8(kf,kp0+sl_cur);
  WAIT_BAR(2);
  s16x4 vlo[8],vhi[8]; u32x4 pw0,pw1,pw2,pw3;
  #define PKW(P,B) cvtpk_s(P[B],P[B+1])
  #define PAF(k) __builtin_bit_cast(bf16x8,pw##k)
  #define VFR(i) (bf16x8){vlo[i][0],vlo[i][1],vlo[i][2],vlo[i][3],vhi[i][0],vhi[i][1],vhi[i][2],vhi[i][3]}
  #define PIN(x) asm volatile("":"+v"(x))
  #define MX3(a,b,c) __builtin_fmaxf(__builtin_fmaxf((a),(b)),(c))
  #define GAPA(MF,A0,A1,A2,A3,W0,W1,PW) do{ MF; sacc+=A0; sacc+=A1; sacc+=A2; sacc+=A3; PIN(sacc); W0; W1; PIN(PW); SBAR(); }while(0)
  #define EX(v) __builtin_amdgcn_exp2f(v)
  #define GAPB(MF,X,B) do{ MF; X[B]=EX(X[B]); X[B+1]=EX(X[B+1]); X[B+2]=EX(X[B+2]); X[B+3]=EX(X[B+3]); PIN(X); SBAR(); }while(0)
  #define VRD(i) do{ vlo[i]=vtr(vp_+(((i)>>2)*4096+((i)&3)*1024)); vhi[i]=vtr(vp_+(((i)>>2)*4096+((i)&3)*1024+512)); }while(0)
  #define KRD(G,j) do{ if(G){ kload2(kf,kp0+sl_next,j); SBAR(); } }while(0)
  #define STEP(C0,C1,P0,P1,t,GK,GV,GL) do{ SBAR(); \
    const lds_cptr vp_=vp0+sl_prev; \
    VRD(0); SBAR(); float sacc=(P0[0]+P0[1]); \
    GAPA(C0=__builtin_amdgcn_mfma_f32_32x32x16_bf16(kf[0],qr[0],negm,0,0,0), P0[2],P0[3],P0[4],P0[5],     pw0[0]=PKW(P0,0), pw0[1]=PKW(P0,2), pw0); \
    VRD(4); SBAR(); GAPA(C1=__builtin_amdgcn_mfma_f32_32x32x16_bf16(kf[1],qr[0],negm,0,0,0), P0[6],P0[7],P0[8],P0[9],     pw0[2]=PKW(P0,4), pw0[3]=PKW(P0,6), pw0); \
    VRD(1); SBAR(); GAPA(C0=__builtin_amdgcn_mfma_f32_32x32x16_bf16(kf[2],qr[1],C0,0,0,0),   P0[10],P0[11],P0[12],P0[13], pw1[0]=PKW(P0,8), pw1[1]=PKW(P0,10), pw1); \
    VRD(5); SBAR(); GAPA(C1=__builtin_amdgcn_mfma_f32_32x32x16_bf16(kf[3],qr[1],C1,0,0,0),   P0[14],P0[15],P1[0],P1[1],   pw1[2]=PKW(P0,12),pw1[3]=PKW(P0,14), pw1); \
    VRD(2); SBAR(); GAPA(C0=__builtin_amdgcn_mfma_f32_32x32x16_bf16(kf[4],qr[2],C0,0,0,0),   P1[2],P1[3],P1[4],P1[5],     pw2[0]=PKW(P1,0), pw2[1]=PKW(P1,2), pw2); \
    VRD(6); SBAR(); GAPA(C1=__builtin_amdgcn_mfma_f32_32x32x16_bf16(kf[5],qr[2],C1,0,0,0),   P1[6],P1[7],P1[8],P1[9],     pw2[2]=PKW(P1,4), pw2[3]=PKW(P1,6), pw2); \
    VRD(3); SBAR(); GAPA(C0=__builtin_amdgcn_mfma_f32_32x32x16_bf16(kf[6],qr[3],C0,0,0,0),   P1[10],P1[11],P1[12],P1[13], pw3[0]=PKW(P1,8), pw3[1]=PKW(P1,10), pw3); \
    VRD(7); SBAR(); GAPA(C1=__builtin_amdgcn_mfma_f32_32x32x16_bf16(kf[7],qr[3],C1,0,0,0),   P1[14],P1[15],0.f,0.f,       pw3[2]=PKW(P1,12),pw3[3]=PKW(P1,14), pw3); \
    l_reg+=sacc; \
    if(GK){DMA_K((t)+3,sl_cur);} if(GV){DMA_V((t)+1,sl_next);} \
    CBIAS(C0,C1,t); CMASK(C0,C1,t); \
    { float a=MX3(C0[0],C0[1],C1[0]),b=MX3(C0[2],C0[3],C1[1]); a=MX3(a,C1[2],C1[3]); \
      _Pragma("unroll") for(int r=4;r<16;r+=4){a=MX3(a,C0[r],C0[r+1]);b=MX3(b,C0[r+2],C0[r+3]);a=MX3(a,C1[r],C1[r+1]);b=MX3(b,C1[r+2],C1[r+3]);} \
      float rm=__builtin_fmaxf(a,b); { auto rr=__builtin_amdgcn_permlane32_swap(__float_as_uint(rm),__float_as_uint(rm),false,false); rm=__builtin_fmaxf(__uint_as_float(rr[0]),__uint_as_float(rr[1])); } \
      resc=false; \
      if(__builtin_expect(__any(rm>(float)THRL),0)){ const float dl=__builtin_fmaxf(rm,0.f); mhat+=dl; \
        _Pragma("unroll") for(int r=0;r<16;++r){C0[r]-=dl;C1[r]-=dl;} \
        _Pragma("unroll") for(int r=0;r<16;++r)negm[r]=-mhat; asm volatile("":"+v"(negm)); \
        const float f=__builtin_amdgcn_exp2f(-dl); l_reg*=f; if(hi==0)wsf[r32]=f; resc=true; } } \
    SBAR(); \
    GAPB(o[0]=__builtin_amdgcn_mfma_f32_32x32x16_bf16(PAF(0),VFR(0),o[0],0,0,0), C0,0); \
    GAPB(o[1]=__builtin_amdgcn_mfma_f32_32x32x16_bf16(PAF(0),VFR(4),o[1],0,0,0), C0,4); \
    KRD(GL,0); GAPB(o[0]=__builtin_amdgcn_mfma_f32_32x32x16_bf16(PAF(1),VFR(1),o[0],0,0,0), C0,8); \
    KRD(GL,1); GAPB(o[1]=__builtin_amdgcn_mfma_f32_32x32x16_bf16(PAF(1),VFR(5),o[1],0,0,0), C0,12); \
    KRD(GL,2); GAPB(o[0]=__builtin_amdgcn_mfma_f32_32x32x16_bf16(PAF(2),VFR(2),o[0],0,0,0), C1,0); \
    KRD(GL,3); GAPB(o[1]=__builtin_amdgcn_mfma_f32_32x32x16_bf16(PAF(2),VFR(6),o[1],0,0,0), C1,4); \
    GAPB(o[0]=__builtin_amdgcn_mfma_f32_32x32x16_bf16(PAF(3),VFR(3),o[0],0,0,0), C1,8); \
    GAPB(o[1]=__builtin_amdgcn_mfma_f32_32x32x16_bf16(PAF(3),VFR(7),o[1],0,0,0), C1,12); \
    }while(0)
  int t=1;
  #undef CMASK
  #define CMASK(P0,P1,t) do{}while(0)
  for(;t+5<NT;t+=2){
    STEP(pB0,pB1,pA0,pA1,t,true,true,true);     WAIT_BAR(2); RESC(); ROT();
    STEP(pA0,pA1,pB0,pB1,t+1,true,true,true);   WAIT_BAR(2); RESC(); ROT();
  }
  #undef CMASK
  #define CMASK(P0,P1,t) do{int jb_=(t)-(NT-4); if(jb_>=0)cmask(P0,P1,jb_,qrel,hi);}while(0)
  #define ENDW(tt) do{ if((tt)+3<NT){WAIT_BAR(2);} else if((tt)+2<NT){WAIT_BAR(1);} else {WAIT_BAR(0);} }while(0)
  for(;t+1<NT;t+=2){
    STEP(pB0,pB1,pA0,pA1,t,(t+3<NT),(t+1<NT),(t+1<NT));       ENDW(t);   RESC(); ROT();
    STEP(pA0,pA1,pB0,pB1,t+1,(t+4<NT),(t+2<NT),(t+2<NT));     ENDW(t+1); RESC(); ROT();
  }
  STEP(pB0,pB1,pA0,pA1,NT-1,false,false,false); RESC();
  { float sacc=pB0[0]+pB0[1]; _Pragma("unroll") for(int r=2;r<16;++r)sacc+=pB0[r]; _Pragma("unroll") for(int r=0;r<16;++r)sacc+=pB1[r]; l_reg+=sacc;
    pw0=(u32x4){PKW(pB0,0),PKW(pB0,2),PKW(pB0,4),PKW(pB0,6)};pw1=(u32x4){PKW(pB0,8),PKW(pB0,10),PKW(pB0,12),PKW(pB0,14)};pw2=(u32x4){PKW(pB1,0),PKW(pB1,2),PKW(pB1,4),PKW(pB1,6)};pw3=(u32x4){PKW(pB1,8),PKW(pB1,10),PKW(pB1,12),PKW(pB1,14)};
    SBAR(); pv(o,vb0+sl_cur,PAF(0),PAF(1),PAF(2),PAF(3)); }
  #undef PKW
  #undef PAF
  #undef VFR
  #undef PIN
  #undef MX3
  #undef GAPA
  #undef GAPB
  #undef EX
  #undef VRD
  #undef KRD
  #undef STEP
  #undef ENDW
  {auto rr=__builtin_amdgcn_permlane32_swap(__float_as_uint(l_reg),__float_as_uint(l_reg),false,false);l_reg=__uint_as_float(rr[0])+__uint_as_float(rr[1]);}
  if(hi==0)wsf[32+r32]=l_reg;asm volatile("s_waitcnt lgkmcnt(0)":::"memory");
  float rli[16];
  #pragma unroll
  for(int r=0;r<16;++r)rli[r]=__builtin_amdgcn_rcpf(wsf[32+crow(r,hi)]);
  bf16*Ow=O+(rowbase+q0+wid*QBLK)*PO+h*D;
  { bf16*stg=(bf16*)(shm+LDS_OST)+wid*2048;
    #pragma unroll
    for(int r=0;r<16;++r){const int orow=crow(r,hi);
      #pragma unroll
      for(int d0=0;d0<2;++d0)stg[orow*64+d0*32+r32]=__float2bfloat16(o[d0][r]*rli[r]);}
    asm volatile("s_waitcnt lgkmcnt(0)":::"memory");
    #pragma unroll
    for(int i=0;i<4;++i){const int row=i*8+(lane>>3),ch=lane&7; const u32x4 v=*(const u32x4*)(stg+row*64+ch*8); ATTN_STORE16(Ow+(long)row*PO+ch*8,v);} }
  asm volatile("s_waitcnt lgkmcnt(0)\n\ts_barrier":::"memory");
  #undef DMA_K
  #undef DMA_V
  #undef CMASK
  #undef CBIAS
  #undef START
  #undef RESC
  #undef ROT
}
constexpr int ATTN_LDS_BYTES=LDS_BYTES;
struct AttnTensors { const bf16* Q; const bf16* K; const bf16* V; bf16* O; const float* CT; float TH; };
struct AttnUnit { int bh; int qb; };
struct StaticOrder {
  int vcu;
  __device__ __forceinline__ explicit StaticOrder(int grid,int block):vcu((block%8)*(grid/8)+block/8){}
  __device__ __forceinline__ bool next(int i,AttnUnit&u)const{ if(i>=4)return false; const int s=vcu&7; u.bh=vcu>>3; u.qb=(i==0)?s:(i==1)?15-s:(i==2)?16+s:31-s; return true; }
  __device__ __forceinline__ void a_ready(const AttnUnit&)const{}
  __device__ __forceinline__ void done(const AttnUnit&)const{}
};
template<class Sched,int THRL=8> __device__ __forceinline__ void attn_phase(char*lds,const AttnTensors&T,const Sched&S,const int tid_in){
  AttnUnit u;
  for(int i=0;S.next(i,u);++i){ S.a_ready(u); attn_unit<THRL>(u.bh/NHEAD,u.bh%NHEAD,u.qb,T.Q,T.K,T.V,T.O,T.CT,T.TH,lds,tid_in); S.done(u); }
}
#undef SBAR
#undef WAIT_BAR
}

constexpr int NWAVES = 8;
#ifndef MK_N_LAUNCHES
#define MK_N_LAUNCHES 1
#endif
enum Phase { PH_PRO = 0, PH_IN0, PH_MIX0, PH_OUT0, PH_XQ0, PH_XO0, PH_UP0, PH_DN0, PH_IN1, PH_MIX1, PH_OUT1, PH_XQ1, PH_XO1, PH_UP1, PH_DN1, N_PHASES };
constexpr int N_LAUNCHES = MK_N_LAUNCHES;
static_assert(N_LAUNCHES == 1 || N_LAUNCHES == N_PHASES, "MK_N_LAUNCHES is 1 or 15");

#ifndef MK_F8DN
#define MK_F8DN 2
#endif
#ifndef MK_F8XO
#define MK_F8XO 1
#endif
constexpr float F8_XOASCALE = 64.0f, F8_XOWSCALE = 512.0f;
constexpr float F8_HSCALE = 16.0f, F8_WSCALE = 1024.0f;
constexpr int BATCH = 4, SEQ = 8192, D = 1024, T = BATCH * SEQ;
constexpr int NMEM = 256, MROWS = BATCH * NMEM;
constexpr int EVEN_IN = 2568, N_IN0 = 2560, N_IN1 = 2048, DFF = 2816, XAW = 512;
constexpr int Z1P = 1536;
constexpr float EPS = 1e-6f, LOG2E = 1.4426950408889634f;
constexpr float FOX_C2 = 0.125f * LOG2E;
constexpr float XA_C2 = 0.08838834764831845f * LOG2E;

constexpr size_t MiB = 1u << 20;
constexpr size_t WS_CTL = 0, CTL_ZERO_BYTES = 64 * 1024;
constexpr size_t WS_WIN0 = 2 * MiB, WS_WOUT0 = 7 * MiB, WS_WIN1 = 9 * MiB, WS_WOUT1 = 13 * MiB;
constexpr size_t WS_LAYER = 15 * MiB, LAYER_STRIDE = 21 * MiB, L_WQ = 0, L_WKV = 1 * MiB, L_WO = 3 * MiB, L_WGU = 4 * MiB, L_WD = 15 * MiB;
constexpr size_t WS_WSP = 57 * MiB;
constexpr size_t WS_MEMN = 58 * MiB, WS_KVRAW = 60 * MiB, WS_KN = 64 * MiB, WS_VT = 66 * MiB;
constexpr size_t WS_LOGF = 68 * MiB, WS_CUM = 69 * MiB, WS_SSQ = 70 * MiB;
constexpr size_t WS_XB = 72 * MiB, WS_Y = 136 * MiB, WS_XQ = WS_Y, WS_XO = WS_Y + 32 * MiB, WS_BIG = 200 * MiB, WS_END = 376 * MiB;
constexpr int CW_TMO = 0, CW_CODE = 1;
constexpr int CW_BAR = 4096;
constexpr int CW_Q0 = 64;

constexpr int RING_OFF = 0, RING_BYTES = 131072;
constexpr int XA_KROW = 272, XA_VROW = 528, XA_KBYTES = 256 * XA_KROW, XA_VBYTES = 128 * XA_VROW;
constexpr int LDSCTL_OFF = 139264, MISC_OFF = LDSCTL_OFF + 320;
constexpr int LDS_BYTES = 147456;
static_assert(XA_KBYTES + XA_VBYTES <= LDSCTL_OFF && MISC_OFF + 128 <= LDS_BYTES, "LDS map");
#define GAS __attribute__((address_space(1)))
#define LAS __attribute__((address_space(3)))
typedef unsigned short bf16;
typedef unsigned v4u __attribute__((ext_vector_type(4)));
typedef float f32x4 __attribute__((ext_vector_type(4)));
typedef short bf16x8 __attribute__((ext_vector_type(8)));
typedef GAS unsigned gu32;
typedef GAS unsigned long long gu64;
#define RLX_AGENT __ATOMIC_RELAXED, __HIP_MEMORY_SCOPE_AGENT
#define LDS_WAIT() asm volatile("s_waitcnt lgkmcnt(0)" ::: "memory")
#define VM_WAIT() asm volatile("s_waitcnt vmcnt(0)" ::: "memory")
__device__ __forceinline__ unsigned long long rt() { return __builtin_amdgcn_s_memrealtime(); }
__device__ __forceinline__ unsigned f2bf(float f) { unsigned u = __builtin_bit_cast(unsigned, f); return (u + 0x7fffu + ((u >> 16) & 1u)) >> 16; }
__device__ __forceinline__ unsigned pk2(float lo, float hi) { return f2bf(lo) | (f2bf(hi) << 16); }
typedef float pk_f32x2 __attribute__((ext_vector_type(2))); typedef __bf16 pk_bf16x2 __attribute__((ext_vector_type(2)));
__device__ __forceinline__ unsigned pk2h(float lo, float hi) { const pk_f32x2 v = {lo, hi}; return __builtin_bit_cast(unsigned, __builtin_convertvector(v, pk_bf16x2)); }

#define XB_TMO      128
#define XB_XCNT(j)  (256  + 64 * (j))
#define XB_XSUB(j)  (1280 + 64 * (j))
#define XB_XGEN(j)  (2304 + 64 * (j))
#define XB_TOP      3328
#define XB_TOPGEN   3392
#define XCD_BAR_WORDS 3456
#define XB_SPIN_CAP (1u << 18)

__device__ __forceinline__ unsigned xb_ld(unsigned* p)              { return __hip_atomic_load(p, __ATOMIC_RELAXED, __HIP_MEMORY_SCOPE_AGENT); }
__device__ __forceinline__ unsigned xb_add(unsigned* p, unsigned v) { return __hip_atomic_fetch_add(p, v, __ATOMIC_RELAXED, __HIP_MEMORY_SCOPE_AGENT); }
__device__ __forceinline__ unsigned xb_xcc_id() { return (unsigned)__builtin_amdgcn_s_getreg((3 << 11) | 20) & 0xFu; }
#define XB_SPIN(cond, bar) do { unsigned _sp = 0; while (cond) { __builtin_amdgcn_s_sleep(1); \
    if ((++_sp & 255u) == 0u) { if (xb_ld(&(bar)[XB_TMO])) break; if (_sp > XB_SPIN_CAP) { atomicAdd(&(bar)[XB_TMO], 1u); break; } } } } while (0)

struct XcdBarrier {
    unsigned* bar; unsigned x;
    volatile LAS unsigned* st;
};

__device__ __forceinline__ XcdBarrier xcd_barrier_post(unsigned* bar, volatile LAS unsigned* st, const int tid_in) {
    XcdBarrier b; b.bar = bar; b.x = xb_xcc_id(); b.st = st;
    if (tid_in == 0) (void)xb_add(&bar[XB_XCNT(b.x)], 1u);
    return b;
}
__device__ __forceinline__ void xcd_barrier_complete(unsigned* bar, unsigned x, unsigned& nloc, unsigned& nx) {
    const unsigned G = gridDim.x * gridDim.y * gridDim.z;
    unsigned sum, cnt, mine, sp = 0u;
    for (;;) {
        sum = 0u; cnt = 0u; mine = 0u;
#pragma unroll
        for (unsigned j = 0; j < 16; ++j) { const unsigned c = xb_ld(&bar[XB_XCNT(j)]); sum += c; cnt += (c > 0u) ? 1u : 0u; mine = (j == x) ? c : mine; }
        if (sum == G) break;
        __builtin_amdgcn_s_sleep(1);
        if ((++sp & 255u) == 0u) { if (xb_ld(&bar[XB_TMO])) break; if (sp > XB_SPIN_CAP) { atomicAdd(&bar[XB_TMO], 1u); break; } }
    }
    nloc = mine > 0u ? mine : 1u; nx = cnt > 0u ? cnt : 1u;
}

__device__ __forceinline__ void xcd_barrier(const XcdBarrier& b, const int tid_in) {
    asm volatile("s_waitcnt vmcnt(0)" ::: "memory");
    __syncthreads();
    int t0_ = tid_in; asm volatile("" : "+v"(t0_));
    if (t0_ == 0) {
        unsigned* bar = b.bar; asm volatile("" : "+v"(bar));
        __builtin_amdgcn_s_waitcnt(0);
        unsigned nloc = b.st[0], nx = b.st[1];
        if (nloc == 0u) { xcd_barrier_complete(bar, b.x, nloc, nx); b.st[0] = nloc; b.st[1] = nx; }
        const unsigned old = xb_add(&bar[XB_XSUB(b.x)], 1u);
        const unsigned gen = old / nloc;
        if (old + 1u == (gen + 1u) * nloc) {
            __builtin_amdgcn_fence(__ATOMIC_RELEASE, "agent");
            asm volatile("s_waitcnt vmcnt(0)" ::: "memory");
            const unsigned og = xb_add(&bar[XB_TOP], 1u);
            const unsigned tg = og / nx;
            if (og + 1u == (tg + 1u) * nx) xb_add(&bar[XB_TOPGEN], 1u);
            else XB_SPIN(xb_ld(&bar[XB_TOPGEN]) == tg, bar);
            __builtin_amdgcn_fence(__ATOMIC_ACQUIRE, "agent");
            xb_add(&bar[XB_XGEN(b.x)], 1u);
            asm volatile("s_waitcnt vmcnt(0)" ::: "memory");
        } else {
            XB_SPIN(xb_ld(&bar[XB_XGEN(b.x)]) == gen, bar);
            __builtin_amdgcn_fence(__ATOMIC_ACQUIRE, "agent");
            asm volatile("s_waitcnt vmcnt(0)" ::: "memory");
        }
    }
    __syncthreads();
}

typedef float f32x16 __attribute__((ext_vector_type(16)));
typedef unsigned u32x2 __attribute__((ext_vector_type(2)));
__device__ __forceinline__ float bf2f(short s) { return __builtin_bit_cast(float, (unsigned)(unsigned short)s << 16); }
__device__ __forceinline__ float bfu2f(unsigned u16) { return __builtin_bit_cast(float, u16 << 16); }
__device__ __forceinline__ float rsq(float x) { return __builtin_amdgcn_rsqf(x); }

typedef const float* cfp_t;
struct Frame {
    LAS unsigned char* lds;
    volatile LAS unsigned* MISC;
    gu32* ctl;
    int tid, lane, wave;
    int vcu, G;
    const __attribute__((address_space(4))) cfp_t* in;
    const float* x; float* out;
    unsigned char* ws;
    bf16 *XB, *Y, *XQ, *XO, *BIG, *MEMN, *KVRAW, *KN, *VT, *WSP;
    float *LOGF, *CUM, *SSQ;
};
__device__ __forceinline__ bf16* lw(Frame& F, int l, size_t off) { return (bf16*)(F.ws + WS_LAYER + (size_t)l * LAYER_STRIDE + off); }

__device__ __forceinline__ float wave_sum(float v) {
#pragma unroll
    for (int o = 1; o < 64; o <<= 1) v += __shfl_xor(v, o);
    return v;
}
typedef float f32x2 __attribute__((ext_vector_type(2)));
__device__ __forceinline__ int p0_drow(int n, int map) {
    if (map == 1) { if (n >= 1024 && n < 2048) { const int tile = n >> 8, ll = n & 255; return tile * 256 + 128 * ((ll >> 5) & 1) + 32 * (ll >> 6) + (ll & 31); } return n; }
    if (map == 2) return 256 * (n >> 7) + (n & 127);
    if (map == 3) return 256 * (n >> 7) + 128 + (n & 127);
    if (map == 4) {
        if (n < 512) return n; if (n < 1024) return 512 + 256 * ((n - 512) >> 7) + (n & 127); if (n < 1536) return 1536 + (n - 1024); return 512 + 256 * ((n - 1536) >> 7) + 128 + (n & 127); }
    return n;
}
__device__ __forceinline__ void p0_transpose_item(const float* W, int ldn, const float* ks, bf16* WT, int ldk, int koff, int k0, int n0, int map, LAS unsigned char* scr, int lane) {
    const float* src = W + (size_t)k0 * ldn + n0 + 2 * lane;
#pragma unroll
    for (int hh = 0; hh < 2; ++hh) {
        f32x2 v[32];
#pragma unroll
        for (int i = 0; i < 32; ++i) v[i] = __builtin_nontemporal_load((const GAS f32x2*)(src + (size_t)(32 * hh + i) * ldn));
#pragma unroll
        for (int i = 0; i < 32; i += 2) { const int kk = 32 * hh + i; float s0 = 1.f, s1 = 1.f; if (ks) { s0 = ks[k0 + kk]; s1 = ks[k0 + kk + 1]; }
            *(LAS unsigned*)(scr + (2 * lane) * 136 + kk * 2) = pk2h(v[i].x * s0, v[i + 1].x * s1);
            *(LAS unsigned*)(scr + (2 * lane + 1) * 136 + kk * 2) = pk2h(v[i].y * s0, v[i + 1].y * s1); }
    }
    LDS_WAIT(); asm volatile("" ::: "memory");
    const int c = lane & 7;
#pragma unroll
    for (int j = 0; j < 16; ++j) { const int n = (lane >> 3) + 8 * j; const LAS unsigned char* p = scr + n * 136 + c * 16;
        const u32x2 lo = *(const LAS u32x2*)p, hi = *(const LAS u32x2*)(p + 8);
        v4u o; o.x = lo.x; o.y = lo.y; o.z = hi.x; o.w = hi.y;
        *(GAS v4u*)(WT + (size_t)p0_drow(n0 + n, map) * ldk + koff + k0 + 8 * c) = o; }
    LDS_WAIT(); asm volatile("" ::: "memory");
}
__device__ __forceinline__ void p0_transpose_item8(const float* W, int ldn, float sc, unsigned char* WT, int ldk, int k0, int n0, LAS unsigned char* scr, int lane) {
    const float* src = W + (size_t)k0 * ldn + n0 + 2 * lane;
#pragma unroll
    for (int hh = 0; hh < 2; ++hh) {
        f32x2 v[32];
#pragma unroll
        for (int i = 0; i < 32; ++i) v[i] = __builtin_nontemporal_load((const GAS f32x2*)(src + (size_t)(32 * hh + i) * ldn));
#pragma unroll
        for (int i = 0; i < 32; i += 4) { const int kk = 32 * hh + i;
            *(LAS unsigned*)(scr + (2 * lane) * 72 + kk) = pg8::pk4_f8(v[i].x * sc, v[i + 1].x * sc, v[i + 2].x * sc, v[i + 3].x * sc);
            *(LAS unsigned*)(scr + (2 * lane + 1) * 72 + kk) = pg8::pk4_f8(v[i].y * sc, v[i + 1].y * sc, v[i + 2].y * sc, v[i + 3].y * sc); }
    }
    LDS_WAIT(); asm volatile("" ::: "memory");
    const int c = lane & 3;
#pragma unroll
    for (int j = 0; j < 8; ++j) { const int n = (lane >> 2) + 16 * j; const LAS unsigned char* p = scr + n * 72 + c * 16;
        const u32x2 lo = *(const LAS u32x2*)p, hi = *(const LAS u32x2*)(p + 8);
        v4u o; o.x = lo.x; o.y = lo.y; o.z = hi.x; o.w = hi.y;
        *(GAS v4u*)(WT + (size_t)(n0 + n) * ldk + k0 + 16 * c) = o; }
    LDS_WAIT(); asm volatile("" ::: "memory");
}
__device__ __forceinline__ bool p0_job8(int& r, const float* src, int ldn, int K, int N, float sc, unsigned char* dst, int ldk, LAS unsigned char* scr, int lane) {
    const int nblk = N / 128, items = (K / 64) * nblk;
    if (r >= items) { r -= items; return false; }
    const int kb = r / nblk, nb = r % nblk;
    p0_transpose_item8(src, ldn, sc, dst, ldk, 64 * kb, 128 * nb, scr, lane);
    return true;
}
__device__ __forceinline__ bool p0_job(int& r, const float* src, int ldn, int K, int N, const float* ks, bf16* dst, int ldk, int koff, int map, LAS unsigned char* scr, int lane) {
    const int nblk = N / 128, items = (K / 64) * nblk;
    if (r >= items) { r -= items; return false; }
    const int kb = r / nblk, nb = r % nblk;
    p0_transpose_item(src, ldn, ks, dst, ldk, koff, 64 * kb, 128 * nb, map, scr, lane);
    return true;
}
__device__ __forceinline__ void p0_prologue(Frame& F) {
    LAS unsigned char* scr = F.lds + RING_OFF + F.wave * 17408;
    const int gw = F.vcu * NWAVES + F.wave, NGW = F.G * NWAVES, lane = F.lane;
    const __attribute__((address_space(4))) cfp_t* in = F.in;
    constexpr int I_IN0 = 16 * 20, I_SQ = 16 * 8, I_IN1 = 16 * 16, I_O1 = 8 * 8, I_Q = 16 * 4, I_KV = 16 * 8, I_XO = 8 * 8, I_G = 16 * 22, I_DN = 44 * 8;
    constexpr int NITEMS = I_IN0 + I_SQ + I_IN1 + I_O1 + 2 * (I_Q + I_KV + I_XO + 2 * I_G + I_DN);
#ifdef PROBE_PHASE
#define P0REP(k) for (int prep_ = 0; prep_ < ((PROBE_PHASE == 100 + (k)) ? 2 : 1); ++prep_)
#else
#define P0REP(k)
#endif
    P0REP(1)
    for (int it = gw; it < NITEMS; it += NGW) {
        int r = it;
        if (p0_job(r, in[14], EVEN_IN, D, N_IN0, in[2], (bf16*)(F.ws + WS_WIN0), D, 0, 1, scr, lane)) continue;
        if (p0_job(r, in[21], D, D, D, nullptr, (bf16*)(F.ws + WS_WOUT0), D, 0, 0, scr, lane)) continue;
        if (p0_job(r, in[22], N_IN1, D, N_IN1, in[2] + D, (bf16*)(F.ws + WS_WIN1), D, 0, 4, scr, lane)) continue;
        if (p0_job(r, in[26] + (size_t)512 * D, D, 512, D, nullptr, (bf16*)(F.ws + WS_WOUT1), D, 512, 0, scr, lane)) continue;
        bool done = false;
#pragma unroll
        for (int l = 0; l < 2; ++l) {
            if (done) break;
            if (p0_job(r, in[5] + (size_t)l * D * XAW, XAW, D, XAW, in[3] + l * D, lw(F, l, L_WQ), D, 0, 0, scr, lane)) { done = true; break; }
            if (p0_job(r, in[6] + (size_t)l * D * D, D, D, D, in[4] + l * D, lw(F, l, L_WKV), D, 0, 0, scr, lane)) { done = true; break; }
            if (MK_F8XO) { if (p0_job8(r, in[7] + (size_t)l * XAW * D, D, XAW, D, F8_XOWSCALE, (unsigned char*)lw(F, l, L_WO), XAW, scr, lane)) { done = true; break; } }
            else if (p0_job(r, in[7] + (size_t)l * XAW * D, D, XAW, D, nullptr, lw(F, l, L_WO), XAW, 0, 0, scr, lane)) { done = true; break; }
            if (p0_job(r, in[11] + (size_t)l * D * DFF, DFF, D, DFF, in[10] + l * D, lw(F, l, L_WGU), D, 0, 2, scr, lane)) { done = true; break; }
            if (p0_job(r, in[12] + (size_t)l * D * DFF, DFF, D, DFF, in[10] + l * D, lw(F, l, L_WGU), D, 0, 3, scr, lane)) { done = true; break; }
            if ((MK_F8DN >> l) & 1) { if (p0_job8(r, in[13] + (size_t)l * DFF * D, D, DFF, D, F8_WSCALE, (unsigned char*)lw(F, l, L_WD), DFF, scr, lane)) { done = true; break; } }
            else if (p0_job(r, in[13] + (size_t)l * DFF * D, D, DFF, D, nullptr, lw(F, l, L_WD), DFF, 0, 0, scr, lane)) { done = true; break; }
        }
    }
    P0REP(2)
    for (int it = gw; it < 128 * 16; it += NGW) {
        const int kk0 = (it >> 4) * 4, n0 = (it & 15) * 64, g = kk0 >> 7;
        const float* wp = in[23] + (size_t)kk0 * 128; const float* sp = in[24] + g * 128; const float* wo = in[26] + (size_t)(g * 128) * D + n0 + lane;
        float acc[4];
#pragma unroll
        for (int j = 0; j < 4; ++j) acc[j] = 0.f;
#pragma unroll 32
        for (int d = 0; d < 128; ++d) { const float w = wo[(size_t)d * D] * sp[d];
#pragma unroll
            for (int j = 0; j < 4; ++j) acc[j] += wp[j * 128 + d] * w; }
        u32x2 o; o.x = pk2h(acc[0], acc[1]); o.y = pk2h(acc[2], acc[3]);
        *(GAS u32x2*)((bf16*)(F.ws + WS_WOUT1) + (size_t)(n0 + lane) * D + kk0) = o;
    }
    for (int i = gw * 64 + lane; i < 4 * 128 * 128; i += NGW * 64) { const int t = (i >> 7) & 127, s = i & 127; const float w = in[17][i]; F.WSP[i] = (bf16)f2bf((t >> 6) >= (s >> 6) ? w : 0.f); }
    for (int row = gw; row < MROWS; row += NGW) {
        const GAS f32x4* xr = (const GAS f32x4*)(in[1] + (size_t)row * D) + lane;
        f32x4 v[4]; float s = 0.f;
#pragma unroll
        for (int j = 0; j < 4; ++j) { v[j] = xr[64 * j]; s += (v[j].x * v[j].x + v[j].y * v[j].y) + (v[j].z * v[j].z + v[j].w * v[j].w); }
        const float rstd = rsq(wave_sum(s) * (1.f / D) + EPS);
        GAS unsigned long long* o8 = (GAS unsigned long long*)(F.MEMN + (size_t)row * D) + lane;
#pragma unroll
        for (int j = 0; j < 4; ++j) o8[64 * j] = (unsigned long long)pk2h(v[j].x * rstd, v[j].y * rstd) | ((unsigned long long)pk2h(v[j].z * rstd, v[j].w * rstd) << 32);
    }
    {
        LAS float* wl = (LAS float*)(F.lds + RING_OFF);
        __syncthreads();
#pragma unroll
        for (int r = 0; r < 2; ++r) { const int k = F.tid + 512 * r; const float g = in[2][k]; const float* p = in[14] + (size_t)k * EVEN_IN + N_IN0;
            const f32x4 a = *(const f32x4*)p, b = *(const f32x4*)(p + 4);
            wl[0 * 1024 + k] = a.x * g; wl[1 * 1024 + k] = a.y * g; wl[2 * 1024 + k] = a.z * g; wl[3 * 1024 + k] = a.w * g;
            wl[4 * 1024 + k] = b.x * g; wl[5 * 1024 + k] = b.y * g; wl[6 * 1024 + k] = b.z * g; wl[7 * 1024 + k] = b.w * g; }
        __syncthreads();
        float wf[8][16];
#pragma unroll
        for (int j = 0; j < 8; ++j)
#pragma unroll
            for (int jj = 0; jj < 4; ++jj) { const f32x4 w = *(const LAS f32x4*)(wl + j * 1024 + 4 * lane + 256 * jj); wf[j][jj * 4 + 0] = w.x; wf[j][jj * 4 + 1] = w.y; wf[j][jj * 4 + 2] = w.z; wf[j][jj * 4 + 3] = w.w; }
        const float bfl = in[15][lane & 7];
        P0REP(3) {
        int row = gw;
        f32x4 v[4], v1[4];
        if (row < T) { const GAS f32x4* xr = (const GAS f32x4*)(F.x + (size_t)row * D) + lane;
#pragma unroll
            for (int j = 0; j < 4; ++j) v[j] = __builtin_nontemporal_load(xr + 64 * j); }
        if (row + NGW < T) { const GAS f32x4* xr = (const GAS f32x4*)(F.x + (size_t)(row + NGW) * D) + lane;
#pragma unroll
            for (int j = 0; j < 4; ++j) v1[j] = __builtin_nontemporal_load(xr + 64 * j); }
        while (row < T) {
            const int nrow = row + NGW; f32x4 vn[4];
            if (nrow + NGW < T) { const GAS f32x4* xr = (const GAS f32x4*)(F.x + (size_t)(nrow + NGW) * D) + lane;
#pragma unroll
                for (int j = 0; j < 4; ++j) vn[j] = __builtin_nontemporal_load(xr + 64 * j); }
            float s = 0.f;
#pragma unroll
            for (int j = 0; j < 4; ++j) s += (v[j].x * v[j].x + v[j].y * v[j].y) + (v[j].z * v[j].z + v[j].w * v[j].w);
            float a[8];
#pragma unroll
            for (int j2 = 0; j2 < 8; ++j2) { float t = 0.f;
#pragma unroll
                for (int jj = 0; jj < 4; ++jj) t += (v[jj].x * wf[j2][jj * 4 + 0] + v[jj].y * wf[j2][jj * 4 + 1]) + (v[jj].z * wf[j2][jj * 4 + 2] + v[jj].w * wf[j2][jj * 4 + 3]);
                a[j2] = t; }
            float b4[4], b2[2], b1;
#pragma unroll
            for (int i = 0; i < 4; ++i) { const float keep = (lane & 1) ? a[2 * i + 1] : a[2 * i], give = (lane & 1) ? a[2 * i] : a[2 * i + 1]; b4[i] = keep + __shfl_xor(give, 1); }
#pragma unroll
            for (int i = 0; i < 2; ++i) { const float keep = (lane & 2) ? b4[2 * i + 1] : b4[2 * i], give = (lane & 2) ? b4[2 * i] : b4[2 * i + 1]; b2[i] = keep + __shfl_xor(give, 2); }
            { const float keep = (lane & 4) ? b2[1] : b2[0], give = (lane & 4) ? b2[0] : b2[1]; b1 = keep + __shfl_xor(give, 4); }
            b1 += __shfl_xor(b1, 8); b1 += __shfl_xor(b1, 16); b1 += __shfl_xor(b1, 32);
            s = wave_sum(s);
            const float rstd = rsq(s * (1.f / D) + EPS);
            if (lane < 16) F.SSQ[(size_t)row * 16 + lane] = (lane == 0) ? s : 0.f;
            GAS unsigned long long* o8 = (GAS unsigned long long*)(F.XB + (size_t)row * D) + lane;
#pragma unroll
            for (int j = 0; j < 4; ++j) o8[64 * j] = (unsigned long long)pk2h(v[j].x, v[j].y) | ((unsigned long long)pk2h(v[j].z, v[j].w) << 32);
            if (lane < 8) { const float fl = b1 * rstd + bfl; const float lf = fminf(fl, 0.f) - log1pf(expf(-fabsf(fl)));
                F.LOGF[((size_t)(row / SEQ) * 8 + lane) * SEQ + (row % SEQ)] = lf * LOG2E; }
#pragma unroll
            for (int j = 0; j < 4; ++j) { v[j] = v1[j]; v1[j] = vn[j]; }
            row = nrow;
        }
        }
    }
}
__device__ __forceinline__ void cumsum_seq(Frame& F, int bh) {
    const int tid = F.tid, lane = F.lane;
    const f32x4* src = (const f32x4*)(F.LOGF + (size_t)bh * SEQ + tid * 16);
    f32x4 q[4];
#pragma unroll
    for (int i = 0; i < 4; ++i) q[i] = src[i];
    float run = 0.f;
#pragma unroll
    for (int i = 0; i < 4; ++i) { q[i].x += run; q[i].y += q[i].x; q[i].z += q[i].y; q[i].w += q[i].z; run = q[i].w; }
    float incl = run;
#pragma unroll
    for (int o = 1; o < 64; o <<= 1) { const float t = __shfl_up(incl, o); if (lane >= o) incl += t; }
    LAS float* sc = (LAS float*)F.lds;
    __syncthreads();
    if (lane == 63) sc[F.wave] = incl;
    __syncthreads();
    float woff = 0.f;
#pragma unroll
    for (int w = 0; w < NWAVES; ++w) woff += (w < F.wave) ? sc[w] : 0.f;
    const float off = woff + (incl - run);
    f32x4* dst = (f32x4*)(F.CUM + (size_t)bh * SEQ + tid * 16);
#pragma unroll
    for (int i = 0; i < 4; ++i) dst[i] = q[i] + off;
    __syncthreads();
}
__device__ __forceinline__ void xa_kv_finalize(Frame& F, int item) {
    const int tid = F.tid, l = item >> 4, b = (item >> 2) & 3, h = item & 3;
    const int kvr = tid >> 1, half = tid & 1;
    const bf16* kp = F.KVRAW + (size_t)l * MROWS * D + (size_t)(b * NMEM + kvr) * D + h * 128 + 64 * half;
    const size_t obase = (size_t)((l * 4 + b) * 4 + h) * (NMEM * 128);
    bf16x8 x[8]; float ss = 0.f;
#pragma unroll
    for (int i = 0; i < 8; ++i) { x[i] = *(const GAS bf16x8*)(kp + 8 * i);
#pragma unroll
        for (int e = 0; e < 8; ++e) { const float f = bf2f(x[i][e]); ss += f * f; } }
    ss += __shfl_xor(ss, 1);
    const float rstd = rsq(ss * (1.f / 128.f) + EPS);
    const float* gk = F.in[9] + l * 128 + 64 * half;
    bf16* ko = F.KN + obase + (size_t)kvr * 128 + 64 * half;
#pragma unroll
    for (int i = 0; i < 8; ++i) { v4u o;
        o.x = pk2(bf2f(x[i][0]) * rstd * gk[8 * i + 0], bf2f(x[i][1]) * rstd * gk[8 * i + 1]); o.y = pk2(bf2f(x[i][2]) * rstd * gk[8 * i + 2], bf2f(x[i][3]) * rstd * gk[8 * i + 3]);
        o.z = pk2(bf2f(x[i][4]) * rstd * gk[8 * i + 4], bf2f(x[i][5]) * rstd * gk[8 * i + 5]); o.w = pk2(bf2f(x[i][6]) * rstd * gk[8 * i + 6], bf2f(x[i][7]) * rstd * gk[8 * i + 7]);
        *(GAS v4u*)(ko + 8 * i) = o; }
    const bf16* vp = kp + XAW;
    const int pk = (kvr & ~12) | ((kvr & 4) << 1) | ((kvr & 8) >> 1);
    LAS unsigned short* vl = (LAS unsigned short*)F.lds;
    __syncthreads();
#pragma unroll
    for (int i = 0; i < 8; ++i) { const bf16x8 v = *(const GAS bf16x8*)(vp + 8 * i);
#pragma unroll
        for (int e = 0; e < 8; ++e) vl[(64 * half + 8 * i + e) * NMEM + pk] = (unsigned short)v[e]; }
    __syncthreads();
    bf16* vo = F.VT + obase;
#pragma unroll
    for (int i = 0; i < 8; ++i) { const int id = tid + 512 * i; *(GAS v4u*)(vo + id * 8) = *(const LAS v4u*)(vl + id * 8); }
    __syncthreads();
}
__device__ __forceinline__ void gmlp_loads(Frame& F, int r0, int g, bf16x8 (&x)[4], v4u (&up)[4], float (&bp)[4]) {
    const int tid = F.tid, lane = F.lane; const bf16* Z = F.BIG;
    { const int row = tid >> 2, q = tid & 3; const bf16* vp = Z + (size_t)(r0 + row) * N_IN0 + 512 + g * 128 + 32 * q;
#pragma unroll
      for (int i = 0; i < 4; ++i) x[i] = __builtin_nontemporal_load((const GAS bf16x8*)(vp + 8 * i)); }
    const int tb = F.wave & 3, chh = F.wave >> 2;
#pragma unroll
    for (int i = 0; i < 4; ++i) { const int t = (lane >> 3) + 8 * i, ch = lane & 7, row = r0 + 32 * tb + t;
        up[i] = __builtin_nontemporal_load((const GAS v4u*)(Z + (size_t)row * N_IN0 + g * 128 + 64 * chh + 8 * ch)); bp[i] = F.in[18][g * 128 + 32 * tb + t]; }
}
__device__ __forceinline__ void gmlp_compute(Frame& F, int r0, int g, const bf16x8 (&x)[4], const v4u (&up)[4], const float (&bp)[4], bool has_next, bf16x8 (&nx)[4], v4u (&nup)[4], float (&nbp)[4]) {
    const int tid = F.tid, lane = F.lane, wid = F.wave, r32 = lane & 31, hi = lane >> 5;
    LAS unsigned char* vT = F.lds;
    __syncthreads();
    { const int row = tid >> 2, q = tid & 3; float ss = 0.f;
#pragma unroll
      for (int i = 0; i < 4; ++i)
#pragma unroll
          for (int e = 0; e < 8; ++e) { const float f = bf2f(x[i][e]); ss += f * f; }
      ss += __shfl_xor(ss, 1); ss += __shfl_xor(ss, 2);
      const float rstd = rsq(ss * (1.f / 128.f) + EPS);
      const float* gv = F.in[16] + g * 128 + 32 * q;
#pragma unroll
      for (int i = 0; i < 4; ++i)
#pragma unroll
          for (int e = 0; e < 8; e += 2) { const int c = 32 * q + 8 * i + e; const unsigned w = pk2h(bf2f(x[i][e]) * rstd * gv[8 * i + e], bf2f(x[i][e + 1]) * rstd * gv[8 * i + e + 1]);
              *(LAS unsigned short*)(vT + c * 272 + row * 2) = (unsigned short)(w & 0xffffu); *(LAS unsigned short*)(vT + (c + 1) * 272 + row * 2) = (unsigned short)(w >> 16); }
    }
    if (has_next) gmlp_loads(F, r0, g + 1, nx, nup, nbp);
    __syncthreads();
    const int tb = wid & 3, chh = wid >> 2;
    f32x16 acc[2]; acc[0] = f32x16{}; acc[1] = f32x16{};
    const bf16* Wg = F.WSP + (size_t)g * 128 * 128 + (size_t)(32 * tb + r32) * 128 + 8 * hi;
#pragma unroll
    for (int ks = 0; ks < 8; ++ks) { const bf16x8 bfr = *(const GAS bf16x8*)(Wg + 16 * ks);
#pragma unroll
        for (int c2 = 0; c2 < 2; ++c2) { const bf16x8 a = *(const LAS bf16x8*)(vT + (32 * (2 * chh + c2) + r32) * 272 + (16 * ks + 8 * hi) * 2);
            acc[c2] = __builtin_amdgcn_mfma_f32_32x32x16_bf16(a, bfr, acc[c2], 0, 0, 0); } }
    LAS unsigned char* stg = F.lds + 40960 + wid * (32 * 272);
#pragma unroll
    for (int c2 = 0; c2 < 2; ++c2)
#pragma unroll
        for (int g4 = 0; g4 < 4; ++g4) { const f32x4 v = (f32x4){acc[c2][4 * g4 + 0], acc[c2][4 * g4 + 1], acc[c2][4 * g4 + 2], acc[c2][4 * g4 + 3]};
            *(LAS f32x4*)(stg + r32 * 272 + (32 * c2 + 8 * g4 + 4 * hi) * 4) = v; }
    LDS_WAIT(); asm volatile("" ::: "memory");
#pragma unroll
    for (int i = 0; i < 4; ++i) { const int t = (lane >> 3) + 8 * i, ch = lane & 7, row = r0 + 32 * tb + t;
        const f32x4 s0 = *(const LAS f32x4*)(stg + t * 272 + ch * 32), s1 = *(const LAS f32x4*)(stg + t * 272 + ch * 32 + 16);
        const float bs = bp[i]; const v4u u = up[i];
        v4u o; o.x = pk2h(bfu2f(u.x & 0xffffu) * (s0.x + bs), bfu2f(u.x >> 16) * (s0.y + bs)); o.y = pk2h(bfu2f(u.y & 0xffffu) * (s0.z + bs), bfu2f(u.y >> 16) * (s0.w + bs));
        o.z = pk2h(bfu2f(u.z & 0xffffu) * (s1.x + bs), bfu2f(u.z >> 16) * (s1.y + bs)); o.w = pk2h(bfu2f(u.w & 0xffffu) * (s1.z + bs), bfu2f(u.w >> 16) * (s1.w + bs));
        *(GAS v4u*)(F.Y + (size_t)row * D + g * 128 + 64 * chh + 8 * ch) = o; }
}
__device__ __forceinline__ void gmlp_item(Frame& F, int blk) {
    const int r0 = blk * 128;
    bf16x8 xa[4], xb[4]; v4u ua[4], ub[4]; float ba[4], bb[4];
    gmlp_loads(F, r0, 0, xa, ua, ba);
    gmlp_compute(F, r0, 0, xa, ua, ba, true, xb, ub, bb);
    gmlp_compute(F, r0, 1, xb, ub, bb, true, xa, ua, ba);
    gmlp_compute(F, r0, 2, xa, ua, ba, true, xb, ub, bb);
    gmlp_compute(F, r0, 3, xb, ub, bb, false, xa, ua, ba);
}
__device__ __forceinline__ void mix1_phase(Frame& F) {
    const bf16* Z = F.BIG;
    const int tid = F.tid;
    for (int it = F.vcu; it < T / 128; it += F.G) {
        const int rc = it * 4 + (tid >> 7), cc = tid & 127, t0 = rc * 32, pos0 = t0 % SEQ;
        if (cc < 64) {
            const int w = 2 << (cc >> 4); const bf16* zp = Z + (size_t)t0 * Z1P + 8 * cc; bf16* yp = F.Y + (size_t)t0 * D + 8 * cc;
            float s[8];
#pragma unroll
            for (int e = 0; e < 8; ++e) s[e] = 0.f;
            for (int j = 1; j < w; ++j) if (pos0 - j >= 0) { const bf16x8 z = *(const GAS bf16x8*)(zp - (size_t)j * Z1P);
#pragma unroll
                for (int e = 0; e < 8; ++e) s[e] += bf2f(z[e]); }
            for (int i = 0; i < 32; ++i) { const int pos = pos0 + i; const bf16x8 z = *(const GAS bf16x8*)(zp + (size_t)i * Z1P);
                float zf[8];
#pragma unroll
                for (int e = 0; e < 8; ++e) { zf[e] = bf2f(z[e]); s[e] += zf[e]; }
                const float inv = 1.0f / (float)((pos + 1 < w) ? pos + 1 : w);
                v4u o; o.x = pk2h(s[0] * inv - zf[0], s[1] * inv - zf[1]); o.y = pk2h(s[2] * inv - zf[2], s[3] * inv - zf[3]); o.z = pk2h(s[4] * inv - zf[4], s[5] * inv - zf[5]); o.w = pk2h(s[6] * inv - zf[6], s[7] * inv - zf[7]);
                *(GAS v4u*)(yp + (size_t)i * D) = o;
                if (pos + 1 >= w) { const bf16x8 zo = *(const GAS bf16x8*)(zp + (long)(i - w + 1) * Z1P);
#pragma unroll
                    for (int e = 0; e < 8; ++e) s[e] -= bf2f(zo[e]); } }
        } else {
            const int c8 = (cc - 64) * 8; const bf16* xp = Z + (size_t)t0 * Z1P + 512 + c8; bf16* yp = F.Y + (size_t)t0 * D + 512 + c8;
            const float* cw = F.in[25];
            float w0[8], w1[8], w2[8], x1[8], x2[8];
#pragma unroll
            for (int e = 0; e < 8; ++e) { w0[e] = cw[c8 + e]; w1[e] = cw[512 + c8 + e]; w2[e] = cw[1024 + c8 + e]; x1[e] = 0.f; x2[e] = 0.f; }
            if (pos0 >= 2) { const bf16x8 a2 = *(const GAS bf16x8*)(xp - 2 * (size_t)Z1P), a1 = *(const GAS bf16x8*)(xp - (size_t)Z1P);
#pragma unroll
                for (int e = 0; e < 8; ++e) { x2[e] = bf2f(a2[e]); x1[e] = bf2f(a1[e]); } }
            for (int i = 0; i < 32; ++i) { const bf16* p = xp + (size_t)i * Z1P; const bf16x8 xv = __builtin_nontemporal_load((const GAS bf16x8*)p), gb = __builtin_nontemporal_load((const GAS bf16x8*)(p + 512));
                float y[8];
#pragma unroll
                for (int e = 0; e < 8; ++e) { const float x0 = bf2f(xv[e]); y[e] = bf2f(gb[e]) * (w0[e] * x2[e] + w1[e] * x1[e] + w2[e] * x0); x2[e] = x1[e]; x1[e] = x0; }
                v4u o; o.x = pk2h(y[0], y[1]); o.y = pk2h(y[2], y[3]); o.z = pk2h(y[4], y[5]); o.w = pk2h(y[6], y[7]);
                *(GAS v4u*)(yp + (size_t)i * D) = o; }
        }
    }
}
__device__ __forceinline__ void xa_attn_unit(Frame& F, int l, int pm, int pn) {
    const int b = pm / (SEQ / 256);
    for (int hh = 0; hh < 2; ++hh) {
        int tid = F.tid; asm volatile("" : "+v"(tid));
        const int lane = tid & 63, wid = F.wave, r32 = lane & 31, hi = lane >> 5;
        LAS unsigned char* Kl = F.lds; LAS unsigned char* Vl = F.lds + XA_KBYTES;
        const unsigned q = (unsigned)(pm * 256 + wid * 32 + r32);
        const int h = 2 * pn + hh;
        const bf16* Kg = F.KN + (size_t)((l * 4 + b) * 4 + h) * (NMEM * 128);
        const bf16* Vg = F.VT + (size_t)((l * 4 + b) * 4 + h) * (NMEM * 128);
        const bf16* Qp = F.XQ + (q * XAW + h * 128 + 8 * hi);
        bf16x8 qf[8];
#pragma unroll
        for (int ks = 0; ks < 8; ++ks) qf[ks] = *(const GAS bf16x8*)(Qp + 16 * ks);
        __syncthreads();
#pragma unroll
        for (int i = 0; i < 8; ++i) { const int id = tid + 512 * i, row = id >> 4, ch = id & 15; const v4u x = *(const GAS v4u*)(Kg + row * 128 + ch * 8); *(LAS v4u*)(Kl + row * XA_KROW + ch * 16) = x; }
#pragma unroll
        for (int i = 0; i < 8; ++i) { const int id = tid + 512 * i, row = id >> 5, ch = id & 31; const v4u x = *(const GAS v4u*)(Vg + row * 256 + ch * 8); *(LAS v4u*)(Vl + row * XA_VROW + ch * 16) = x; }
        float ss = 0.f;
#pragma unroll
        for (int ks = 0; ks < 8; ++ks)
#pragma unroll
            for (int e = 0; e < 8; ++e) { const float f = bf2f(qf[ks][e]); ss += f * f; }
        ss += __shfl_xor(ss, 32);
        const float sc = rsq(ss * (1.f / 128.f) + EPS) * XA_C2;
        const float* gq = F.in[8] + l * 128 + 8 * hi;
#pragma unroll
        for (int ks = 0; ks < 8; ++ks) { const f32x4 ga = *(const f32x4*)(gq + 16 * ks), gb = *(const f32x4*)(gq + 16 * ks + 4);
            v4u w; w.x = pk2(bf2f(qf[ks][0]) * sc * ga.x, bf2f(qf[ks][1]) * sc * ga.y); w.y = pk2(bf2f(qf[ks][2]) * sc * ga.z, bf2f(qf[ks][3]) * sc * ga.w);
            w.z = pk2(bf2f(qf[ks][4]) * sc * gb.x, bf2f(qf[ks][5]) * sc * gb.y); w.w = pk2(bf2f(qf[ks][6]) * sc * gb.z, bf2f(qf[ks][7]) * sc * gb.w);
            qf[ks] = __builtin_bit_cast(bf16x8, w); }
        __syncthreads();
        f32x16 s[8];
#pragma unroll
        for (int kvb = 0; kvb < 8; ++kvb) s[kvb] = f32x16{};
        const LAS unsigned char* kbase = Kl + r32 * XA_KROW + hi * 16;
        bf16x8 fa[4], fb[4];
#define XA_LDK(dst, st) do { _Pragma("unroll") for (int j_ = 0; j_ < 4; ++j_) dst[j_] = *(const LAS bf16x8*)(kbase + ((st) >> 1) * (32 * XA_KROW) + (4 * ((st) & 1) + j_) * 32); } while (0)
#define XA_MMK(src, st) do { _Pragma("unroll") for (int j_ = 0; j_ < 4; ++j_) s[(st) >> 1] = __builtin_amdgcn_mfma_f32_32x32x16_bf16(src[j_], qf[4 * ((st) & 1) + j_], s[(st) >> 1], 0, 0, 0); } while (0)
        XA_LDK(fa, 0);
#pragma unroll
        for (int st = 0; st < 16; st += 2) {
            XA_LDK(fb, st + 1); XA_MMK(fa, st); __builtin_amdgcn_sched_barrier(0);
            if (st + 2 < 16) XA_LDK(fa, st + 2);
            XA_MMK(fb, st + 1); __builtin_amdgcn_sched_barrier(0);
        }
#undef XA_LDK
#undef XA_MMK
        __syncthreads();
        float m = -INFINITY;
#pragma unroll
        for (int kvb = 0; kvb < 8; ++kvb)
#pragma unroll
            for (int r = 0; r < 16; ++r) m = fmaxf(m, s[kvb][r]);
        m = fmaxf(m, __shfl_xor(m, 32));
        float lsum = 0.f;
        bf16x8 pf[8][2];
#pragma unroll
        for (int kvb = 0; kvb < 8; ++kvb) {
#pragma unroll
            for (int r = 0; r < 16; ++r) { const float p = __builtin_amdgcn_exp2f(s[kvb][r] - m); s[kvb][r] = p; lsum += p; }
#pragma unroll
            for (int s2 = 0; s2 < 2; ++s2) { v4u w; w.x = pk2h(s[kvb][8 * s2 + 0], s[kvb][8 * s2 + 1]); w.y = pk2h(s[kvb][8 * s2 + 2], s[kvb][8 * s2 + 3]); w.z = pk2h(s[kvb][8 * s2 + 4], s[kvb][8 * s2 + 5]); w.w = pk2h(s[kvb][8 * s2 + 6], s[kvb][8 * s2 + 7]);
                pf[kvb][s2] = __builtin_bit_cast(bf16x8, w); } }
        lsum += __shfl_xor(lsum, 32);
        f32x16 o[4];
#pragma unroll
        for (int db = 0; db < 4; ++db) o[db] = f32x16{};
        const LAS unsigned char* vbase = Vl + r32 * XA_VROW + hi * 16;
#define XA_LDV(dst, st) do { _Pragma("unroll") for (int j_ = 0; j_ < 4; ++j_) dst[j_] = *(const LAS bf16x8*)(vbase + j_ * (32 * XA_VROW) + (st) * 32); } while (0)
#define XA_MMV(src, st) do { _Pragma("unroll") for (int j_ = 0; j_ < 4; ++j_) o[j_] = __builtin_amdgcn_mfma_f32_32x32x16_bf16(src[j_], pf[(st) >> 1][(st) & 1], o[j_], 0, 0, 0); } while (0)
        XA_LDV(fa, 0);
#pragma unroll
        for (int st = 0; st < 16; st += 2) {
            XA_LDV(fb, st + 1); XA_MMV(fa, st); __builtin_amdgcn_sched_barrier(0);
            if (st + 2 < 16) XA_LDV(fa, st + 2);
            XA_MMV(fb, st + 1); __builtin_amdgcn_sched_barrier(0);
        }
#undef XA_LDV
#undef XA_MMV
        LAS unsigned char* stg = Kl + wid * (32 * XA_KROW);
        if constexpr (MK_F8XO) {
            const float inv = F8_XOASCALE / lsum;
#pragma unroll
            for (int db = 0; db < 4; ++db)
#pragma unroll
                for (int g4 = 0; g4 < 4; ++g4) { const int d0 = 32 * db + 8 * g4 + 4 * hi;
                    *(LAS unsigned*)(stg + r32 * 144 + d0) = pg8::pk4_f8(o[db][4 * g4 + 0] * inv, o[db][4 * g4 + 1] * inv, o[db][4 * g4 + 2] * inv, o[db][4 * g4 + 3] * inv); }
            LDS_WAIT(); asm volatile("" ::: "memory");
            unsigned char* Ob8 = (unsigned char*)F.XO + ((unsigned)(pm * 256 + wid * 32) * XAW + h * 128);
#pragma unroll
            for (int i = 0; i < 4; ++i) { const int row = 8 * i + (lane >> 3), ch = lane & 7; const v4u v = *(const LAS v4u*)(stg + row * 144 + ch * 16); *(GAS v4u*)(Ob8 + row * XAW + ch * 16) = v; }
            continue;
        }
        const float inv = 1.0f / lsum;
#pragma unroll
        for (int db = 0; db < 4; ++db)
#pragma unroll
            for (int g4 = 0; g4 < 4; ++g4) { const int d0 = 32 * db + 8 * g4 + 4 * hi; u32x2 w; w.x = pk2(o[db][4 * g4 + 0] * inv, o[db][4 * g4 + 1] * inv); w.y = pk2(o[db][4 * g4 + 2] * inv, o[db][4 * g4 + 3] * inv);
                *(LAS u32x2*)(stg + r32 * XA_KROW + d0 * 2) = w; }
        LDS_WAIT(); asm volatile("" ::: "memory");
        bf16* Ob = F.XO + ((unsigned)(pm * 256 + wid * 32) * XAW + h * 128);
#pragma unroll
        for (int i = 0; i < 8; ++i) { const int row = 4 * i + (lane >> 4), ch = lane & 15; const v4u v = *(const LAS v4u*)(stg + row * XA_KROW + ch * 16); *(GAS v4u*)(Ob + row * XAW + ch * 8) = v; }
    }
}

constexpr int RS_OFF = 131072;
template <class Sched> __device__ __forceinline__ const LAS float* rs_prepare(Frame& F, const Sched& S) {
    LAS float* t = (LAS float*)(F.lds + RS_OFF);
    int p0 = -1, p1 = -1, p2 = -1, p3 = -1; pg8::Unit u;
    for (int i = 0; S.next(i, u); ++i) { const int pm = u.pm; if (pm == p0 || pm == p1 || pm == p2 || pm == p3) continue; if (p0 < 0) p0 = pm; else if (p1 < 0) p1 = pm; else if (p2 < 0) p2 = pm; else if (p3 < 0) p3 = pm; }
    __syncthreads();
    if (F.tid < 4) t[F.tid] = __builtin_bit_cast(float, F.tid == 0 ? p0 : F.tid == 1 ? p1 : F.tid == 2 ? p2 : p3);
#pragma unroll
    for (int pass = 0; pass < 2; ++pass) { const int sl = 2 * pass + (F.tid >> 8); const int pm = sl == 0 ? p0 : sl == 1 ? p1 : sl == 2 ? p2 : p3;
        if (pm >= 0) t[16 + 256 * sl + (F.tid & 255)] = pg8::row_rstd(F.SSQ, pm * 256 + (F.tid & 255)); }
    __syncthreads();
    return t;
}

struct Args { cfp_t in[27]; float* out; unsigned char* ws; int ph_lo, ph_hi, li, pad; };
#define MKFRAME() do { int t_; asm volatile("v_mbcnt_lo_u32_b32 %0, -1, 0\n\tv_mbcnt_hi_u32_b32 %0, -1, %0\n\tv_lshl_add_u32 %0, %1, 6, %0" : "=&v"(t_) : "s"(wave_s));     \
    const __attribute__((address_space(4))) Args* ap_ = (const __attribute__((address_space(4))) Args*)__builtin_amdgcn_kernarg_segment_ptr(); asm volatile("" : "+s"(ap_)); unsigned char* ws_ = ap_->ws; \
    F.lds = (LAS unsigned char*)lds; F.MISC = (volatile LAS unsigned*)(F.lds + MISC_OFF); \
    F.tid = t_; F.lane = F.tid & 63; F.wave = __builtin_amdgcn_readfirstlane(F.tid >> 6); \
    F.G = gridDim.x; { const int bx = blockIdx.x; F.vcu = (F.G % 8 == 0) ? (bx % 8) * (F.G / 8) + bx / 8 : bx; } \
    F.ws = ws_; F.in = ap_->in; F.x = ap_->in[0]; F.out = ap_->out; F.ctl = (gu32*)(ws_ + WS_CTL); \
    F.XB = (bf16*)(ws_ + WS_XB); F.Y = (bf16*)(ws_ + WS_Y); F.XQ = (bf16*)(ws_ + WS_XQ); F.XO = (bf16*)(ws_ + WS_XO); F.BIG = (bf16*)(ws_ + WS_BIG); \
    F.MEMN = (bf16*)(ws_ + WS_MEMN); F.KVRAW = (bf16*)(ws_ + WS_KVRAW); F.KN = (bf16*)(ws_ + WS_KN); F.VT = (bf16*)(ws_ + WS_VT); F.WSP = (bf16*)(ws_ + WS_WSP); \
    F.LOGF = (float*)(ws_ + WS_LOGF); F.CUM = (float*)(ws_ + WS_CUM); F.SSQ = (float*)(ws_ + WS_SSQ); } while (0)
#define GRID_BAR() do { if (N_LAUNCHES == 1) { MKFRAME(); XcdBarrier b_; b_.bar = (unsigned*)(F.ctl + CW_BAR); b_.x = xb_xcc_id(); b_.st = F.MISC + 8; xcd_barrier(b_, F.tid); } } while (0)
#define IN(k) (lo <= (k) && (k) < hi)
#ifdef PROBE_PHASE
#define PROBE_REPS(k) (((k) == PROBE_PHASE) ? 2 : 1)
#else
#define PROBE_REPS(k) 1
#endif
#ifdef PROBE_XA_PHASE
#define PROBE_XA(k) (((k) == PROBE_XA_PHASE) ? 2 : 1)
#else
#define PROBE_XA(k) 1
#endif
#ifdef PROBE_EPI_PHASE
#define PROBE_EPI(k) (((k) == PROBE_EPI_PHASE) ? 2 : 1)
#else
#define PROBE_EPI(k) 1
#endif
#define BOTH(k) (IN(k) && IN((k) + 1))
template <int l> __device__ __forceinline__ void layer_phases(const int lo, const int hi, const int wave_s) {
    extern __shared__ __attribute__((aligned(16))) unsigned char lds[];
    Frame F; unsigned char* ws;
        const int pb = (l == 0) ? PH_IN0 : PH_IN1;
        if (IN(pb)) for (int rep_ = 0; rep_ < PROBE_REPS(pb); ++rep_) { MKFRAME(); ws = F.ws;
            if (l == 0) {
                if (blockIdx.x < 32) cumsum_seq(F, blockIdx.x);
                { pg8::Gemm g{F.XB, (const bf16*)(ws + WS_WIN0), T, N_IN0, D}; pg8::StaticOrder S; S.init(T, N_IN0, F.G, (int)blockIdx.x);
                  pg8::EpiIn0 E{F.BIG, N_IN0, rs_prepare(F, S), F.in[19], F.in[20], FOX_C2};
                  pg8::gemm_phase<pg8::EpiIn0, pg8::StaticOrder, PG8_ALIGN, PG8_SP2>(F.lds + RING_OFF, g, S, E, F.tid); }
            } else {
                pg8::Gemm g{F.XB, (const bf16*)(ws + WS_WIN1), T, N_IN1, D}; pg8::StaticOrder S; S.init(T, N_IN1, F.G, (int)blockIdx.x);
                pg8::EpiIn1 E{F.BIG, Z1P, rs_prepare(F, S)};
                pg8::gemm_phase<pg8::EpiIn1, pg8::StaticOrder, PG8_ALIGN, PG8_SP2>(F.lds + RING_OFF, g, S, E, F.tid);
            }
            if (BOTH(pb)) GRID_BAR();
        }
        if (IN(pb + 1)) for (int rep_ = 0; rep_ < PROBE_REPS(pb + 1); ++rep_) { MKFRAME(); ws = F.ws;
            if (l == 0) {
                for (;;) {
                    MKFRAME();
                    volatile LAS unsigned* mail = F.MISC + 16;
                    __syncthreads();
                    if (F.tid == 0) mail[0] = __hip_atomic_fetch_add((unsigned*)(F.ctl + CW_Q0), 1u, __ATOMIC_RELAXED, __HIP_MEMORY_SCOPE_AGENT);
                    __syncthreads();
                    const int it = __builtin_amdgcn_readfirstlane((int)mail[0]);
                    if (it >= 32 + 1024 + 256) break;
                    if (it < 32) {
                        const int l2 = it >> 4;
                        pg8::Gemm g{F.MEMN, lw(F, l2, L_WKV), MROWS, D, D}; pg8::OneUnit S; S.u.pm = (it >> 2) & 3; S.u.pn = it & 3;
                        pg8::EpiPlain E{F.KVRAW + (size_t)l2 * MROWS * D, D, nullptr};
                        pg8::gemm_phase<pg8::EpiPlain, pg8::OneUnit, PG8_ALIGN, PG8_SP2>(F.lds + RING_OFF, g, S, E, F.tid);
                    } else if (it >= 32 + 256) {
                        const int j = it - (32 + 256), hh = 7 - (j >> 7), qb = 31 - ((j & 127) >> 2), b = j & 3;
                        float th;
                        { const float gm = fabsf(F.in[19][F.lane] * F.in[20][F.lane]); float mx = gm;
        #pragma unroll
                          for (int o = 1; o < 64; o <<= 1) mx = fmaxf(mx, __shfl_xor(mx, o));
                          th = 2.0f * (64.0f * FOX_C2 * mx * 1.02f) + 40.0f; }
                        attn_body::attn_unit<8>(b, hh, qb, (const attn_body::bf16*)(F.BIG + 1024), (const attn_body::bf16*)(F.BIG + 1536), (const attn_body::bf16*)(F.BIG + 2048), (attn_body::bf16*)(F.Y + 512), F.CUM, th, (char*)lds + RING_OFF, F.tid);
                    } else {
                        const int blk = it - 32;
                        gmlp_item(F, blk);
                    }
                }
            } else {
                mix1_phase(F);
            }
            if (BOTH(pb + 1)) GRID_BAR();
        }
        if (IN(pb + 2)) for (int rep_ = 0; rep_ < PROBE_REPS(pb + 2); ++rep_) { MKFRAME(); ws = F.ws;
            if (l == 0 && blockIdx.x < 32) xa_kv_finalize(F, blockIdx.x);
            pg8::Gemm g{F.Y, (const bf16*)(ws + (l == 0 ? WS_WOUT0 : WS_WOUT1)), T, D, D}; pg8::StaticOrder S; S.init(T, D, F.G, (int)blockIdx.x);
            pg8::EpiRes E{nullptr, F.XB, nullptr, F.SSQ, D, 1.0f};
            pg8::gemm_phase<pg8::EpiRes, pg8::StaticOrder, PG8_ALIGN, PG8_SP2>(F.lds + RING_OFF, g, S, E, F.tid, PROBE_EPI(pb + 2));
            if (BOTH(pb + 2)) GRID_BAR();
        }
        if (IN(pb + 3)) for (int rep_ = 0; rep_ < PROBE_REPS(pb + 3); ++rep_) { MKFRAME(); ws = F.ws;
            pg8::Gemm g{F.XB, lw(F, l, L_WQ), T, XAW, D}; pg8::StaticOrder S; S.init(T, XAW, F.G, (int)blockIdx.x);
            pg8::EpiPlain E{F.XQ, XAW, rs_prepare(F, S)};
            pg8::gemm_phase<pg8::EpiPlain, pg8::StaticOrder, PG8_ALIGN, PG8_SP2>(F.lds + RING_OFF, g, S, E, F.tid);
            VM_WAIT(); __syncthreads();
            __builtin_amdgcn_fence(__ATOMIC_ACQUIRE, "agent"); VM_WAIT(); __syncthreads();
            pg8::Unit u;
            for (int i = 0; S.next(i, u); ++i) for (int xr_ = 0; xr_ < PROBE_XA(pb + 3); ++xr_) xa_attn_unit(F, l, u.pm, u.pn);
            if (BOTH(pb + 3)) GRID_BAR();
        }
        if (IN(pb + 4)) for (int rep_ = 0; rep_ < PROBE_REPS(pb + 4); ++rep_) { MKFRAME(); ws = F.ws;
            constexpr bool f8 = MK_F8XO != 0;
            pg8::Gemm g{F.XO, lw(F, l, L_WO), T, D, f8 ? XAW / 2 : XAW}; pg8::StaticOrder S; S.init(T, D, F.G, (int)blockIdx.x);
            pg8::EpiResT<f8> E{nullptr, F.XB, nullptr, F.SSQ, D, f8 ? 1.0f / (F8_XOASCALE * F8_XOWSCALE) : 1.0f};
            pg8::gemm_phase<pg8::EpiResT<f8>, pg8::StaticOrder, PG8_ALIGN, PG8_SP2>(F.lds + RING_OFF, g, S, E, F.tid);
            if (BOTH(pb + 4)) GRID_BAR();
        }
        if (IN(pb + 5)) for (int rep_ = 0; rep_ < PROBE_REPS(pb + 5); ++rep_) { MKFRAME(); ws = F.ws;
            pg8::Gemm g{F.XB, lw(F, l, L_WGU), T, 2 * DFF, D}; pg8::StaticOrder S; S.init(T, 2 * DFF, F.G, (int)blockIdx.x);
            constexpr bool f8 = (MK_F8DN >> l) & 1;
            pg8::EpiSwigluT<f8> E{F.BIG, DFF, rs_prepare(F, S), F8_HSCALE};
            pg8::gemm_phase<pg8::EpiSwigluT<f8>, pg8::StaticOrder, PG8_ALIGN, PG8_SP2>(F.lds + RING_OFF, g, S, E, F.tid, PROBE_EPI(pb + 5));
            if (BOTH(pb + 5)) GRID_BAR();
        }
        if (IN(pb + 6)) for (int rep_ = 0; rep_ < PROBE_REPS(pb + 6); ++rep_) { MKFRAME(); ws = F.ws;
            constexpr bool f8 = (MK_F8DN >> l) & 1;
            pg8::Gemm g{F.BIG, lw(F, l, L_WD), T, D, f8 ? DFF / 2 : DFF}; pg8::StaticOrder S; S.init(T, D, F.G, (int)blockIdx.x);
            pg8::EpiResT<f8> E{nullptr, F.XB, l == 0 ? nullptr : F.out, F.SSQ, D, 1.0f / (F8_HSCALE * F8_WSCALE)};
            pg8::gemm_phase<pg8::EpiResT<f8>, pg8::StaticOrder, PG8_ALIGN, PG8_SP2>(F.lds + RING_OFF, g, S, E, F.tid);
            if (BOTH(pb + 6)) GRID_BAR();
        }
    }
__global__ void __launch_bounds__(NWAVES * 64, 2) mk_fwd(Args args) {
    extern __shared__ __attribute__((aligned(16))) unsigned char lds[];
    int wave_s = __builtin_amdgcn_readfirstlane((int)threadIdx.x >> 6); asm volatile("" : "+s"(wave_s));
    Frame F;
    MKFRAME();
    for (int u = F.tid; u < (LDS_BYTES - LDSCTL_OFF) / 4; u += NWAVES * 64) ((LAS unsigned*)(F.lds + LDSCTL_OFF))[u] = 0u;
    __syncthreads();
    if (N_LAUNCHES == 1) (void)xcd_barrier_post((unsigned*)(F.ctl + CW_BAR), F.MISC + 8, F.tid);
    const int lo = args.ph_lo, hi = args.ph_hi;
    if (IN(PH_PRO)) for (int rep_ = 0; rep_ < PROBE_REPS(PH_PRO); ++rep_) { MKFRAME(); p0_prologue(F); if (BOTH(PH_PRO)) GRID_BAR(); }
    layer_phases<0>(lo, hi, wave_s);
    layer_phases<1>(lo, hi, wave_s);
#ifdef PROBE_BARS
    for (int pb_ = 0; pb_ < PROBE_BARS; ++pb_) { MKFRAME(); GRID_BAR(); }
#endif
}
#undef MKFRAME
#undef IN
#undef BOTH
#undef GRID_BAR

extern "C" void kernel_launch(void* const* d_in, const int* in_sizes, int n_in, void* d_out, int out_size, void* d_ws, size_t ws_size, hipStream_t stream) {
    static int grid = 0;
    if (grid == 0) {
        if (n_in != 27 || in_sizes[0] != T * D || out_size != T * D || ws_size < WS_END) { fprintf(stderr, "kernel_launch: built for 27 inputs, x and out of %d floats, >= %zu bytes of workspace; got n_in %d, in0 %d, out %d, ws %zu; nothing launched\n", T * D, (size_t)WS_END, n_in, n_in > 0 ? in_sizes[0] : -1, out_size, ws_size); grid = -1; return; }
        int dev = 0, cus = 0, per_cu = 0;
        if (hipGetDevice(&dev) != hipSuccess || hipDeviceGetAttribute(&cus, hipDeviceAttributeMultiprocessorCount, dev) != hipSuccess) { fprintf(stderr, "kernel_launch: hipGetDevice / hipDeviceGetAttribute failed; nothing launched\n"); grid = -1; return; }
        if (hipFuncSetAttribute((const void*)mk_fwd, hipFuncAttributeMaxDynamicSharedMemorySize, LDS_BYTES) != hipSuccess) { fprintf(stderr, "kernel_launch: hipFuncSetAttribute failed\n"); grid = -1; return; }
        if (hipOccupancyMaxActiveBlocksPerMultiprocessor(&per_cu, (const void*)mk_fwd, NWAVES * 64, LDS_BYTES) != hipSuccess || per_cu < 1)
            fprintf(stderr, "kernel_launch: note: the occupancy query reports %d workgroups per CU\n", per_cu);
        (void)hipGetLastError();
        grid = cus;
        if (grid != 256) fprintf(stderr, "kernel_launch: %d CUs; the attention schedule is built for 256\n", grid);
    }
    if (grid < 0) return;
    if (hipMemsetAsync((char*)d_ws + WS_CTL, 0, CTL_ZERO_BYTES, stream) != hipSuccess) { fprintf(stderr, "kernel_launch: hipMemsetAsync of the control words failed; nothing launched\n"); return; }
    Args a{};
    for (int i = 0; i < 27; ++i) a.in[i] = (const float*)d_in[i];
    a.out = (float*)d_out; a.ws = (unsigned char*)d_ws;
    for (int li = 0; li < N_LAUNCHES; ++li) {
        a.ph_lo = (N_LAUNCHES == 1) ? 0 : li; a.ph_hi = (N_LAUNCHES == 1) ? N_PHASES : li + 1; a.li = li;
        hipLaunchKernelGGL(mk_fwd, dim3(grid), dim3(NWAVES * 64), LDS_BYTES, stream, a);
        const hipError_t le = hipPeekAtLastError();
        if (le != hipSuccess) { fprintf(stderr, "kernel_launch: launch %d failed: %s\n", li, hipGetErrorName(le)); break; }
    }
}
```

```cpp
#include <hip/hip_runtime.h>
#include <cstdio>
#include <cstdint>
namespace pg8 {
#define PG8_LAS __attribute__((address_space(3)))
typedef unsigned short bf16_t;
typedef short bf16x8 __attribute__((ext_vector_type(8)));
typedef float f32x4 __attribute__((ext_vector_type(4)));
typedef float f32x2 __attribute__((ext_vector_type(2)));
typedef unsigned u32x4 __attribute__((ext_vector_type(4)));
typedef unsigned u32x2 __attribute__((ext_vector_type(2)));
typedef int i32x4 __attribute__((ext_vector_type(4)));
typedef int i32x8 __attribute__((ext_vector_type(8)));
constexpr int BM = 256, BK = 64, HALF = 128, HTB = HALF * BK * 2  , STAGE_BYTES = 8 * HTB, NXCD = 8, WGM = 8;

__host__ __device__ __forceinline__ int lds_byte(int r, int c) { const int st = (r >> 4) * 2 + (c >> 5), rr = r & 15, cc = c & 31, ob = rr * 64 + cc * 2; return st * 1024 + (ob ^ (((ob >> 9) & 1) << 5)); }
__host__ __device__ __forceinline__ void stage_rc(int b, int& R, int& C) { const int st = b / 1024, sb = b % 1024, swz = sb ^ (((sb >> 9) & 1) << 5); R = (st >> 1) * 16 + swz / 64; C = (st & 1) * 32 + (swz % 64) / 2; }
__host__ __device__ __forceinline__ int perm32(int rho) { const int n = rho >> 4, i = rho & 15; return 8 * (i >> 2) + 4 * n + (i & 3); }

struct Unit { int pm, pn; };
struct Gemm { const bf16_t* A; const bf16_t* Bt; int M, N, K; };

struct StaticOrder {
    int nM, nN, nwg, G, c;
    __host__ __device__ __forceinline__ void init(int M, int N, int G_, int c_) { nM = M / BM; nN = N / BM; nwg = nM * nN; G = G_; c = c_; }
    __host__ __device__ __forceinline__ bool next(int i, Unit& u) const {
        const long L = (long)i * G + c; if (L >= nwg) return false;
        int wgid = (int)L; { const int q = nwg / NXCD, r = nwg % NXCD, xcd = wgid % NXCD, off = wgid / NXCD; wgid = (xcd < r ? xcd * (q + 1) : r * (q + 1) + (xcd - r) * q) + off; }
        const int nig = WGM * nN, gid = wgid / nig, fm = gid * WGM, gsz = (nM - fm) < WGM ? (nM - fm) : WGM;
        u.pm = fm + ((wgid % nig) % gsz); u.pn = (wgid % nig) / gsz; return true;
    }
    __device__ __forceinline__ void a_ready(const Unit&) const {}
    __device__ __forceinline__ void done(const Unit&) const {}
};
struct OneUnit { Unit u;
    __device__ __forceinline__ bool next(int i, Unit& o) const { if (i != 0) return false; o = u; return true; }
    __device__ __forceinline__ void a_ready(const Unit&) const {}
    __device__ __forceinline__ void done(const Unit&) const {}
};

__device__ __forceinline__ unsigned cvt_pk_bf16(float lo, float hi) { unsigned r; asm volatile("v_cvt_pk_bf16_f32 %0, %1, %2" : "=v"(r) : "v"(lo), "v"(hi)); return r; }
__device__ __forceinline__ u32x4 pack8(const f32x4 a, const f32x4 b) { u32x4 w; w.x = cvt_pk_bf16(a[0], a[1]); w.y = cvt_pk_bf16(a[2], a[3]); w.z = cvt_pk_bf16(b[0], b[1]); w.w = cvt_pk_bf16(b[2], b[3]); return w; }
constexpr float RMS_EPS = 1e-6f;
__device__ __forceinline__ float row_rstd(const float* ssq, int row) {
    const f32x4* p = (const f32x4*)(ssq + (size_t)row * 16);
    const f32x4 a = p[0], b = p[1], c = p[2], d = p[3];
    const float s = (((a[0] + a[1]) + (a[2] + a[3])) + ((b[0] + b[1]) + (b[2] + b[3]))) + (((c[0] + c[1]) + (c[2] + c[3])) + ((d[0] + d[1]) + (d[2] + d[3])));
    return __builtin_amdgcn_rsqf(s * (1.0f / 1024.0f) + RMS_EPS);
}
struct RsTab { const PG8_LAS float* t;
    __device__ __forceinline__ int slot(int pm) const { int s = 0;
#pragma unroll
        for (int k = 1; k < 4; ++k) s = (__builtin_bit_cast(int, t[k]) == pm) ? k : s; return s; }
    __device__ __forceinline__ float get(int slot, int r) const { return t[16 + 256 * slot + r]; }
};
__device__ __forceinline__ void ssq4(f32x2& s2, const f32x4 x) { const f32x2 lo = {x[0], x[1]}, hi = {x[2], x[3]}; s2 += lo * lo; s2 += hi * hi; }
__device__ __forceinline__ float sigmoid_fast(float t) { return __builtin_amdgcn_rcpf(1.0f + __builtin_amdgcn_exp2f(-1.4426950408889634f * t)); }
__device__ __forceinline__ float gelu_tanh(float x) { const float t = 1.5957691216057308f * (x + 0.044715f * x * x * x); return x * sigmoid_fast(t); }
__device__ __forceinline__ float silu_f(float x) { return x * sigmoid_fast(x); }

struct EpiPlain {
    static constexpr bool PERM = true, AFTER_DRAIN = false, F8 = false; static constexpr int NVM = 16;
    bf16_t* O; int ldc; const PG8_LAS float* rst;
    __device__ __forceinline__ void operator()(const f32x4 (&acc)[2][2][4][2], const Unit& u, int wr, int wc, int fr, int fq) const {
        const int row0 = u.pm * BM + wr * 64 + fr, col0 = u.pn * BM + wc * 32 + 8 * fq;
        const RsTab R{rst}; const int rsl = rst ? R.slot(u.pm) : 0;
#pragma unroll
        for (int ai = 0; ai < 2; ++ai)
#pragma unroll
            for (int m = 0; m < 4; ++m) { const int row = row0 + ai * HALF + m * 16; const float rs = rst ? R.get(rsl, ai * HALF + wr * 64 + m * 16 + fr) : 1.0f; bf16_t* rowp = O + (size_t)row * ldc + col0;
#pragma unroll
                for (int bj = 0; bj < 2; ++bj) *(u32x4*)(rowp + bj * HALF) = pack8(acc[ai][bj][m][0] * rs, acc[ai][bj][m][1] * rs); }
    }
};
struct EpiIn0 {
    static constexpr bool PERM = true, AFTER_DRAIN = false, F8 = false; static constexpr int NVM = 16;
    bf16_t* O; int ldc; const PG8_LAS float* rst; const float* gq; const float* gk; float qscale;
    __device__ __forceinline__ void operator()(const f32x4 (&acc)[2][2][4][2], const Unit& u, int wr, int wc, int fr, int fq) const {
        const int row0 = u.pm * BM + wr * 64 + fr; const int pn = u.pn;
        const bool headed = (pn >= 4 && pn < 8);
        const RsTab R{rst}; const int rsl = R.slot(u.pm);
        f32x4 gn[2][2];
#pragma unroll
        for (int bj = 0; bj < 2; ++bj)
#pragma unroll
            for (int n = 0; n < 2; ++n) { gn[bj][n] = (f32x4){1.f, 1.f, 1.f, 1.f};
                if (pn == 4 || pn == 5) { const int d = 32 * bj + 8 * fq + 4 * n; const f32x4 a = *(const f32x4*)(gq + d), b = *(const f32x4*)(gk + d); gn[bj][n] = a * b * qscale; } }
#pragma unroll
        for (int ai = 0; ai < 2; ++ai)
#pragma unroll
            for (int m = 0; m < 4; ++m) { const int row = row0 + ai * HALF + m * 16; const float rs = R.get(rsl, ai * HALF + wr * 64 + m * 16 + fr);
                f32x4 v[2][2];
#pragma unroll
                for (int bj = 0; bj < 2; ++bj)
#pragma unroll
                    for (int n = 0; n < 2; ++n) v[bj][n] = acc[ai][bj][m][n] * rs;
                if (pn < 4) {
#pragma unroll
                    for (int bj = 0; bj < 2; ++bj)
#pragma unroll
                        for (int n = 0; n < 2; ++n) { const f32x4 x = v[bj][n]; const f32x4 in = (x * x) * 0.044715f + 1.0f; const f32x4 tt = (x * in) * (-1.5957691216057308f * 1.4426950408889634f);
                            f32x4 ex;
#pragma unroll
                            for (int e = 0; e < 4; ++e) ex[e] = __builtin_amdgcn_exp2f(tt[e]);
                            const f32x4 d = ex + 1.0f; f32x4 r;
#pragma unroll
                            for (int e = 0; e < 4; ++e) r[e] = __builtin_amdgcn_rcpf(d[e]);
                            v[bj][n] = x * r; }
                } else if (headed) {
                    f32x2 s2 = {0.f, 0.f};
#pragma unroll
                    for (int bj = 0; bj < 2; ++bj)
#pragma unroll
                        for (int n = 0; n < 2; ++n) ssq4(s2, v[bj][n]);
                    float ss = s2[0] + s2[1];
                    ss += __shfl_xor(ss, 16); ss += __shfl_xor(ss, 32);
                    const float r = __builtin_amdgcn_rsqf(ss * (1.0f / 64.0f) + RMS_EPS);
#pragma unroll
                    for (int bj = 0; bj < 2; ++bj)
#pragma unroll
                        for (int n = 0; n < 2; ++n) v[bj][n] = v[bj][n] * r * gn[bj][n];
                }
                bf16_t* rowp = O + (size_t)row * ldc + pn * BM + 8 * fq;
#pragma unroll
                for (int bj = 0; bj < 2; ++bj) { const int c = headed ? (64 * wc + 32 * bj) : (128 * bj + 32 * wc); *(u32x4*)(rowp + c) = pack8(v[bj][0], v[bj][1]); } }
    }
};
struct EpiIn1 {
    static constexpr bool PERM = true, AFTER_DRAIN = false, F8 = false; static constexpr int NVM = 8;
    bf16_t* O; int ldc; const PG8_LAS float* rst;
    __device__ __forceinline__ void operator()(const f32x4 (&acc)[2][2][4][2], const Unit& u, int wr, int wc, int fr, int fq) const {
        const int row0 = u.pm * BM + wr * 64 + fr; const int pn = u.pn;
        const RsTab R{rst}; const int rsl = R.slot(u.pm);
        const bool pair = (pn >= 2 && pn < 6);
        const int cbase = pair ? 512 + 128 * (pn - 2) + wc * 32 + 8 * fq : (pn < 2 ? 256 * pn : 1024 + 256 * (pn - 6)) + wc * 32 + 8 * fq;
#pragma unroll
        for (int ai = 0; ai < 2; ++ai)
#pragma unroll
            for (int m = 0; m < 4; ++m) { const int row = row0 + ai * HALF + m * 16; const float rs = R.get(rsl, ai * HALF + wr * 64 + m * 16 + fr); bf16_t* rowp = O + (size_t)row * ldc + cbase;
                if (pair) { const float r2 = rs * rs; *(u32x4*)rowp = pack8(acc[ai][0][m][0] * acc[ai][1][m][0] * r2, acc[ai][0][m][1] * acc[ai][1][m][1] * r2); }
                else {
#pragma unroll
                    for (int bj = 0; bj < 2; ++bj) *(u32x4*)(rowp + bj * HALF) = pack8(acc[ai][bj][m][0] * rs, acc[ai][bj][m][1] * rs); } }
    }
};
__device__ __forceinline__ float clamp_f8(float v) { return __builtin_amdgcn_fmed3f(v, -448.0f, 448.0f); }
__device__ __forceinline__ unsigned pk4_f8(float a, float b, float c, float d) { int r = __builtin_amdgcn_cvt_pk_fp8_f32(clamp_f8(a), clamp_f8(b), 0, false); r = __builtin_amdgcn_cvt_pk_fp8_f32(clamp_f8(c), clamp_f8(d), r, true); return (unsigned)r; }
template <bool OUT8> struct EpiSwigluT {
    static constexpr bool PERM = true, AFTER_DRAIN = false, F8 = false; static constexpr int NVM = 8;
    bf16_t* O; int ldc; const PG8_LAS float* rst; float hscale;
    __device__ __forceinline__ void operator()(const f32x4 (&acc)[2][2][4][2], const Unit& u, int wr, int wc, int fr, int fq) const {
        const int row0 = u.pm * BM + wr * 64 + fr, col0 = u.pn * HALF + wc * 32 + 8 * fq;
        const RsTab R{rst}; const int rsl = R.slot(u.pm);
#pragma unroll
        for (int ai = 0; ai < 2; ++ai)
#pragma unroll
            for (int m = 0; m < 4; ++m) { const int row = row0 + ai * HALF + m * 16; const float rs = R.get(rsl, ai * HALF + wr * 64 + m * 16 + fr);
                const float c1 = -1.4426950408889634f * rs, rs2 = OUT8 ? rs * rs * hscale : rs * rs;
                f32x4 o[2];
#pragma unroll
                for (int n = 0; n < 2; ++n) { const f32x4 g = acc[ai][0][m][n], up = acc[ai][1][m][n];
                    const f32x4 t = g * c1; f32x4 ex;
#pragma unroll
                    for (int e = 0; e < 4; ++e) ex[e] = __builtin_amdgcn_exp2f(t[e]);
                    const f32x4 d = ex + 1.0f; f32x4 r;
#pragma unroll
                    for (int e = 0; e < 4; ++e) r[e] = __builtin_amdgcn_rcpf(d[e]);
                    o[n] = ((g * up) * rs2) * r; }
                if constexpr (OUT8) { u32x2 w; w.x = pk4_f8(o[0][0], o[0][1], o[0][2], o[0][3]); w.y = pk4_f8(o[1][0], o[1][1], o[1][2], o[1][3]);
                    __builtin_nontemporal_store(w, (u32x2*)((unsigned char*)O + (size_t)row * ldc + col0)); }
                else __builtin_nontemporal_store(pack8(o[0], o[1]), (u32x4*)(O + (size_t)row * ldc + col0)); }
    }
};
__device__ __forceinline__ f32x4 bf_lo4(const u32x4 w) { return (f32x4){__builtin_bit_cast(float, w.x << 16), __builtin_bit_cast(float, w.x & 0xffff0000u), __builtin_bit_cast(float, w.y << 16), __builtin_bit_cast(float, w.y & 0xffff0000u)}; }
__device__ __forceinline__ f32x4 bf_hi4(const u32x4 w) { return (f32x4){__builtin_bit_cast(float, w.z << 16), __builtin_bit_cast(float, w.z & 0xffff0000u), __builtin_bit_cast(float, w.w << 16), __builtin_bit_cast(float, w.w & 0xffff0000u)}; }
typedef __bf16 bf16x2_t __attribute__((ext_vector_type(2)));
__device__ __forceinline__ float dot2bf(unsigned w, float c) { const bf16x2_t v = __builtin_bit_cast(bf16x2_t, w); return __builtin_amdgcn_fdot2_f32_bf16(v, v, c, false); }
template <bool F8_> struct EpiResT {
    static constexpr bool PERM = true, AFTER_DRAIN = false, F8 = F8_; static constexpr int NVM = 16;
    const float* base32; bf16_t* xb; float* out32; float* ssq; int ldc; float ascale;
    __device__ __forceinline__ void operator()(const f32x4 (&acc)[2][2][4][2], const Unit& u, int wr, int wc, int fr, int fq) const {
        const int row0 = u.pm * BM + wr * 64 + fr, col0 = u.pn * BM + wc * 32 + 8 * fq;
        u32x4 pre[2][4][2];
        if (!base32) {
#pragma unroll
            for (int ai = 0; ai < 2; ++ai)
#pragma unroll
                for (int m = 0; m < 4; ++m)
#pragma unroll
                    for (int bj = 0; bj < 2; ++bj) pre[ai][m][bj] = *(const u32x4*)(xb + (size_t)(row0 + ai * HALF + m * 16) * ldc + col0 + bj * HALF);
        }
#pragma unroll
        for (int ai = 0; ai < 2; ++ai) {
#pragma unroll
            for (int m = 0; m < 4; ++m) { const int row = row0 + ai * HALF + m * 16; const size_t off = (size_t)row * ldc + col0;
                f32x4 v[2][2]; float ss = 0.f;
#pragma unroll
                for (int bj = 0; bj < 2; ++bj) {
                    f32x4 b0, b1;
                    if (base32) { b0 = *(const f32x4*)(base32 + off + bj * HALF); b1 = *(const f32x4*)(base32 + off + bj * HALF + 4); }
                    else { b0 = bf_lo4(pre[ai][m][bj]); b1 = bf_hi4(pre[ai][m][bj]); }
                    if constexpr (F8_) { v[bj][0] = b0 + acc[ai][bj][m][0] * ascale; v[bj][1] = b1 + acc[ai][bj][m][1] * ascale; } else { v[bj][0] = b0 + acc[ai][bj][m][0]; v[bj][1] = b1 + acc[ai][bj][m][1]; }
                }
                if (out32) {
#pragma unroll
                    for (int bj = 0; bj < 2; ++bj) { *(f32x4*)(out32 + off + bj * HALF) = v[bj][0]; *(f32x4*)(out32 + off + bj * HALF + 4) = v[bj][1]; }
                } else {
                    float sq = 0.f;
#pragma unroll
                    for (int bj = 0; bj < 2; ++bj) { const u32x4 w = pack8(v[bj][0], v[bj][1]); *(u32x4*)(xb + off + bj * HALF) = w;
                        sq = dot2bf(w.x, sq); sq = dot2bf(w.y, sq); sq = dot2bf(w.z, sq); sq = dot2bf(w.w, sq); }
                    ss = sq;
                    ss += __shfl_xor(ss, 16); ss += __shfl_xor(ss, 32);
                    if (fq == 0) ssq[(size_t)row * 16 + 4 * u.pn + wc] = ss; }
            }
            asm volatile("" ::: "memory");
        }
    }
};
using EpiRes = EpiResT<false>;

#ifndef PG8_ZOPAQUE
#define PG8_ZOPAQUE 1
#endif
#ifndef PG8_F8SCALE
#define PG8_F8SCALE 0
#endif
__device__ __forceinline__ i32x8 cat8(const bf16x8 a, const bf16x8 b) { const i32x4 x = __builtin_bit_cast(i32x4, a), y = __builtin_bit_cast(i32x4, b); return __builtin_shufflevector(x, y, 0, 1, 2, 3, 4, 5, 6, 7); }
template <class Epi, class Sched, bool ALIGN_EPI = false, bool SP2 = false>
__device__ __forceinline__ void gemm_phase(PG8_LAS unsigned char* lds, const Gemm g, const Sched& S, const Epi& E, const int tid_in, const int epi_reps = 1) {
    int tid_ = tid_in; asm volatile("" : "+v"(tid_));
    const int tid = tid_, wid = __builtin_amdgcn_readfirstlane(tid >> 6), lane = tid & 63, wr = wid >> 2, wc = wid & 3, fr = lane & 15, fq = lane >> 4;
    const int K = g.K, nt = K / BK;
    unsigned voffA[2], voffB[2];
#pragma unroll
    for (int i = 0; i < 2; ++i) { int R, C; stage_rc(tid * 16 + i * 8192, R, C); const int Rb = Epi::PERM ? ((R & ~31) + perm32(R & 31)) : R;
        voffA[i] = (unsigned)(R * K + C) * 2u; voffB[i] = (unsigned)(Rb * K + C) * 2u; }
    const size_t kstep = (size_t)(BK * 2);
    const size_t hstep = (size_t)HALF * K * 2;
    const size_t tstep = 2 * hstep;
    const unsigned ldsw = (unsigned)wid * 1024u;
    const unsigned ldsb = (unsigned)__builtin_amdgcn_readfirstlane((int)((unsigned)(uintptr_t)lds + ldsw));
    const int aoff = lds_byte(wr * 64 + fr, fq * 8), boff = lds_byte(wc * 32 + fr, fq * 8);
#define PG8_SA(b, h) (((b) * 2 + (h)) * HTB)
#define PG8_SB(b, h) ((4 + (b) * 2 + (h)) * HTB)
#define PG8_STAGE(bufoff, gbase, voff) do { _Pragma("unroll") for (int _i = 0; _i < 2; ++_i) { unsigned keep_; \
        asm volatile("s_nop 4\n\ts_mov_b32 %0, m0\n\ts_mov_b32 m0, %2\n\ts_nop 0\n\tglobal_load_lds_dwordx4 %1, %3\n\ts_mov_b32 m0, %0" : "=&s"(keep_) \
            : "v"((voff)[_i]), "s"(ldsb + (unsigned)((bufoff) + _i * 8192)), "s"((const char*)(gbase)) : "memory"); } } while (0)
#define PG8_LDA(dst, b, h) do { _Pragma("unroll") for (int m = 0; m < 4; ++m) _Pragma("unroll") for (int k = 0; k < 2; ++k) dst[m][k] = *(const PG8_LAS bf16x8*)(lds + PG8_SA(b, h) + aoff + m * 2048 + k * 1024); } while (0)
#define PG8_LDB(dst, b, h) do { _Pragma("unroll") for (int n = 0; n < 2; ++n) _Pragma("unroll") for (int k = 0; k < 2; ++k) dst[n][k] = *(const PG8_LAS bf16x8*)(lds + PG8_SB(b, h) + boff + n * 2048 + k * 1024); } while (0)
#define PG8_MMA(ai, bj, At, Bt) do { __builtin_amdgcn_s_setprio(1); _Pragma("unroll") for (int m = 0; m < 4; ++m) _Pragma("unroll") for (int n = 0; n < 2; ++n) { \
        if constexpr (Epi::F8) acc[ai][bj][m][n] = __builtin_amdgcn_mfma_scale_f32_16x16x128_f8f6f4(cat8(Bt[n][0], Bt[n][1]), cat8(At[m][0], At[m][1]), acc[ai][bj][m][n], 0, 0, 0, PG8_F8SCALE, 0, PG8_F8SCALE); \
        else { _Pragma("unroll") for (int k = 0; k < 2; ++k) acc[ai][bj][m][n] = __builtin_amdgcn_mfma_f32_16x16x32_bf16(Bt[n][k], At[m][k], acc[ai][bj][m][n], 0, 0, 0); } } __builtin_amdgcn_s_setprio(0); } while (0)
#define PG8_WAIT_V(n) asm volatile("s_waitcnt vmcnt(" #n ")" ::: "memory")
#define PG8_WAIT_L(n) asm volatile("s_waitcnt lgkmcnt(" #n ")" ::: "memory")
#define PG8_WAIT_VF() asm volatile("s_waitcnt vmcnt(%0)" :: "n"(8 + Epi::NVM) : "memory")
#define PG8_TRIP_SP2(W12) do { \
            PG8_LDB(B0, 0, 0); PG8_LDB(B1, 0, 1); PG8_SCHED; PG8_LDA(At, 0, 0); PG8_STAGE(PG8_SA(1, 1), a1 + hstep, voffA); \
            W12; PG8_WAIT_L(0); PG8_BAR; PG8_MMA(0, 0, At, B0); PG8_MMA(0, 1, At, B1); PG8_BAR; PG8_SCHED; \
            PG8_LDA(At, 0, 1); PG8_STAGE(PG8_SB(0, 0), b2, voffB); PG8_STAGE(PG8_SB(0, 1), b2 + hstep, voffB); PG8_STAGE(PG8_SA(0, 0), a2, voffA); \
            W12; PG8_WAIT_L(0); PG8_BAR; PG8_MMA(1, 0, At, B0); PG8_MMA(1, 1, At, B1); PG8_BAR; PG8_SCHED; \
            PG8_LDB(B0, 1, 0); PG8_LDB(B1, 1, 1); PG8_SCHED; PG8_LDA(At, 1, 0); PG8_STAGE(PG8_SA(0, 1), a2 + hstep, voffA); \
            PG8_WAIT_V(8); PG8_WAIT_L(0); PG8_BAR; PG8_MMA(0, 0, At, B0); PG8_MMA(0, 1, At, B1); PG8_BAR; PG8_SCHED; \
            PG8_LDA(At, 1, 1); PG8_STAGE(PG8_SB(1, 0), b3, voffB); PG8_STAGE(PG8_SB(1, 1), b3 + hstep, voffB); PG8_STAGE(PG8_SA(1, 0), a3, voffA); \
            PG8_WAIT_V(8); PG8_WAIT_L(0); PG8_BAR; PG8_MMA(1, 0, At, B0); PG8_MMA(1, 1, At, B1); PG8_BAR; PG8_SCHED; } while (0)
#define PG8_BAR __builtin_amdgcn_s_barrier()
#define PG8_SCHED __builtin_amdgcn_sched_barrier(0)
    Unit cur, nxt; int ui = 0;
    if (!S.next(0, cur)) return;
    f32x4 acc[2][2][4][2];
#pragma unroll
    for (int a = 0; a < 2; ++a)
#pragma unroll
        for (int b = 0; b < 2; ++b)
#pragma unroll
            for (int m = 0; m < 4; ++m)
#pragma unroll
                for (int n = 0; n < 2; ++n) acc[a][b][m][n] = (f32x4){0.f, 0.f, 0.f, 0.f};
    bf16x8 At[4][2], B0[2][2], B1[2][2];
    const char* cA = (const char*)g.A + (size_t)cur.pm * tstep; const char* cB = (const char*)g.Bt + (size_t)cur.pn * tstep;
    S.a_ready(cur);
    if constexpr (SP2) {
        PG8_STAGE(PG8_SB(0, 0), cB, voffB); PG8_STAGE(PG8_SB(0, 1), cB + hstep, voffB); PG8_STAGE(PG8_SA(0, 0), cA, voffA); PG8_STAGE(PG8_SA(0, 1), cA + hstep, voffA);
        if (wr == 1) PG8_BAR;
        PG8_WAIT_V(2); PG8_BAR;
        PG8_STAGE(PG8_SB(1, 0), cB + kstep, voffB); PG8_STAGE(PG8_SA(1, 0), cA + kstep, voffA); PG8_STAGE(PG8_SB(1, 1), cB + hstep + kstep, voffB);
        PG8_WAIT_V(6); PG8_BAR;
    } else {
        PG8_STAGE(PG8_SB(0, 0), cB, voffB); PG8_STAGE(PG8_SA(0, 0), cA, voffA); PG8_STAGE(PG8_SB(0, 1), cB + hstep, voffB); PG8_STAGE(PG8_SA(0, 1), cA + hstep, voffA);
        if (wr == 1) PG8_BAR;
        PG8_WAIT_V(4); PG8_BAR;
        PG8_STAGE(PG8_SB(1, 0), cB + kstep, voffB); PG8_STAGE(PG8_SA(1, 0), cA + kstep, voffA); PG8_STAGE(PG8_SB(1, 1), cB + hstep + kstep, voffB);
        PG8_WAIT_V(6); PG8_BAR;
    }
    for (;;) {
        const bool has_next = S.next(ui + 1, nxt);
        const char* nA = has_next ? (const char*)g.A + (size_t)nxt.pm * tstep : cA; const char* nB = has_next ? (const char*)g.Bt + (size_t)nxt.pn * tstep : cB;
        int t = 0;
        if constexpr (SP2) { if (ui > 0) {
            const char* a1 = cA + kstep; const char* a2 = cA + 2 * kstep; const char* b2 = cB + 2 * kstep; const char* a3 = a2 + kstep; const char* b3 = b2 + kstep;
            PG8_TRIP_SP2(PG8_WAIT_VF()); t = 2; } }
        for (; t < nt; t += 2) {
            const bool last = (t == nt - 2);
            const char* a1 = cA + (size_t)(t + 1) * kstep;
            const char* a2 = last ? nA : cA + (size_t)(t + 2) * kstep; const char* b2 = last ? nB : cB + (size_t)(t + 2) * kstep;
            const char* a3 = a2 + kstep; const char* b3 = b2 + kstep;
            if (last && has_next) S.a_ready(nxt);
            if constexpr (SP2) {
            PG8_LDB(B0, 0, 0); PG8_LDB(B1, 0, 1); PG8_SCHED; PG8_LDA(At, 0, 0); PG8_STAGE(PG8_SA(1, 1), a1 + hstep, voffA);
            PG8_WAIT_V(8); PG8_WAIT_L(0); PG8_BAR; PG8_MMA(0, 0, At, B0); PG8_MMA(0, 1, At, B1); PG8_BAR; PG8_SCHED;
            PG8_LDA(At, 0, 1); PG8_STAGE(PG8_SB(0, 0), b2, voffB); PG8_STAGE(PG8_SB(0, 1), b2 + hstep, voffB); PG8_STAGE(PG8_SA(0, 0), a2, voffA);
            PG8_WAIT_V(8); PG8_WAIT_L(0); PG8_BAR; PG8_MMA(1, 0, At, B0); PG8_MMA(1, 1, At, B1); PG8_BAR; PG8_SCHED;
            PG8_LDB(B0, 1, 0); PG8_LDB(B1, 1, 1); PG8_SCHED; PG8_LDA(At, 1, 0); PG8_STAGE(PG8_SA(0, 1), a2 + hstep, voffA);
            PG8_WAIT_V(8); PG8_WAIT_L(0); PG8_BAR; PG8_MMA(0, 0, At, B0); PG8_MMA(0, 1, At, B1); PG8_BAR; PG8_SCHED;
            PG8_LDA(At, 1, 1); PG8_STAGE(PG8_SB(1, 0), b3, voffB); PG8_STAGE(PG8_SB(1, 1), b3 + hstep, voffB); PG8_STAGE(PG8_SA(1, 0), a3, voffA);
            PG8_WAIT_V(8); PG8_WAIT_L(0); PG8_BAR; PG8_MMA(1, 0, At, B0); PG8_MMA(1, 1, At, B1); PG8_BAR; PG8_SCHED;
            } else {
            PG8_LDB(B0, 0, 0); PG8_SCHED; PG8_LDA(At, 0, 0); PG8_STAGE(PG8_SA(1, 1), a1 + hstep, voffA);
            PG8_WAIT_L(8); PG8_BAR; PG8_WAIT_L(0); PG8_MMA(0, 0, At, B0); PG8_BAR; PG8_SCHED;
            PG8_LDB(B1, 0, 1); PG8_STAGE(PG8_SB(0, 0), b2, voffB);
            PG8_BAR; PG8_WAIT_L(0); PG8_MMA(0, 1, At, B1); PG8_BAR;
            PG8_LDA(At, 0, 1); PG8_STAGE(PG8_SA(0, 0), a2, voffA);
            PG8_BAR; PG8_WAIT_L(0); PG8_MMA(1, 0, At, B0); PG8_BAR; PG8_SCHED;
            PG8_STAGE(PG8_SB(0, 1), b2 + hstep, voffB);
            PG8_WAIT_V(6); PG8_BAR; PG8_MMA(1, 1, At, B1); PG8_BAR;
            PG8_LDB(B0, 1, 0); PG8_SCHED; PG8_LDA(At, 1, 0); PG8_STAGE(PG8_SA(0, 1), a2 + hstep, voffA);
            PG8_WAIT_L(8); PG8_BAR; PG8_WAIT_L(0); PG8_MMA(0, 0, At, B0); PG8_BAR; PG8_SCHED;
            PG8_LDB(B1, 1, 1); PG8_STAGE(PG8_SB(1, 0), b3, voffB);
            PG8_BAR; PG8_WAIT_L(0); PG8_MMA(0, 1, At, B1); PG8_BAR;
            PG8_LDA(At, 1, 1); PG8_STAGE(PG8_SA(1, 0), a3, voffA);
            PG8_BAR; PG8_WAIT_L(0); PG8_MMA(1, 0, At, B0); PG8_BAR; PG8_SCHED;
            PG8_STAGE(PG8_SB(1, 1), b3 + hstep, voffB);
            PG8_WAIT_V(6); PG8_BAR; PG8_MMA(1, 1, At, B1); PG8_BAR;
            }
        }
        if constexpr (ALIGN_EPI) { if (wr == 0) PG8_BAR; }
        if constexpr (!Epi::AFTER_DRAIN) { int ln_; asm volatile("v_mbcnt_lo_u32_b32 %0, -1, 0\n\tv_mbcnt_hi_u32_b32 %0, -1, %0" : "=v"(ln_)); const int fr_ = ln_ & 15, fq_ = ln_ >> 4;
            for (int er_ = 0; er_ < epi_reps; ++er_) E(acc, cur, wr, wc, fr_, fq_); S.done(cur); }
        if (!has_next) break;
        { float z_ = 0.f; if (PG8_ZOPAQUE) asm volatile("" : "+v"(z_));
#pragma unroll
        for (int a = 0; a < 2; ++a)
#pragma unroll
            for (int b = 0; b < 2; ++b)
#pragma unroll
                for (int m = 0; m < 4; ++m)
#pragma unroll
                    for (int n = 0; n < 2; ++n) acc[a][b][m][n] = (f32x4){z_, z_, z_, z_}; }
        cur = nxt; cA = nA; cB = nB; ++ui;
        if constexpr (ALIGN_EPI) { if (wr == 1) PG8_BAR; }
    }
    PG8_WAIT_V(0);
    if constexpr (!ALIGN_EPI) { if (wr == 0) PG8_BAR; }
    PG8_BAR;
    if constexpr (Epi::AFTER_DRAIN) { E.fused(acc, cur, wr, wc, fr, fq, lds, wid, lane); S.done(cur); }
#undef PG8_SA
#undef PG8_SB
#undef PG8_STAGE
#undef PG8_LDA
#undef PG8_LDB
#undef PG8_MMA
#undef PG8_WAIT_V
#undef PG8_WAIT_L
#undef PG8_WAIT_VF
#undef PG8_TRIP_SP2
#undef PG8_BAR
#undef PG8_SCHED
}
}

#ifndef PG8_SP2
#define PG8_SP2 true
#endif
#ifndef PG8_ALIGN
#define PG8_ALIGN true
#endif
#include <hip/hip_bf16.h>
#include <cmath>
namespace attn_body {
using bf16=__hip_bfloat16;
using bf16x8=__attribute__((ext_vector_type(8)))short;
using s16x4=__attribute__((ext_vector_type(4)))short;
using f32x16=__attribute__((ext_vector_type(16)))float;
using u32x4=__attribute__((ext_vector_type(4)))unsigned;
constexpr int BATCH=4,NHEAD=8,SEQ=8192,D=64,PQ=2560,PO=1024;
constexpr int NW=8,QBLK=32,QB=QBLK*NW,KVBLK=64,NQB=SEQ/QB;
constexpr int ATTN_UNIT_ROWS=QB;
__device__ __forceinline__ int crow(int r,int hi){return (r&3)+8*(r>>2)+4*hi;}
#define SBAR() __builtin_amdgcn_sched_barrier(0)
__device__ __forceinline__ void cmask(f32x16&p0,f32x16&p1,int jb,int qrel,int hi){
  const float NEG=-INFINITY; int kb=64*jb+4*hi;
  #pragma unroll
  for(int r=0;r<16;++r){int kv=kb+(r&3)+8*(r>>2); if(kv>qrel)p0[r]=NEG; if(kv+32>qrel)p1[r]=NEG;}
}

constexpr int NSLOT=3, SLOTB=8192;
constexpr int LDS_K=0, LDS_V=NSLOT*SLOTB, LDS_WS=2*NSLOT*SLOTB, LDS_OST=LDS_WS+NW*64*4, LDS_CT=LDS_OST+NW*4096+2048, LDS_BYTES=LDS_CT+SEQ*4;
constexpr float C2=0.125f*1.4426950408889634f;
__device__ __forceinline__ void glds16(const void*sbase,unsigned voff,unsigned lds_dst){unsigned keep;
  asm volatile("s_nop 4\n\ts_mov_b32 %0, m0\n\ts_mov_b32 m0, %2\n\ts_nop 0\n\tglobal_load_lds_dwordx4 %1, %3\n\ts_mov_b32 m0, %0":"=&s"(keep):"v"(voff),"s"(lds_dst),"s"(sbase):"memory");}
__device__ __forceinline__ float max3f(float a,float b,float c){float r;asm("v_max3_f32 %0, %1, %2, %3":"=v"(r):"v"(a),"v"(b),"v"(c));return r;}
__device__ __forceinline__ float max2f(float a,float b){float r;asm("v_max_f32_e32 %0, %1, %2":"=v"(r):"v"(a),"v"(b));return r;}
__device__ __forceinline__ float fadd_s(float a,float b){float r;asm("v_add_f32_e32 %0, %1, %2":"=v"(r):"v"(a),"v"(b));return r;}
__device__ __forceinline__ float fsub_s(float a,float b){float r;asm("v_sub_f32_e32 %0, %1, %2":"=v"(r):"v"(a),"v"(b));return r;}
typedef float f32x2_t __attribute__((ext_vector_type(2))); typedef float f32x4_t __attribute__((ext_vector_type(4))); typedef __bf16 bf16x2_t __attribute__((ext_vector_type(2)));
__device__ __forceinline__ unsigned cvtpk_s(float lo,float hi){f32x2_t v={lo,hi};bf16x2_t b=__builtin_convertvector(v,bf16x2_t);return __builtin_bit_cast(unsigned,b);}
#define WAIT_BAR(N) asm volatile("s_waitcnt vmcnt(" #N ") lgkmcnt(0)\n\ts_barrier":::"memory")

__device__ __forceinline__ void qkt(f32x16&p0,f32x16&p1,const char*Kslot,const bf16x8*qr,const f32x16&negm,int r32,int hi){
  const char*kb=Kslot+hi*1024+r32*16;
  #pragma unroll
  for(int d0=0;d0<4;++d0){
    const bf16x8 b0=*reinterpret_cast<const bf16x8*>(kb+d0*2048);
    const bf16x8 b1=*reinterpret_cast<const bf16x8*>(kb+d0*2048+512);
    if(d0==0){p0=__builtin_amdgcn_mfma_f32_32x32x16_bf16(b0,qr[0],negm,0,0,0);p1=__builtin_amdgcn_mfma_f32_32x32x16_bf16(b1,qr[0],negm,0,0,0);}
    else{p0=__builtin_amdgcn_mfma_f32_32x32x16_bf16(b0,qr[d0],p0,0,0,0);p1=__builtin_amdgcn_mfma_f32_32x32x16_bf16(b1,qr[d0],p1,0,0,0);}}
}
typedef __attribute__((address_space(3))) const char* lds_cptr;
typedef short v4i16_t __attribute__((ext_vector_type(4)));
__device__ __forceinline__ void kload8(bf16x8*kf,lds_cptr kp){
  kf[0]=*(const __attribute__((address_space(3))) bf16x8*)(kp);      kf[1]=*(const __attribute__((address_space(3))) bf16x8*)(kp+512);
  kf[2]=*(const __attribute__((address_space(3))) bf16x8*)(kp+2048); kf[3]=*(const __attribute__((address_space(3))) bf16x8*)(kp+2560);
  kf[4]=*(const __attribute__((address_space(3))) bf16x8*)(kp+4096); kf[5]=*(const __attribute__((address_space(3))) bf16x8*)(kp+4608);
  kf[6]=*(const __attribute__((address_space(3))) bf16x8*)(kp+6144); kf[7]=*(const __attribute__((address_space(3))) bf16x8*)(kp+6656);
}
__device__ __forceinline__ void kload2(bf16x8*kf,lds_cptr kp,int j){ kf[2*j]=*(const __attribute__((address_space(3))) bf16x8*)(kp+j*2048); kf[2*j+1]=*(const __attribute__((address_space(3))) bf16x8*)(kp+j*2048+512); }
__device__ __forceinline__ s16x4 vtr(lds_cptr p){ return __builtin_bit_cast(s16x4,__builtin_amdgcn_ds_read_tr16_b64_v4i16((__attribute__((address_space(3))) v4i16_t*)p)); }
__device__ __forceinline__ float rowmax(const f32x16&p0,const f32x16&p1){
  float a=max3f(p0[0],p0[1],p1[0]),b=max3f(p0[2],p0[3],p1[1]);a=max3f(a,p1[2],p1[3]);
  #pragma unroll
  for(int r=4;r<16;r+=4){a=max3f(a,p0[r],p0[r+1]);b=max3f(b,p0[r+2],p0[r+3]);a=max3f(a,p1[r],p1[r+1]);b=max3f(b,p1[r+2],p1[r+3]);}
  const float m=max2f(a,b);
  auto rr=__builtin_amdgcn_permlane32_swap(__float_as_uint(m),__float_as_uint(m),false,false);
  return max2f(__uint_as_float(rr[0]),__uint_as_float(rr[1]));
}
__device__ __forceinline__ void pv(f32x16*o,int vb,bf16x8 pa0,bf16x8 pa1,bf16x8 pa2,bf16x8 pa3){
  #pragma unroll
  for(int d0=0;d0<2;++d0){s16x4 lo[4],hi[4];
    #pragma unroll
    for(int ks=0;ks<4;++ks){
      asm volatile("ds_read_b64_tr_b16 %0,%1 offset:%c2":"=&v"(lo[ks]):"v"(vb),"i"(d0*4096+ks*1024):"memory");
      asm volatile("ds_read_b64_tr_b16 %0,%1 offset:%c2":"=&v"(hi[ks]):"v"(vb),"i"(d0*4096+ks*1024+512):"memory");}
    asm volatile("s_waitcnt lgkmcnt(0)":::"memory");SBAR();
    #define PK(k) (bf16x8){lo[k][0],lo[k][1],lo[k][2],lo[k][3],hi[k][0],hi[k][1],hi[k][2],hi[k][3]}
    o[d0]=__builtin_amdgcn_mfma_f32_32x32x16_bf16(pa0,PK(0),o[d0],0,0,0);
    o[d0]=__builtin_amdgcn_mfma_f32_32x32x16_bf16(pa1,PK(1),o[d0],0,0,0);
    o[d0]=__builtin_amdgcn_mfma_f32_32x32x16_bf16(pa2,PK(2),o[d0],0,0,0);
    o[d0]=__builtin_amdgcn_mfma_f32_32x32x16_bf16(pa3,PK(3),o[d0],0,0,0);
    #undef PK
  }
}

#ifndef ATTN_STORE16
#define ATTN_STORE16(p,v) (*(u32x4*)(p)=(v))
#endif
template<int THRL> __device__ __forceinline__ void attn_unit(int b,int h,int qb,const bf16*Q,const bf16*__restrict__ K,const bf16*__restrict__ V,bf16*O,const float*__restrict__ CT,const float TH,char*shm,const int tid_in){
  int tid_=tid_in; asm volatile("":"+v"(tid_)); const int tid=tid_,lane=tid&63,r32=lane&31,hi=lane>>5; const int wid=__builtin_amdgcn_readfirstlane(tid>>6);
  const long rowbase=(long)b*SEQ; const int q0=qb*QB;
  const bf16*Qw=Q+(rowbase+q0+wid*QBLK)*PQ+h*D;
  const float*ctg=CT+(long)(b*NHEAD+h)*SEQ;
  int t0;
  { const int NTf=(q0+QB)/KVBLK; const float cq0=ctg[q0];
    const bool k0=(lane>=NTf-4)||!(cq0-ctg[64*lane+63]<-TH);
    const int l1=lane+64; const bool k1=(l1>=NTf-4)||!(cq0-ctg[64*(l1<NTf?l1:NTf-1)+63]<-TH);
    const unsigned long long m0=__ballot(k0),m1=__ballot(k1);
    const int first=m0?__builtin_ctzll(m0):64+(m1?__builtin_ctzll(m1):63);
    t0=__builtin_amdgcn_readfirstlane(first)&~1; if(t0>NTf-4)t0=NTf-4; }
  const int tbase=t0*KVBLK;
  const bf16*Kh=K+(rowbase+tbase)*PQ+h*D,*Vh=V+(rowbase+tbase)*PQ+h*D;
  const unsigned lds0=(unsigned)(uintptr_t)shm;
  float*wsf=(float*)(shm+LDS_WS)+wid*64;
  const unsigned koff=(unsigned)(lane*PQ+wid*8)*2u;
  const unsigned voff=(unsigned)((16*(wid&3)+(lane>>2))*PQ+(wid>>2)*32+(lane&3)*8)*2u;
  const unsigned kdst=lds0+LDS_K+wid*1024, vdst=lds0+LDS_V+wid*1024;
  #define DMA_K(t,slot) glds16(Kh+(long)(t)*KVBLK*PQ,koff,(unsigned)__builtin_amdgcn_readfirstlane(kdst+(slot)))
  #define DMA_V(t,slot) glds16(Vh+(long)(t)*KVBLK*PQ,voff,(unsigned)__builtin_amdgcn_readfirstlane(vdst+(slot)))
  const int vb0=(int)(lds0+LDS_V)+((lane>>4)&1)*32+(lane&3)*8+(4*hi+((lane&15)>>2))*64;
  const char*Kbase=shm+LDS_K; bf16x8 kf[8];
  const lds_cptr shm3=(lds_cptr)shm; const lds_cptr kp0=shm3+LDS_K+hi*1024+r32*16; const lds_cptr vp0=shm3+LDS_V+((lane>>4)&1)*32+(lane&3)*8+(4*hi+((lane&15)>>2))*64;
  const int NT=(q0+QB)/KVBLK-t0;
  { typedef __attribute__((address_space(3))) u32x4 lv4; const u32x4*src=(const u32x4*)(ctg+tbase); lv4*dst=(lv4*)(shm3+LDS_CT); const int n4=(q0+QB-tbase)/4;
    for(int i=tid;i<n4;i+=NW*64)dst[i]=src[i]; }
  const float ctl=ctg[q0+wid*QBLK+r32];
  const __attribute__((address_space(3))) float*ctab=(const __attribute__((address_space(3))) float*)(shm3+LDS_CT)+4*hi;
  DMA_K(0,0);DMA_V(0,0);DMA_K(1,SLOTB);
  bf16x8 qr[4];
  #pragma unroll
  for(int d0=0;d0<4;++d0)qr[d0]=*reinterpret_cast<const bf16x8*>(&Qw[(long)r32*PQ+d0*16+hi*8]);
  float mhat=-ctl,l_reg=0.f;     f32x16 o[2];o[0]=f32x16{};o[1]=f32x16{};f32x16 negm;
  _Pragma("unroll") for(int r=0;r<16;++r)negm[r]=ctl; asm volatile("":"+v"(negm));
  #define CBIAS(C0,C1,t) do{ const __attribute__((address_space(3))) float*tb_=ctab+64*(t); \
    _Pragma("unroll") for(int g_=0;g_<4;++g_){ const f32x4_t a_=*(const __attribute__((address_space(3))) f32x4_t*)(tb_+8*g_), b_=*(const __attribute__((address_space(3))) f32x4_t*)(tb_+32+8*g_); \
      _Pragma("unroll") for(int e_=0;e_<4;++e_){ C0[4*g_+e_]-=a_[e_]; C1[4*g_+e_]-=b_[e_]; } } }while(0)
  const int qrel=wid*QBLK+r32;
  #define CMASK(P0,P1,t) do{int jb_=(t)-(NT-4); if(jb_>=0)cmask(P0,P1,jb_,qrel,hi);}while(0)
  bool resc=false;
  #define START(P0,P1) do{ const float rm=rowmax(P0,P1); resc=false; \
    { const float dl=rm; mhat=fadd_s(mhat,dl); \
      _Pragma("unroll") for(int r=0;r<16;++r){P0[r]=fsub_s(P0[r],dl);P1[r]=fsub_s(P1[r],dl);} \
      _Pragma("unroll") for(int r=0;r<16;++r)negm[r]=-mhat; asm volatile("":"+v"(negm)); } \
    _Pragma("unroll") for(int r=0;r<16;++r)P0[r]=__builtin_amdgcn_exp2f(P0[r]); }while(0)
  #define RESC() do{ if(resc){ asm volatile("s_waitcnt lgkmcnt(0)":::"memory"); \
      _Pragma("unroll") for(int d_=0;d_<2;++d_) _Pragma("unroll") for(int r=0;r<16;++r)o[d_][r]*=wsf[crow(r,hi)]; } }while(0)
  f32x16 pA0,pA1,pB0,pB1;
  int sl_prev=0,sl_cur=0,sl_next=SLOTB;
  #define ROT() do{sl_prev=sl_cur;sl_cur=sl_next;sl_next=(sl_next==(NSLOT-1)*SLOTB)?0:sl_next+SLOTB;}while(0)
  DMA_K(2,2*SLOTB);
  WAIT_BAR(3);
  qkt(pA0,pA1,Kbase,qr,negm,r32,hi);asm volatile("s_nop 15\n\ts_nop 7":"+v"(pA0),"+v"(pA1));CBIAS(pA0,pA1,0);asm volatile("s_nop 1":"+v"(pA0),"+v"(pA1));CMASK(pA0,pA1,0);
  START(pA0,pA1);
  _Pragma("unroll") for(int r=0;r<16;++r)pA1[r]=__builtin_amdgcn_exp2f(pA1[r]);
  WAIT_BAR(0);
  DMA_K(3,0);DMA_V(1,SLOTB);
  ROT();
  kload8(kf,kp0+sl_cur);
  WAIT_BAR(2);
  s16x4 vlo[8],vhi[8]; u32x4 pw0,pw1,pw2,pw3;
  #define PKW(P,B) cvtpk_s(P[B],P[B+1])
  #define PAF(k) __builtin_bit_cast(bf16x8,pw##k)
  #define VFR(i) (bf16x8){vlo[i][0],vlo[i][1],vlo[i][2],vlo[i][3],vhi[i][0],vhi[i][1],vhi[i][2],vhi[i][3]}
  #define PIN(x) asm volatile("":"+v"(x))
  #define MX3(a,b,c) __builtin_fmaxf(__builtin_fmaxf((a),(b)),(c))
  #define GAPA(MF,A0,A1,A2,A3,W0,W1,PW) do{ MF; sacc+=A0; sacc+=A1; sacc+=A2; sacc+=A3; PIN(sacc); W0; W1; PIN(PW); SBAR(); }while(0)
  #define EX(v) __builtin_amdgcn_exp2f(v)
  #define GAPB(MF,X,B) do{ MF; X[B]=EX(X[B]); X[B+1]=EX(X[B+1]); X[B+2]=EX(X[B+2]); X[B+3]=EX(X[B+3]); PIN(X); SBAR(); }while(0)
  #define VRD(i) do{ vlo[i]=vtr(vp_+(((i)>>2)*4096+((i)&3)*1024)); vhi[i]=vtr(vp_+(((i)>>2)*4096+((i)&3)*1024+512)); }while(0)
  #define KRD(G,j) do{ if(G){ kload2(kf,kp0+sl_next,j); SBAR(); } }while(0)
  #define STEP(C0,C1,P0,P1,t,GK,GV,GL) do{ SBAR(); \
    const lds_cptr vp_=vp0+sl_prev; \
    VRD(0); SBAR(); float sacc=(P0[0]+P0[1]); \
    GAPA(C0=__builtin_amdgcn_mfma_f32_32x32x16_bf16(kf[0],qr[0],negm,0,0,0), P0[2],P0[3],P0[4],P0[5],     pw0[0]=PKW(P0,0), pw0[1]=PKW(P0,2), pw0); \
    VRD(4); SBAR(); GAPA(C1=__builtin_amdgcn_mfma_f32_32x32x16_bf16(kf[1],qr[0],negm,0,0,0), P0[6],P0[7],P0[8],P0[9],     pw0[2]=PKW(P0,4), pw0[3]=PKW(P0,6), pw0); \
    VRD(1); SBAR(); GAPA(C0=__builtin_amdgcn_mfma_f32_32x32x16_bf16(kf[2],qr[1],C0,0,0,0),   P0[10],P0[11],P0[12],P0[13], pw1[0]=PKW(P0,8), pw1[1]=PKW(P0,10), pw1); \
    VRD(5); SBAR(); GAPA(C1=__builtin_amdgcn_mfma_f32_32x32x16_bf16(kf[3],qr[1],C1,0,0,0),   P0[14],P0[15],P1[0],P1[1],   pw1[2]=PKW(P0,12),pw1[3]=PKW(P0,14), pw1); \
    VRD(2); SBAR(); GAPA(C0=__builtin_amdgcn_mfma_f32_32x32x16_bf16(kf[4],qr[2],C0,0,0,0),   P1[2],P1[3],P1[4],P1[5],     pw2[0]=PKW(P1,0), pw2[1]=PKW(P1,2), pw2); \
    VRD(6); SBAR(); GAPA(C1=__builtin_amdgcn_mfma_f32_32x32x16_bf16(kf[5],qr[2],C1,0,0,0),   P1[6],P1[7],P1[8],P1[9],     pw2[2]=PKW(P1,4), pw2[3]=PKW(P1,6), pw2); \
    VRD(3); SBAR(); GAPA(C0=__builtin_amdgcn_mfma_f32_32x32x16_bf16(kf[6],qr[3],C0,0,0,0),   P1[10],P1[11],P1[12],P1[13], pw3[0]=PKW(P1,8), pw3[1]=PKW(P1,10), pw3); \
    VRD(7); SBAR(); GAPA(C1=__builtin_amdgcn_mfma_f32_32x32x16_bf16(kf[7],qr[3],C1,0,0,0),   P1[14],P1[15],0.f,0.f,       pw3[2]=PKW(P1,12),pw3[3]=PKW(P1,14), pw3); \
    l_reg+=sacc; \
    if(GK){DMA_K((t)+3,sl_cur);} if(GV){DMA_V((t)+1,sl_next);} \
    CBIAS(C0,C1,t); CMASK(C0,C1,t); \
    { float a=MX3(C0[0],C0[1],C1[0]),b=MX3(C0[2],C0[3],C1[1]); a=MX3(a,C1[2],C1[3]); \
      _Pragma("unroll") for(int r=4;r<16;r+=4){a=MX3(a,C0[r],C0[r+1]);b=MX3(b,C0[r+2],C0[r+3]);a=MX3(a,C1[r],C1[r+1]);b=MX3(b,C1[r+2],C1[r+3]);} \
      float rm=__builtin_fmaxf(a,b); { auto rr=__builtin_amdgcn_permlane32_swap(__float_as_uint(rm),__float_as_uint(rm),false,false); rm=__builtin_fmaxf(__uint_as_float(rr[0]),__uint_as_float(rr[1])); } \
      resc=false; \
      if(__builtin_expect(__any(rm>(float)THRL),0)){ const float dl=__builtin_fmaxf(rm,0.f); mhat+=dl; \
        _Pragma("unroll") for(int r=0;r<16;++r){C0[r]-=dl;C1[r]-=dl;} \
        _Pragma("unroll") for(int r=0;r<16;++r)negm[r]=-mhat; asm volatile("":"+v"(negm)); \
        const float f=__builtin_amdgcn_exp2f(-dl); l_reg*=f; if(hi==0)wsf[r32]=f; resc=true; } } \
    SBAR(); \
    GAPB(o[0]=__builtin_amdgcn_mfma_f32_32x32x16_bf16(PAF(0),VFR(0),o[0],0,0,0), C0,0); \
    GAPB(o[1]=__builtin_amdgcn_mfma_f32_32x32x16_bf16(PAF(0),VFR(4),o[1],0,0,0), C0,4); \
    KRD(GL,0); GAPB(o[0]=__builtin_amdgcn_mfma_f32_32x32x16_bf16(PAF(1),VFR(1),o[0],0,0,0), C0,8); \
    KRD(GL,1); GAPB(o[1]=__builtin_amdgcn_mfma_f32_32x32x16_bf16(PAF(1),VFR(5),o[1],0,0,0), C0,12); \
    KRD(GL,2); GAPB(o[0]=__builtin_amdgcn_mfma_f32_32x32x16_bf16(PAF(2),VFR(2),o[0],0,0,0), C1,0); \
    KRD(GL,3); GAPB(o[1]=__builtin_amdgcn_mfma_f32_32x32x16_bf16(PAF(2),VFR(6),o[1],0,0,0), C1,4); \
    GAPB(o[0]=__builtin_amdgcn_mfma_f32_32x32x16_bf16(PAF(3),VFR(3),o[0],0,0,0), C1,8); \
    GAPB(o[1]=__builtin_amdgcn_mfma_f32_32x32x16_bf16(PAF(3),VFR(7),o[1],0,0,0), C1,12); \
    }while(0)
  int t=1;
  #undef CMASK
  #define CMASK(P0,P1,t) do{}while(0)
  for(;t+5<NT;t+=2){
    STEP(pB0,pB1,pA0,pA1,t,true,true,true);     WAIT_BAR(2); RESC(); ROT();
    STEP(pA0,pA1,pB0,pB1,t+1,true,true,true);   WAIT_BAR(2); RESC(); ROT();
  }
  #undef CMASK
  #define CMASK(P0,P1,t) do{int jb_=(t)-(NT-4); if(jb_>=0)cmask(P0,P1,jb_,qrel,hi);}while(0)
  #define ENDW(tt) do{ if((tt)+3<NT){WAIT_BAR(2);} else if((tt)+2<NT){WAIT_BAR(1);} else {WAIT_BAR(0);} }while(0)
  for(;t+1<NT;t+=2){
    STEP(pB0,pB1,pA0,pA1,t,(t+3<NT),(t+1<NT),(t+1<NT));       ENDW(t);   RESC(); ROT();
    STEP(pA0,pA1,pB0,pB1,t+1,(t+4<NT),(t+2<NT),(t+2<NT));     ENDW(t+1); RESC(); ROT();
  }
  STEP(pB0,pB1,pA0,pA1,NT-1,false,false,false); RESC();
  { float sacc=pB0[0]+pB0[1]; _Pragma("unroll") for(int r=2;r<16;++r)sacc+=pB0[r]; _Pragma("unroll") for(int r=0;r<16;++r)sacc+=pB1[r]; l_reg+=sacc;
    pw0=(u32x4){PKW(pB0,0),PKW(pB0,2),PKW(pB0,4),PKW(pB0,6)};pw1=(u32x4){PKW(pB0,8),PKW(pB0,10),PKW(pB0,12),PKW(pB0,14)};pw2=(u32x4){PKW(pB1,0),PKW(pB1,2),PKW(pB1,4),PKW(pB1,6)};pw3=(u32x4){PKW(pB1,8),PKW(pB1,10),PKW(pB1,12),PKW(pB1,14)};
    SBAR(); pv(o,vb0+sl_cur,PAF(0),PAF(1),PAF(2),PAF(3)); }
  #undef PKW
  #undef PAF
  #undef VFR
  #undef PIN
  #undef MX3
  #undef GAPA
  #undef GAPB
  #undef EX
  #undef VRD
  #undef KRD
  #undef STEP
  #undef ENDW
  {auto rr=__builtin_amdgcn_permlane32_swap(__float_as_uint(l_reg),__float_as_uint(l_reg),false,false);l_reg=__uint_as_float(rr[0])+__uint_as_float(rr[1]);}
  if(hi==0)wsf[32+r32]=l_reg;asm volatile("s_waitcnt lgkmcnt(0)":::"memory");
  float rli[16];
  #pragma unroll
  for(int r=0;r<16;++r)rli[r]=__builtin_amdgcn_rcpf(wsf[32+crow(r,hi)]);
  bf16*Ow=O+(rowbase+q0+wid*QBLK)*PO+h*D;
  { bf16*stg=(bf16*)(shm+LDS_OST)+wid*2048;
    #pragma unroll
    for(int r=0;r<16;++r){const int orow=crow(r,hi);
      #pragma unroll
      for(int d0=0;d0<2;++d0)stg[orow*64+d0*32+r32]=__float2bfloat16(o[d0][r]*rli[r]);}
    asm volatile("s_waitcnt lgkmcnt(0)":::"memory");
    #pragma unroll
    for(int i=0;i<4;++i){const int row=i*8+(lane>>3),ch=lane&7; const u32x4 v=*(const u32x4*)(stg+row*64+ch*8); ATTN_STORE16(Ow+(long)row*PO+ch*8,v);} }
  asm volatile("s_waitcnt lgkmcnt(0)\n\ts_barrier":::"memory");
  #undef DMA_K
  #undef DMA_V
  #undef CMASK
  #undef CBIAS
  #undef START
  #undef RESC
  #undef ROT
}
constexpr int ATTN_LDS_BYTES=LDS_BYTES;
struct AttnTensors { const bf16* Q; const bf16* K; const bf16* V; bf16* O; const float* CT; float TH; };
struct AttnUnit { int bh; int qb; };
struct StaticOrder {
  int vcu;
  __device__ __forceinline__ explicit StaticOrder(int grid,int block):vcu((block%8)*(grid/8)+block/8){}
  __device__ __forceinline__ bool next(int i,AttnUnit&u)const{ if(i>=4)return false; const int s=vcu&7; u.bh=vcu>>3; u.qb=(i==0)?s:(i==1)?15-s:(i==2)?16+s:31-s; return true; }
  __device__ __forceinline__ void a_ready(const AttnUnit&)const{}
  __device__ __forceinline__ void done(const AttnUnit&)const{}
};
template<class Sched,int THRL=8> __device__ __forceinline__ void attn_phase(char*lds,const AttnTensors&T,const Sched&S,const int tid_in){
  AttnUnit u;
  for(int i=0;S.next(i,u);++i){ S.a_ready(u); attn_unit<THRL>(u.bh/NHEAD,u.bh%NHEAD,u.qb,T.Q,T.K,T.V,T.O,T.CT,T.TH,lds,tid_in); S.done(u); }
}
#undef SBAR
#undef WAIT_BAR
}

constexpr int NWAVES = 8;
#ifndef MK_N_LAUNCHES
#define MK_N_LAUNCHES 1
#endif
enum Phase { PH_PRO = 0, PH_IN0, PH_MIX0, PH_OUT0, PH_XQ0, PH_XO0, PH_UP0, PH_DN0, PH_IN1, PH_MIX1, PH_OUT1, PH_XQ1, PH_XO1, PH_UP1, PH_DN1, N_PHASES };
constexpr int N_LAUNCHES = MK_N_LAUNCHES;
static_assert(N_LAUNCHES == 1 || N_LAUNCHES == N_PHASES, "MK_N_LAUNCHES is 1 or 15");

#ifndef MK_THRL
#define MK_THRL 20
#endif
#ifndef MK_F8DN
#define MK_F8DN 2
#endif
#ifndef MK_F8XO
#define MK_F8XO 1
#endif
constexpr float F8_XOASCALE = 64.0f, F8_XOWSCALE = 512.0f;
constexpr float F8_HSCALE = 16.0f, F8_WSCALE = 1024.0f;
constexpr int BATCH = 4, SEQ = 8192, D = 1024, T = BATCH * SEQ;
constexpr int NMEM = 256, MROWS = BATCH * NMEM;
constexpr int EVEN_IN = 2568, N_IN0 = 2560, N_IN1 = 2048, DFF = 2816, XAW = 512;
constexpr int Z1P = 1536;
constexpr float EPS = 1e-6f, LOG2E = 1.4426950408889634f;
constexpr float FOX_C2 = 0.125f * LOG2E;
constexpr float XA_C2 = 0.08838834764831845f * LOG2E;

constexpr size_t MiB = 1u << 20;
constexpr size_t WS_CTL = 0, CTL_ZERO_BYTES = 64 * 1024;
constexpr size_t WS_WIN0 = 2 * MiB, WS_WOUT0 = 7 * MiB, WS_WIN1 = 9 * MiB, WS_WOUT1 = 13 * MiB;
constexpr size_t WS_LAYER = 15 * MiB, LAYER_STRIDE = 21 * MiB, L_WQ = 0, L_WKV = 1 * MiB, L_WO = 3 * MiB, L_WGU = 4 * MiB, L_WD = 15 * MiB;
constexpr size_t WS_WSP = 57 * MiB;
constexpr size_t WS_MEMN = 58 * MiB, WS_KVRAW = 60 * MiB, WS_KN = 64 * MiB, WS_VT = 66 * MiB;
constexpr size_t WS_LOGF = 68 * MiB, WS_CUM = 69 * MiB, WS_SSQ = 70 * MiB;
constexpr size_t WS_XB = 72 * MiB, WS_Y = 136 * MiB, WS_XQ = WS_Y, WS_XO = WS_Y + 32 * MiB, WS_BIG = 200 * MiB, WS_END = 376 * MiB;
constexpr int CW_TMO = 0, CW_CODE = 1;
constexpr int CW_BAR = 4096;
constexpr int CW_Q0 = 64;

constexpr int RING_OFF = 0, RING_BYTES = 131072;
constexpr int XA_KROW = 272, XA_VROW = 528, XA_KBYTES = 256 * XA_KROW, XA_VBYTES = 128 * XA_VROW;
constexpr int LDSCTL_OFF = 139264, MISC_OFF = LDSCTL_OFF + 320;
constexpr int LDS_BYTES = 147456;
static_assert(XA_KBYTES + XA_VBYTES <= LDSCTL_OFF && MISC_OFF + 128 <= LDS_BYTES, "LDS map");
#define GAS __attribute__((address_space(1)))
#define LAS __attribute__((address_space(3)))
typedef unsigned short bf16;
typedef unsigned v4u __attribute__((ext_vector_type(4)));
typedef float f32x4 __attribute__((ext_vector_type(4)));
typedef short bf16x8 __attribute__((ext_vector_type(8)));
typedef GAS unsigned gu32;
typedef GAS unsigned long long gu64;
#define RLX_AGENT __ATOMIC_RELAXED, __HIP_MEMORY_SCOPE_AGENT
#define LDS_WAIT() asm volatile("s_waitcnt lgkmcnt(0)" ::: "memory")
#define VM_WAIT() asm volatile("s_waitcnt vmcnt(0)" ::: "memory")
__device__ __forceinline__ unsigned long long rt() { return __builtin_amdgcn_s_memrealtime(); }
__device__ __forceinline__ unsigned f2bf(float f) { unsigned u = __builtin_bit_cast(unsigned, f); return (u + 0x7fffu + ((u >> 16) & 1u)) >> 16; }
__device__ __forceinline__ unsigned pk2(float lo, float hi) { return f2bf(lo) | (f2bf(hi) << 16); }
typedef float pk_f32x2 __attribute__((ext_vector_type(2))); typedef __bf16 pk_bf16x2 __attribute__((ext_vector_type(2)));
__device__ __forceinline__ unsigned pk2h(float lo, float hi) { const pk_f32x2 v = {lo, hi}; return __builtin_bit_cast(unsigned, __builtin_convertvector(v, pk_bf16x2)); }

#define XB_TMO      128
#define XB_XCNT(j)  (256  + 64 * (j))
#define XB_XSUB(j)  (1280 + 64 * (j))
#define XB_XGEN(j)  (2304 + 64 * (j))
#define XB_TOP      3328
#define XB_TOPGEN   3392
#define XCD_BAR_WORDS 3456
#define XB_SPIN_CAP (1u << 18)

__device__ __forceinline__ unsigned xb_ld(unsigned* p)              { return __hip_atomic_load(p, __ATOMIC_RELAXED, __HIP_MEMORY_SCOPE_AGENT); }
__device__ __forceinline__ unsigned xb_add(unsigned* p, unsigned v) { return __hip_atomic_fetch_add(p, v, __ATOMIC_RELAXED, __HIP_MEMORY_SCOPE_AGENT); }
__device__ __forceinline__ unsigned xb_xcc_id() { return (unsigned)__builtin_amdgcn_s_getreg((3 << 11) | 20) & 0xFu; }
#define XB_SPIN(cond, bar) do { unsigned _sp = 0; while (cond) { __builtin_amdgcn_s_sleep(1); \
    if ((++_sp & 255u) == 0u) { if (xb_ld(&(bar)[XB_TMO])) break; if (_sp > XB_SPIN_CAP) { atomicAdd(&(bar)[XB_TMO], 1u); break; } } } } while (0)

struct XcdBarrier {
    unsigned* bar; unsigned x;
    volatile LAS unsigned* st;
};

__device__ __forceinline__ XcdBarrier xcd_barrier_post(unsigned* bar, volatile LAS unsigned* st, const int tid_in) {
    XcdBarrier b; b.bar = bar; b.x = xb_xcc_id(); b.st = st;
    if (tid_in == 0) (void)xb_add(&bar[XB_XCNT(b.x)], 1u);
    return b;
}
__device__ __forceinline__ void xcd_barrier_complete(unsigned* bar, unsigned x, unsigned& nloc, unsigned& nx) {
    const unsigned G = gridDim.x * gridDim.y * gridDim.z;
    unsigned sum, cnt, mine, sp = 0u;
    for (;;) {
        sum = 0u; cnt = 0u; mine = 0u;
#pragma unroll
        for (unsigned j = 0; j < 16; ++j) { const unsigned c = xb_ld(&bar[XB_XCNT(j)]); sum += c; cnt += (c > 0u) ? 1u : 0u; mine = (j == x) ? c : mine; }
        if (sum == G) break;
        __builtin_amdgcn_s_sleep(1);
        if ((++sp & 255u) == 0u) { if (xb_ld(&bar[XB_TMO])) break; if (sp > XB_SPIN_CAP) { atomicAdd(&bar[XB_TMO], 1u); break; } }
    }
    nloc = mine > 0u ? mine : 1u; nx = cnt > 0u ? cnt : 1u;
}

__device__ __forceinline__ void xcd_barrier(const XcdBarrier& b, const int tid_in) {
    asm volatile("s_waitcnt vmcnt(0)" ::: "memory");
    __syncthreads();
    int t0_ = tid_in; asm volatile("" : "+v"(t0_));
    if (t0_ == 0) {
        unsigned* bar = b.bar; asm volatile("" : "+v"(bar));
        __builtin_amdgcn_s_waitcnt(0);
        unsigned nloc = b.st[0], nx = b.st[1];
        if (nloc == 0u) { xcd_barrier_complete(bar, b.x, nloc, nx); b.st[0] = nloc; b.st[1] = nx; }
        const unsigned old = xb_add(&bar[XB_XSUB(b.x)], 1u);
        const unsigned gen = old / nloc;
        if (old + 1u == (gen + 1u) * nloc) {
            __builtin_amdgcn_fence(__ATOMIC_RELEASE, "agent");
            asm volatile("s_waitcnt vmcnt(0)" ::: "memory");
            const unsigned og = xb_add(&bar[XB_TOP], 1u);
            const unsigned tg = og / nx;
            if (og + 1u == (tg + 1u) * nx) xb_add(&bar[XB_TOPGEN], 1u);
            else XB_SPIN(xb_ld(&bar[XB_TOPGEN]) == tg, bar);
            __builtin_amdgcn_fence(__ATOMIC_ACQUIRE, "agent");
            xb_add(&bar[XB_XGEN(b.x)], 1u);
            asm volatile("s_waitcnt vmcnt(0)" ::: "memory");
        } else {
            XB_SPIN(xb_ld(&bar[XB_XGEN(b.x)]) == gen, bar);
            __builtin_amdgcn_fence(__ATOMIC_ACQUIRE, "agent");
            asm volatile("s_waitcnt vmcnt(0)" ::: "memory");
        }
    }
    __syncthreads();
}

typedef float f32x16 __attribute__((ext_vector_type(16)));
typedef unsigned u32x2 __attribute__((ext_vector_type(2)));
__device__ __forceinline__ float bf2f(short s) { return __builtin_bit_cast(float, (unsigned)(unsigned short)s << 16); }
__device__ __forceinline__ float bfu2f(unsigned u16) { return __builtin_bit_cast(float, u16 << 16); }
__device__ __forceinline__ float rsq(float x) { return __builtin_amdgcn_rsqf(x); }

typedef const float* cfp_t;
struct Frame {
    LAS unsigned char* lds;
    volatile LAS unsigned* MISC;
    gu32* ctl;
    int tid, lane, wave;
    int vcu, G;
    const __attribute__((address_space(4))) cfp_t* in;
    const float* x; float* out;
    unsigned char* ws;
    bf16 *XB, *Y, *XQ, *XO, *BIG, *MEMN, *KVRAW, *KN, *VT, *WSP;
    float *LOGF, *CUM, *SSQ;
};
__device__ __forceinline__ bf16* lw(Frame& F, int l, size_t off) { return (bf16*)(F.ws + WS_LAYER + (size_t)l * LAYER_STRIDE + off); }

__device__ __forceinline__ float wave_sum(float v) {
#pragma unroll
    for (int o = 1; o < 64; o <<= 1) v += __shfl_xor(v, o);
    return v;
}
typedef float f32x2 __attribute__((ext_vector_type(2)));
__device__ __forceinline__ int p0_drow(int n, int map) {
    if (map == 1) { if (n >= 1024 && n < 2048) { const int tile = n >> 8, ll = n & 255; return tile * 256 + 128 * ((ll >> 5) & 1) + 32 * (ll >> 6) + (ll & 31); } return n; }
    if (map == 2) return 256 * (n >> 7) + (n & 127);
    if (map == 3) return 256 * (n >> 7) + 128 + (n & 127);
    if (map == 4) {
        if (n < 512) return n; if (n < 1024) return 512 + 256 * ((n - 512) >> 7) + (n & 127); if (n < 1536) return 1536 + (n - 1024); return 512 + 256 * ((n - 1536) >> 7) + 128 + (n & 127); }
    return n;
}
__device__ __forceinline__ void p0_transpose_item(const float* W, int ldn, const float* ks, bf16* WT, int ldk, int koff, int k0, int n0, int map, LAS unsigned char* scr, int lane) {
    const float* src = W + (size_t)k0 * ldn + n0 + 2 * lane;
#pragma unroll
    for (int hh = 0; hh < 2; ++hh) {
        f32x2 v[32];
#pragma unroll
        for (int i = 0; i < 32; ++i) v[i] = __builtin_nontemporal_load((const GAS f32x2*)(src + (size_t)(32 * hh + i) * ldn));
#pragma unroll
        for (int i = 0; i < 32; i += 2) { const int kk = 32 * hh + i; float s0 = 1.f, s1 = 1.f; if (ks) { s0 = ks[k0 + kk]; s1 = ks[k0 + kk + 1]; }
            *(LAS unsigned*)(scr + (2 * lane) * 136 + kk * 2) = pk2h(v[i].x * s0, v[i + 1].x * s1);
            *(LAS unsigned*)(scr + (2 * lane + 1) * 136 + kk * 2) = pk2h(v[i].y * s0, v[i + 1].y * s1); }
    }
    LDS_WAIT(); asm volatile("" ::: "memory");
    const int c = lane & 7;
#pragma unroll
    for (int j = 0; j < 16; ++j) { const int n = (lane >> 3) + 8 * j; const LAS unsigned char* p = scr + n * 136 + c * 16;
        const u32x2 lo = *(const LAS u32x2*)p, hi = *(const LAS u32x2*)(p + 8);
        v4u o; o.x = lo.x; o.y = lo.y; o.z = hi.x; o.w = hi.y;
        *(GAS v4u*)(WT + (size_t)p0_drow(n0 + n, map) * ldk + koff + k0 + 8 * c) = o; }
    LDS_WAIT(); asm volatile("" ::: "memory");
}
__device__ __forceinline__ void p0_transpose_item8(const float* W, int ldn, float sc, unsigned char* WT, int ldk, int k0, int n0, LAS unsigned char* scr, int lane) {
    const float* src = W + (size_t)k0 * ldn + n0 + 2 * lane;
#pragma unroll
    for (int hh = 0; hh < 2; ++hh) {
        f32x2 v[32];
#pragma unroll
        for (int i = 0; i < 32; ++i) v[i] = __builtin_nontemporal_load((const GAS f32x2*)(src + (size_t)(32 * hh + i) * ldn));
#pragma unroll
        for (int i = 0; i < 32; i += 4) { const int kk = 32 * hh + i;
            *(LAS unsigned*)(scr + (2 * lane) * 72 + kk) = pg8::pk4_f8(v[i].x * sc, v[i + 1].x * sc, v[i + 2].x * sc, v[i + 3].x * sc);
            *(LAS unsigned*)(scr + (2 * lane + 1) * 72 + kk) = pg8::pk4_f8(v[i].y * sc, v[i + 1].y * sc, v[i + 2].y * sc, v[i + 3].y * sc); }
    }
    LDS_WAIT(); asm volatile("" ::: "memory");
    const int c = lane & 3;
#pragma unroll
    for (int j = 0; j < 8; ++j) { const int n = (lane >> 2) + 16 * j; const LAS unsigned char* p = scr + n * 72 + c * 16;
        const u32x2 lo = *(const LAS u32x2*)p, hi = *(const LAS u32x2*)(p + 8);
        v4u o; o.x = lo.x; o.y = lo.y; o.z = hi.x; o.w = hi.y;
        *(GAS v4u*)(WT + (size_t)(n0 + n) * ldk + k0 + 16 * c) = o; }
    LDS_WAIT(); asm volatile("" ::: "memory");
}
__device__ __forceinline__ bool p0_job8(int& r, const float* src, int ldn, int K, int N, float sc, unsigned char* dst, int ldk, LAS unsigned char* scr, int lane) {
    const int nblk = N / 128, items = (K / 64) * nblk;
    if (r >= items) { r -= items; return false; }
    const int kb = r / nblk, nb = r % nblk;
    p0_transpose_item8(src, ldn, sc, dst, ldk, 64 * kb, 128 * nb, scr, lane);
    return true;
}
__device__ __forceinline__ bool p0_job(int& r, const float* src, int ldn, int K, int N, const float* ks, bf16* dst, int ldk, int koff, int map, LAS unsigned char* scr, int lane) {
    const int nblk = N / 128, items = (K / 64) * nblk;
    if (r >= items) { r -= items; return false; }
    const int kb = r / nblk, nb = r % nblk;
    p0_transpose_item(src, ldn, ks, dst, ldk, koff, 64 * kb, 128 * nb, map, scr, lane);
    return true;
}
__device__ __forceinline__ void p0_prologue(Frame& F) {
    LAS unsigned char* scr = F.lds + RING_OFF + F.wave * 17408;
    const int gw = F.vcu * NWAVES + F.wave, NGW = F.G * NWAVES, lane = F.lane;
    const __attribute__((address_space(4))) cfp_t* in = F.in;
    constexpr int I_IN0 = 16 * 20, I_SQ = 16 * 8, I_IN1 = 16 * 16, I_O1 = 8 * 8, I_Q = 16 * 4, I_KV = 16 * 8, I_XO = 8 * 8, I_G = 16 * 22, I_DN = 44 * 8;
    constexpr int NITEMS = I_IN0 + I_SQ + I_IN1 + I_O1 + 2 * (I_Q + I_KV + I_XO + 2 * I_G + I_DN);
#ifdef PROBE_PHASE
#define P0REP(k) for (int prep_ = 0; prep_ < ((PROBE_PHASE == 100 + (k)) ? 2 : 1); ++prep_)
#else
#define P0REP(k)
#endif
    P0REP(1)
    for (int it = gw; it < NITEMS; it += NGW) {
        int r = it;
        if (p0_job(r, in[14], EVEN_IN, D, N_IN0, in[2], (bf16*)(F.ws + WS_WIN0), D, 0, 1, scr, lane)) continue;
        if (p0_job(r, in[21], D, D, D, nullptr, (bf16*)(F.ws + WS_WOUT0), D, 0, 0, scr, lane)) continue;
        if (p0_job(r, in[22], N_IN1, D, N_IN1, in[2] + D, (bf16*)(F.ws + WS_WIN1), D, 0, 4, scr, lane)) continue;
        if (p0_job(r, in[26] + (size_t)512 * D, D, 512, D, nullptr, (bf16*)(F.ws + WS_WOUT1), D, 512, 0, scr, lane)) continue;
        bool done = false;
#pragma unroll
        for (int l = 0; l < 2; ++l) {
            if (done) break;
            if (p0_job(r, in[5] + (size_t)l * D * XAW, XAW, D, XAW, in[3] + l * D, lw(F, l, L_WQ), D, 0, 0, scr, lane)) { done = true; break; }
            if (p0_job(r, in[6] + (size_t)l * D * D, D, D, D, in[4] + l * D, lw(F, l, L_WKV), D, 0, 0, scr, lane)) { done = true; break; }
            if (MK_F8XO) { if (p0_job8(r, in[7] + (size_t)l * XAW * D, D, XAW, D, F8_XOWSCALE, (unsigned char*)lw(F, l, L_WO), XAW, scr, lane)) { done = true; break; } }
            else if (p0_job(r, in[7] + (size_t)l * XAW * D, D, XAW, D, nullptr, lw(F, l, L_WO), XAW, 0, 0, scr, lane)) { done = true; break; }
            if (p0_job(r, in[11] + (size_t)l * D * DFF, DFF, D, DFF, in[10] + l * D, lw(F, l, L_WGU), D, 0, 2, scr, lane)) { done = true; break; }
            if (p0_job(r, in[12] + (size_t)l * D * DFF, DFF, D, DFF, in[10] + l * D, lw(F, l, L_WGU), D, 0, 3, scr, lane)) { done = true; break; }
            if ((MK_F8DN >> l) & 1) { if (p0_job8(r, in[13] + (size_t)l * DFF * D, D, DFF, D, F8_WSCALE, (unsigned char*)lw(F, l, L_WD), DFF, scr, lane)) { done = true; break; } }
            else if (p0_job(r, in[13] + (size_t)l * DFF * D, D, DFF, D, nullptr, lw(F, l, L_WD), DFF, 0, 0, scr, lane)) { done = true; break; }
        }
    }
    P0REP(2)
    for (int it = gw; it < 128 * 16; it += NGW) {
        const int kk0 = (it >> 4) * 4, n0 = (it & 15) * 64, g = kk0 >> 7;
        const float* wp = in[23] + (size_t)kk0 * 128; const float* sp = in[24] + g * 128; const float* wo = in[26] + (size_t)(g * 128) * D + n0 + lane;
        float acc[4];
#pragma unroll
        for (int j = 0; j < 4; ++j) acc[j] = 0.f;
#pragma unroll 32
        for (int d = 0; d < 128; ++d) { const float w = wo[(size_t)d * D] * sp[d];
#pragma unroll
            for (int j = 0; j < 4; ++j) acc[j] += wp[j * 128 + d] * w; }
        u32x2 o; o.x = pk2h(acc[0], acc[1]); o.y = pk2h(acc[2], acc[3]);
        *(GAS u32x2*)((bf16*)(F.ws + WS_WOUT1) + (size_t)(n0 + lane) * D + kk0) = o;
    }
    for (int i = gw * 64 + lane; i < 4 * 128 * 128; i += NGW * 64) { const int t = (i >> 7) & 127, s = i & 127; const float w = in[17][i]; F.WSP[i] = (bf16)f2bf((t >> 6) >= (s >> 6) ? w : 0.f); }
    for (int row = gw; row < MROWS; row += NGW) {
        const GAS f32x4* xr = (const GAS f32x4*)(in[1] + (size_t)row * D) + lane;
        f32x4 v[4]; float s = 0.f;
#pragma unroll
        for (int j = 0; j < 4; ++j) { v[j] = xr[64 * j]; s += (v[j].x * v[j].x + v[j].y * v[j].y) + (v[j].z * v[j].z + v[j].w * v[j].w); }
        const float rstd = rsq(wave_sum(s) * (1.f / D) + EPS);
        GAS unsigned long long* o8 = (GAS unsigned long long*)(F.MEMN + (size_t)row * D) + lane;
#pragma unroll
        for (int j = 0; j < 4; ++j) o8[64 * j] = (unsigned long long)pk2h(v[j].x * rstd, v[j].y * rstd) | ((unsigned long long)pk2h(v[j].z * rstd, v[j].w * rstd) << 32);
    }
    {
        LAS float* wl = (LAS float*)(F.lds + RING_OFF);
        __syncthreads();
#pragma unroll
        for (int r = 0; r < 2; ++r) { const int k = F.tid + 512 * r; const float g = in[2][k]; const float* p = in[14] + (size_t)k * EVEN_IN + N_IN0;
            const f32x4 a = *(const f32x4*)p, b = *(const f32x4*)(p + 4);
            wl[0 * 1024 + k] = a.x * g; wl[1 * 1024 + k] = a.y * g; wl[2 * 1024 + k] = a.z * g; wl[3 * 1024 + k] = a.w * g;
            wl[4 * 1024 + k] = b.x * g; wl[5 * 1024 + k] = b.y * g; wl[6 * 1024 + k] = b.z * g; wl[7 * 1024 + k] = b.w * g; }
        __syncthreads();
        float wf[8][16];
#pragma unroll
        for (int j = 0; j < 8; ++j)
#pragma unroll
            for (int jj = 0; jj < 4; ++jj) { const f32x4 w = *(const LAS f32x4*)(wl + j * 1024 + 4 * lane + 256 * jj); wf[j][jj * 4 + 0] = w.x; wf[j][jj * 4 + 1] = w.y; wf[j][jj * 4 + 2] = w.z; wf[j][jj * 4 + 3] = w.w; }
        const float bfl = in[15][lane & 7];
        P0REP(3) {
        int row = gw;
        f32x4 v[4], v1[4];
        if (row < T) { const GAS f32x4* xr = (const GAS f32x4*)(F.x + (size_t)row * D) + lane;
#pragma unroll
            for (int j = 0; j < 4; ++j) v[j] = __builtin_nontemporal_load(xr + 64 * j); }
        if (row + NGW < T) { const GAS f32x4* xr = (const GAS f32x4*)(F.x + (size_t)(row + NGW) * D) + lane;
#pragma unroll
            for (int j = 0; j < 4; ++j) v1[j] = __builtin_nontemporal_load(xr + 64 * j); }
        while (row < T) {
            const int nrow = row + NGW; f32x4 vn[4];
            if (nrow + NGW < T) { const GAS f32x4* xr = (const GAS f32x4*)(F.x + (size_t)(nrow + NGW) * D) + lane;
#pragma unroll
                for (int j = 0; j < 4; ++j) vn[j] = __builtin_nontemporal_load(xr + 64 * j); }
            float s = 0.f;
#pragma unroll
            for (int j = 0; j < 4; ++j) s += (v[j].x * v[j].x + v[j].y * v[j].y) + (v[j].z * v[j].z + v[j].w * v[j].w);
            float a[8];
#pragma unroll
            for (int j2 = 0; j2 < 8; ++j2) { float t = 0.f;
#pragma unroll
                for (int jj = 0; jj < 4; ++jj) t += (v[jj].x * wf[j2][jj * 4 + 0] + v[jj].y * wf[j2][jj * 4 + 1]) + (v[jj].z * wf[j2][jj * 4 + 2] + v[jj].w * wf[j2][jj * 4 + 3]);
                a[j2] = t; }
            float b4[4], b2[2], b1;
#pragma unroll
            for (int i = 0; i < 4; ++i) { const float keep = (lane & 1) ? a[2 * i + 1] : a[2 * i], give = (lane & 1) ? a[2 * i] : a[2 * i + 1]; b4[i] = keep + __shfl_xor(give, 1); }
#pragma unroll
            for (int i = 0; i < 2; ++i) { const float keep = (lane & 2) ? b4[2 * i + 1] : b4[2 * i], give = (lane & 2) ? b4[2 * i] : b4[2 * i + 1]; b2[i] = keep + __shfl_xor(give, 2); }
            { const float keep = (lane & 4) ? b2[1] : b2[0], give = (lane & 4) ? b2[0] : b2[1]; b1 = keep + __shfl_xor(give, 4); }
            b1 += __shfl_xor(b1, 8); b1 += __shfl_xor(b1, 16); b1 += __shfl_xor(b1, 32);
            s = wave_sum(s);
            const float rstd = rsq(s * (1.f / D) + EPS);
            if (lane < 16) F.SSQ[(size_t)row * 16 + lane] = (lane == 0) ? s : 0.f;
            GAS unsigned long long* o8 = (GAS unsigned long long*)(F.XB + (size_t)row * D) + lane;
#pragma unroll
            for (int j = 0; j < 4; ++j) o8[64 * j] = (unsigned long long)pk2h(v[j].x, v[j].y) | ((unsigned long long)pk2h(v[j].z, v[j].w) << 32);
            if (lane < 8) { const float fl = b1 * rstd + bfl; const float lf = fminf(fl, 0.f) - log1pf(expf(-fabsf(fl)));
                F.LOGF[((size_t)(row / SEQ) * 8 + lane) * SEQ + (row % SEQ)] = lf * LOG2E; }
#pragma unroll
            for (int j = 0; j < 4; ++j) { v[j] = v1[j]; v1[j] = vn[j]; }
            row = nrow;
        }
        }
    }
}
__device__ __forceinline__ void cumsum_seq(Frame& F, int bh) {
    const int tid = F.tid, lane = F.lane;
    const f32x4* src = (const f32x4*)(F.LOGF + (size_t)bh * SEQ + tid * 16);
    f32x4 q[4];
#pragma unroll
    for (int i = 0; i < 4; ++i) q[i] = src[i];
    float run = 0.f;
#pragma unroll
    for (int i = 0; i < 4; ++i) { q[i].x += run; q[i].y += q[i].x; q[i].z += q[i].y; q[i].w += q[i].z; run = q[i].w; }
    float incl = run;
#pragma unroll
    for (int o = 1; o < 64; o <<= 1) { const float t = __shfl_up(incl, o); if (lane >= o) incl += t; }
    LAS float* sc = (LAS float*)F.lds;
    __syncthreads();
    if (lane == 63) sc[F.wave] = incl;
    __syncthreads();
    float woff = 0.f;
#pragma unroll
    for (int w = 0; w < NWAVES; ++w) woff += (w < F.wave) ? sc[w] : 0.f;
    const float off = woff + (incl - run);
    f32x4* dst = (f32x4*)(F.CUM + (size_t)bh * SEQ + tid * 16);
#pragma unroll
    for (int i = 0; i < 4; ++i) dst[i] = q[i] + off;
    __syncthreads();
}
__device__ __forceinline__ void xa_kv_finalize(Frame& F, int item) {
    const int tid = F.tid, l = item >> 4, b = (item >> 2) & 3, h = item & 3;
    const int kvr = tid >> 1, half = tid & 1;
    const bf16* kp = F.KVRAW + (size_t)l * MROWS * D + (size_t)(b * NMEM + kvr) * D + h * 128 + 64 * half;
    const size_t obase = (size_t)((l * 4 + b) * 4 + h) * (NMEM * 128);
    bf16x8 x[8]; float ss = 0.f;
#pragma unroll
    for (int i = 0; i < 8; ++i) { x[i] = *(const GAS bf16x8*)(kp + 8 * i);
#pragma unroll
        for (int e = 0; e < 8; ++e) { const float f = bf2f(x[i][e]); ss += f * f; } }
    ss += __shfl_xor(ss, 1);
    const float rstd = rsq(ss * (1.f / 128.f) + EPS);
    const float* gk = F.in[9] + l * 128 + 64 * half;
    bf16* ko = F.KN + obase + (size_t)kvr * 128 + 64 * half;
#pragma unroll
    for (int i = 0; i < 8; ++i) { v4u o;
        o.x = pk2(bf2f(x[i][0]) * rstd * gk[8 * i + 0], bf2f(x[i][1]) * rstd * gk[8 * i + 1]); o.y = pk2(bf2f(x[i][2]) * rstd * gk[8 * i + 2], bf2f(x[i][3]) * rstd * gk[8 * i + 3]);
        o.z = pk2(bf2f(x[i][4]) * rstd * gk[8 * i + 4], bf2f(x[i][5]) * rstd * gk[8 * i + 5]); o.w = pk2(bf2f(x[i][6]) * rstd * gk[8 * i + 6], bf2f(x[i][7]) * rstd * gk[8 * i + 7]);
        *(GAS v4u*)(ko + 8 * i) = o; }
    const bf16* vp = kp + XAW;
    const int pk = (kvr & ~12) | ((kvr & 4) << 1) | ((kvr & 8) >> 1);
    LAS unsigned short* vl = (LAS unsigned short*)F.lds;
    __syncthreads();
#pragma unroll
    for (int i = 0; i < 8; ++i) { const bf16x8 v = *(const GAS bf16x8*)(vp + 8 * i);
#pragma unroll
        for (int e = 0; e < 8; ++e) vl[(64 * half + 8 * i + e) * NMEM + pk] = (unsigned short)v[e]; }
    __syncthreads();
    bf16* vo = F.VT + obase;
#pragma unroll
    for (int i = 0; i < 8; ++i) { const int id = tid + 512 * i; *(GAS v4u*)(vo + id * 8) = *(const LAS v4u*)(vl + id * 8); }
    __syncthreads();
}
__device__ __forceinline__ void gmlp_loads(Frame& F, int r0, int g, bf16x8 (&x)[4], v4u (&up)[4], float (&bp)[4]) {
    const int tid = F.tid, lane = F.lane; const bf16* Z = F.BIG;
    { const int row = tid >> 2, q = tid & 3; const bf16* vp = Z + (size_t)(r0 + row) * N_IN0 + 512 + g * 128 + 32 * q;
#pragma unroll
      for (int i = 0; i < 4; ++i) x[i] = __builtin_nontemporal_load((const GAS bf16x8*)(vp + 8 * i)); }
    const int tb = F.wave & 3, chh = F.wave >> 2;
#pragma unroll
    for (int i = 0; i < 4; ++i) { const int t = (lane >> 3) + 8 * i, ch = lane & 7, row = r0 + 32 * tb + t;
        up[i] = __builtin_nontemporal_load((const GAS v4u*)(Z + (size_t)row * N_IN0 + g * 128 + 64 * chh + 8 * ch)); bp[i] = F.in[18][g * 128 + 32 * tb + t]; }
}
__device__ __forceinline__ void gmlp_compute(Frame& F, int r0, int g, const bf16x8 (&x)[4], const v4u (&up)[4], const float (&bp)[4], bool has_next, bf16x8 (&nx)[4], v4u (&nup)[4], float (&nbp)[4]) {
    const int tid = F.tid, lane = F.lane, wid = F.wave, r32 = lane & 31, hi = lane >> 5;
    LAS unsigned char* vT = F.lds;
    __syncthreads();
    { const int row = tid >> 2, q = tid & 3; float ss = 0.f;
#pragma unroll
      for (int i = 0; i < 4; ++i)
#pragma unroll
          for (int e = 0; e < 8; ++e) { const float f = bf2f(x[i][e]); ss += f * f; }
      ss += __shfl_xor(ss, 1); ss += __shfl_xor(ss, 2);
      const float rstd = rsq(ss * (1.f / 128.f) + EPS);
      const float* gv = F.in[16] + g * 128 + 32 * q;
#pragma unroll
      for (int i = 0; i < 4; ++i)
#pragma unroll
          for (int e = 0; e < 8; e += 2) { const int c = 32 * q + 8 * i + e; const unsigned w = pk2h(bf2f(x[i][e]) * rstd * gv[8 * i + e], bf2f(x[i][e + 1]) * rstd * gv[8 * i + e + 1]);
              *(LAS unsigned short*)(vT + c * 272 + row * 2) = (unsigned short)(w & 0xffffu); *(LAS unsigned short*)(vT + (c + 1) * 272 + row * 2) = (unsigned short)(w >> 16); }
    }
    if (has_next) gmlp_loads(F, r0, g + 1, nx, nup, nbp);
    __syncthreads();
    const int tb = wid & 3, chh = wid >> 2;
    f32x16 acc[2]; acc[0] = f32x16{}; acc[1] = f32x16{};
    const bf16* Wg = F.WSP + (size_t)g * 128 * 128 + (size_t)(32 * tb + r32) * 128 + 8 * hi;
#pragma unroll
    for (int ks = 0; ks < 8; ++ks) { const bf16x8 bfr = *(const GAS bf16x8*)(Wg + 16 * ks);
#pragma unroll
        for (int c2 = 0; c2 < 2; ++c2) { const bf16x8 a = *(const LAS bf16x8*)(vT + (32 * (2 * chh + c2) + r32) * 272 + (16 * ks + 8 * hi) * 2);
            acc[c2] = __builtin_amdgcn_mfma_f32_32x32x16_bf16(a, bfr, acc[c2], 0, 0, 0); } }
    LAS unsigned char* stg = F.lds + 40960 + wid * (32 * 272);
#pragma unroll
    for (int c2 = 0; c2 < 2; ++c2)
#pragma unroll
        for (int g4 = 0; g4 < 4; ++g4) { const f32x4 v = (f32x4){acc[c2][4 * g4 + 0], acc[c2][4 * g4 + 1], acc[c2][4 * g4 + 2], acc[c2][4 * g4 + 3]};
            *(LAS f32x4*)(stg + r32 * 272 + (32 * c2 + 8 * g4 + 4 * hi) * 4) = v; }
    LDS_WAIT(); asm volatile("" ::: "memory");
#pragma unroll
    for (int i = 0; i < 4; ++i) { const int t = (lane >> 3) + 8 * i, ch = lane & 7, row = r0 + 32 * tb + t;
        const f32x4 s0 = *(const LAS f32x4*)(stg + t * 272 + ch * 32), s1 = *(const LAS f32x4*)(stg + t * 272 + ch * 32 + 16);
        const float bs = bp[i]; const v4u u = up[i];
        v4u o; o.x = pk2h(bfu2f(u.x & 0xffffu) * (s0.x + bs), bfu2f(u.x >> 16) * (s0.y + bs)); o.y = pk2h(bfu2f(u.y & 0xffffu) * (s0.z + bs), bfu2f(u.y >> 16) * (s0.w + bs));
        o.z = pk2h(bfu2f(u.z & 0xffffu) * (s1.x + bs), bfu2f(u.z >> 16) * (s1.y + bs)); o.w = pk2h(bfu2f(u.w & 0xffffu) * (s1.z + bs), bfu2f(u.w >> 16) * (s1.w + bs));
        *(GAS v4u*)(F.Y + (size_t)row * D + g * 128 + 64 * chh + 8 * ch) = o; }
}
__device__ __forceinline__ void gmlp_item(Frame& F, int blk) {
    const int r0 = blk * 128;
    bf16x8 xa[4], xb[4]; v4u ua[4], ub[4]; float ba[4], bb[4];
    gmlp_loads(F, r0, 0, xa, ua, ba);
    gmlp_compute(F, r0, 0, xa, ua, ba, true, xb, ub, bb);
    gmlp_compute(F, r0, 1, xb, ub, bb, true, xa, ua, ba);
    gmlp_compute(F, r0, 2, xa, ua, ba, true, xb, ub, bb);
    gmlp_compute(F, r0, 3, xb, ub, bb, false, xa, ua, ba);
}
__device__ __forceinline__ void mix1_phase(Frame& F) {
    const bf16* Z = F.BIG;
    const int tid = F.tid;
    for (int it = F.vcu; it < T / 128; it += F.G) {
        const int rc = it * 4 + (tid >> 7), cc = tid & 127, t0 = rc * 32, pos0 = t0 % SEQ;
        if (cc < 64) {
            const int w = 2 << (cc >> 4); const bf16* zp = Z + (size_t)t0 * Z1P + 8 * cc; bf16* yp = F.Y + (size_t)t0 * D + 8 * cc;
            float s[8];
#pragma unroll
            for (int e = 0; e < 8; ++e) s[e] = 0.f;
            for (int j = 1; j < w; ++j) if (pos0 - j >= 0) { const bf16x8 z = *(const GAS bf16x8*)(zp - (size_t)j * Z1P);
#pragma unroll
                for (int e = 0; e < 8; ++e) s[e] += bf2f(z[e]); }
            for (int i = 0; i < 32; ++i) { const int pos = pos0 + i; const bf16x8 z = *(const GAS bf16x8*)(zp + (size_t)i * Z1P);
                float zf[8];
#pragma unroll
                for (int e = 0; e < 8; ++e) { zf[e] = bf2f(z[e]); s[e] += zf[e]; }
                const float inv = 1.0f / (float)((pos + 1 < w) ? pos + 1 : w);
                v4u o; o.x = pk2h(s[0] * inv - zf[0], s[1] * inv - zf[1]); o.y = pk2h(s[2] * inv - zf[2], s[3] * inv - zf[3]); o.z = pk2h(s[4] * inv - zf[4], s[5] * inv - zf[5]); o.w = pk2h(s[6] * inv - zf[6], s[7] * inv - zf[7]);
                *(GAS v4u*)(yp + (size_t)i * D) = o;
                if (pos + 1 >= w) { const bf16x8 zo = *(const GAS bf16x8*)(zp + (long)(i - w + 1) * Z1P);
#pragma unroll
                    for (int e = 0; e < 8; ++e) s[e] -= bf2f(zo[e]); } }
        } else {
            const int c8 = (cc - 64) * 8; const bf16* xp = Z + (size_t)t0 * Z1P + 512 + c8; bf16* yp = F.Y + (size_t)t0 * D + 512 + c8;
            const float* cw = F.in[25];
            float w0[8], w1[8], w2[8], x1[8], x2[8];
#pragma unroll
            for (int e = 0; e < 8; ++e) { w0[e] = cw[c8 + e]; w1[e] = cw[512 + c8 + e]; w2[e] = cw[1024 + c8 + e]; x1[e] = 0.f; x2[e] = 0.f; }
            if (pos0 >= 2) { const bf16x8 a2 = *(const GAS bf16x8*)(xp - 2 * (size_t)Z1P), a1 = *(const GAS bf16x8*)(xp - (size_t)Z1P);
#pragma unroll
                for (int e = 0; e < 8; ++e) { x2[e] = bf2f(a2[e]); x1[e] = bf2f(a1[e]); } }
            for (int i = 0; i < 32; ++i) { const bf16* p = xp + (size_t)i * Z1P; const bf16x8 xv = __builtin_nontemporal_load((const GAS bf16x8*)p), gb = __builtin_nontemporal_load((const GAS bf16x8*)(p + 512));
                float y[8];
#pragma unroll
                for (int e = 0; e < 8; ++e) { const float x0 = bf2f(xv[e]); y[e] = bf2f(gb[e]) * (w0[e] * x2[e] + w1[e] * x1[e] + w2[e] * x0); x2[e] = x1[e]; x1[e] = x0; }
                v4u o; o.x = pk2h(y[0], y[1]); o.y = pk2h(y[2], y[3]); o.z = pk2h(y[4], y[5]); o.w = pk2h(y[6], y[7]);
                *(GAS v4u*)(yp + (size_t)i * D) = o; }
        }
    }
}
__device__ __forceinline__ void xa_attn_unit(Frame& F, int l, int pm, int pn) {
    const int b = pm / (SEQ / 256);
    for (int hh = 0; hh < 2; ++hh) {
        int tid = F.tid; asm volatile("" : "+v"(tid));
        const int lane = tid & 63, wid = F.wave, r32 = lane & 31, hi = lane >> 5;
        LAS unsigned char* Kl = F.lds; LAS unsigned char* Vl = F.lds + XA_KBYTES;
        const unsigned q = (unsigned)(pm * 256 + wid * 32 + r32);
        const int h = 2 * pn + hh;
        const bf16* Kg = F.KN + (size_t)((l * 4 + b) * 4 + h) * (NMEM * 128);
        const bf16* Vg = F.VT + (size_t)((l * 4 + b) * 4 + h) * (NMEM * 128);
        const bf16* Qp = F.XQ + (q * XAW + h * 128 + 8 * hi);
        bf16x8 qf[8];
#pragma unroll
        for (int ks = 0; ks < 8; ++ks) qf[ks] = *(const GAS bf16x8*)(Qp + 16 * ks);
        __syncthreads();
#pragma unroll
        for (int i = 0; i < 8; ++i) { const int id = tid + 512 * i, row = id >> 4, ch = id & 15; const v4u x = *(const GAS v4u*)(Kg + row * 128 + ch * 8); *(LAS v4u*)(Kl + row * XA_KROW + ch * 16) = x; }
#pragma unroll
        for (int i = 0; i < 8; ++i) { const int id = tid + 512 * i, row = id >> 5, ch = id & 31; const v4u x = *(const GAS v4u*)(Vg + row * 256 + ch * 8); *(LAS v4u*)(Vl + row * XA_VROW + ch * 16) = x; }
        float ss = 0.f;
#pragma unroll
        for (int ks = 0; ks < 8; ++ks)
#pragma unroll
            for (int e = 0; e < 8; ++e) { const float f = bf2f(qf[ks][e]); ss += f * f; }
        ss += __shfl_xor(ss, 32);
        const float sc = rsq(ss * (1.f / 128.f) + EPS) * XA_C2;
        const float* gq = F.in[8] + l * 128 + 8 * hi;
#pragma unroll
        for (int ks = 0; ks < 8; ++ks) { const f32x4 ga = *(const f32x4*)(gq + 16 * ks), gb = *(const f32x4*)(gq + 16 * ks + 4);
            v4u w; w.x = pk2(bf2f(qf[ks][0]) * sc * ga.x, bf2f(qf[ks][1]) * sc * ga.y); w.y = pk2(bf2f(qf[ks][2]) * sc * ga.z, bf2f(qf[ks][3]) * sc * ga.w);
            w.z = pk2(bf2f(qf[ks][4]) * sc * gb.x, bf2f(qf[ks][5]) * sc * gb.y); w.w = pk2(bf2f(qf[ks][6]) * sc * gb.z, bf2f(qf[ks][7]) * sc * gb.w);
            qf[ks] = __builtin_bit_cast(bf16x8, w); }
        __syncthreads();
        f32x16 s[8];
#pragma unroll
        for (int kvb = 0; kvb < 8; ++kvb) s[kvb] = f32x16{};
        const LAS unsigned char* kbase = Kl + r32 * XA_KROW + hi * 16;
        bf16x8 fa[4], fb[4];
#define XA_LDK(dst, st) do { _Pragma("unroll") for (int j_ = 0; j_ < 4; ++j_) dst[j_] = *(const LAS bf16x8*)(kbase + ((st) >> 1) * (32 * XA_KROW) + (4 * ((st) & 1) + j_) * 32); } while (0)
#define XA_MMK(src, st) do { _Pragma("unroll") for (int j_ = 0; j_ < 4; ++j_) s[(st) >> 1] = __builtin_amdgcn_mfma_f32_32x32x16_bf16(src[j_], qf[4 * ((st) & 1) + j_], s[(st) >> 1], 0, 0, 0); } while (0)
        XA_LDK(fa, 0);
#pragma unroll
        for (int st = 0; st < 16; st += 2) {
            XA_LDK(fb, st + 1); XA_MMK(fa, st); __builtin_amdgcn_sched_barrier(0);
            if (st + 2 < 16) XA_LDK(fa, st + 2);
            XA_MMK(fb, st + 1); __builtin_amdgcn_sched_barrier(0);
        }
#undef XA_LDK
#undef XA_MMK
        __syncthreads();
        float m = -INFINITY;
#pragma unroll
        for (int kvb = 0; kvb < 8; ++kvb)
#pragma unroll
            for (int r = 0; r < 16; ++r) m = fmaxf(m, s[kvb][r]);
        m = fmaxf(m, __shfl_xor(m, 32));
        float lsum = 0.f;
        bf16x8 pf[8][2];
#pragma unroll
        for (int kvb = 0; kvb < 8; ++kvb) {
#pragma unroll
            for (int r = 0; r < 16; ++r) { const float p = __builtin_amdgcn_exp2f(s[kvb][r] - m); s[kvb][r] = p; lsum += p; }
#pragma unroll
            for (int s2 = 0; s2 < 2; ++s2) { v4u w; w.x = pk2h(s[kvb][8 * s2 + 0], s[kvb][8 * s2 + 1]); w.y = pk2h(s[kvb][8 * s2 + 2], s[kvb][8 * s2 + 3]); w.z = pk2h(s[kvb][8 * s2 + 4], s[kvb][8 * s2 + 5]); w.w = pk2h(s[kvb][8 * s2 + 6], s[kvb][8 * s2 + 7]);
                pf[kvb][s2] = __builtin_bit_cast(bf16x8, w); } }
        lsum += __shfl_xor(lsum, 32);
        f32x16 o[4];
#pragma unroll
        for (int db = 0; db < 4; ++db) o[db] = f32x16{};
        const LAS unsigned char* vbase = Vl + r32 * XA_VROW + hi * 16;
#define XA_LDV(dst, st) do { _Pragma("unroll") for (int j_ = 0; j_ < 4; ++j_) dst[j_] = *(const LAS bf16x8*)(vbase + j_ * (32 * XA_VROW) + (st) * 32); } while (0)
#define XA_MMV(src, st) do { _Pragma("unroll") for (int j_ = 0; j_ < 4; ++j_) o[j_] = __builtin_amdgcn_mfma_f32_32x32x16_bf16(src[j_], pf[(st) >> 1][(st) & 1], o[j_], 0, 0, 0); } while (0)
        XA_LDV(fa, 0);
#pragma unroll
        for (int st = 0; st < 16; st += 2) {
            XA_LDV(fb, st + 1); XA_MMV(fa, st); __builtin_amdgcn_sched_barrier(0);
            if (st + 2 < 16) XA_LDV(fa, st + 2);
            XA_MMV(fb, st + 1); __builtin_amdgcn_sched_barrier(0);
        }
#undef XA_LDV
#undef XA_MMV
        LAS unsigned char* stg = Kl + wid * (32 * XA_KROW);
        if constexpr (MK_F8XO) {
            const float inv = F8_XOASCALE / lsum;
#pragma unroll
            for (int db = 0; db < 4; ++db)
#pragma unroll
                for (int g4 = 0; g4 < 4; ++g4) { const int d0 = 32 * db + 8 * g4 + 4 * hi;
                    *(LAS unsigned*)(stg + r32 * 144 + d0) = pg8::pk4_f8(o[db][4 * g4 + 0] * inv, o[db][4 * g4 + 1] * inv, o[db][4 * g4 + 2] * inv, o[db][4 * g4 + 3] * inv); }
            LDS_WAIT(); asm volatile("" ::: "memory");
            unsigned char* Ob8 = (unsigned char*)F.XO + ((unsigned)(pm * 256 + wid * 32) * XAW + h * 128);
#pragma unroll
            for (int i = 0; i < 4; ++i) { const int row = 8 * i + (lane >> 3), ch = lane & 7; const v4u v = *(const LAS v4u*)(stg + row * 144 + ch * 16); *(GAS v4u*)(Ob8 + row * XAW + ch * 16) = v; }
            continue;
        }
        const float inv = 1.0f / lsum;
#pragma unroll
        for (int db = 0; db < 4; ++db)
#pragma unroll
            for (int g4 = 0; g4 < 4; ++g4) { const int d0 = 32 * db + 8 * g4 + 4 * hi; u32x2 w; w.x = pk2(o[db][4 * g4 + 0] * inv, o[db][4 * g4 + 1] * inv); w.y = pk2(o[db][4 * g4 + 2] * inv, o[db][4 * g4 + 3] * inv);
                *(LAS u32x2*)(stg + r32 * XA_KROW + d0 * 2) = w; }
        LDS_WAIT(); asm volatile("" ::: "memory");
        bf16* Ob = F.XO + ((unsigned)(pm * 256 + wid * 32) * XAW + h * 128);
#pragma unroll
        for (int i = 0; i < 8; ++i) { const int row = 4 * i + (lane >> 4), ch = lane & 15; const v4u v = *(const LAS v4u*)(stg + row * XA_KROW + ch * 16); *(GAS v4u*)(Ob + row * XAW + ch * 8) = v; }
    }
}

constexpr int RS_OFF = 131072;
template <class Sched> __device__ __forceinline__ const LAS float* rs_prepare(Frame& F, const Sched& S) {
    LAS float* t = (LAS float*)(F.lds + RS_OFF);
    int p0 = -1, p1 = -1, p2 = -1, p3 = -1; pg8::Unit u;
    for (int i = 0; S.next(i, u); ++i) { const int pm = u.pm; if (pm == p0 || pm == p1 || pm == p2 || pm == p3) continue; if (p0 < 0) p0 = pm; else if (p1 < 0) p1 = pm; else if (p2 < 0) p2 = pm; else if (p3 < 0) p3 = pm; }
    __syncthreads();
    if (F.tid < 4) t[F.tid] = __builtin_bit_cast(float, F.tid == 0 ? p0 : F.tid == 1 ? p1 : F.tid == 2 ? p2 : p3);
#pragma unroll
    for (int pass = 0; pass < 2; ++pass) { const int sl = 2 * pass + (F.tid >> 8); const int pm = sl == 0 ? p0 : sl == 1 ? p1 : sl == 2 ? p2 : p3;
        if (pm >= 0) t[16 + 256 * sl + (F.tid & 255)] = pg8::row_rstd(F.SSQ, pm * 256 + (F.tid & 255)); }
    __syncthreads();
    return t;
}

struct Args { cfp_t in[27]; float* out; unsigned char* ws; int ph_lo, ph_hi, li, pad; };
#define MKFRAME() do { int t_; asm volatile("v_mbcnt_lo_u32_b32 %0, -1, 0\n\tv_mbcnt_hi_u32_b32 %0, -1, %0\n\tv_lshl_add_u32 %0, %1, 6, %0" : "=&v"(t_) : "s"(wave_s));     \
    const __attribute__((address_space(4))) Args* ap_ = (const __attribute__((address_space(4))) Args*)__builtin_amdgcn_kernarg_segment_ptr(); asm volatile("" : "+s"(ap_)); unsigned char* ws_ = ap_->ws; \
    F.lds = (LAS unsigned char*)lds; F.MISC = (volatile LAS unsigned*)(F.lds + MISC_OFF); \
    F.tid = t_; F.lane = F.tid & 63; F.wave = __builtin_amdgcn_readfirstlane(F.tid >> 6); \
    F.G = gridDim.x; { const int bx = blockIdx.x; F.vcu = (F.G % 8 == 0) ? (bx % 8) * (F.G / 8) + bx / 8 : bx; } \
    F.ws = ws_; F.in = ap_->in; F.x = ap_->in[0]; F.out = ap_->out; F.ctl = (gu32*)(ws_ + WS_CTL); \
    F.XB = (bf16*)(ws_ + WS_XB); F.Y = (bf16*)(ws_ + WS_Y); F.XQ = (bf16*)(ws_ + WS_XQ); F.XO = (bf16*)(ws_ + WS_XO); F.BIG = (bf16*)(ws_ + WS_BIG); \
    F.MEMN = (bf16*)(ws_ + WS_MEMN); F.KVRAW = (bf16*)(ws_ + WS_KVRAW); F.KN = (bf16*)(ws_ + WS_KN); F.VT = (bf16*)(ws_ + WS_VT); F.WSP = (bf16*)(ws_ + WS_WSP); \
    F.LOGF = (float*)(ws_ + WS_LOGF); F.CUM = (float*)(ws_ + WS_CUM); F.SSQ = (float*)(ws_ + WS_SSQ); } while (0)
#define GRID_BAR() do { if (N_LAUNCHES == 1) { MKFRAME(); XcdBarrier b_; b_.bar = (unsigned*)(F.ctl + CW_BAR); b_.x = xb_xcc_id(); b_.st = F.MISC + 8; xcd_barrier(b_, F.tid); } } while (0)
#define IN(k) (lo <= (k) && (k) < hi)
#ifdef PROBE_PHASE
#define PROBE_REPS(k) (((k) == PROBE_PHASE) ? 2 : 1)
#else
#define PROBE_REPS(k) 1
#endif
#ifdef PROBE_XA_PHASE
#define PROBE_XA(k) (((k) == PROBE_XA_PHASE) ? 2 : 1)
#else
#define PROBE_XA(k) 1
#endif
#ifdef PROBE_EPI_PHASE
#define PROBE_EPI(k) (((k) == PROBE_EPI_PHASE) ? 2 : 1)
#else
#define PROBE_EPI(k) 1
#endif
#define BOTH(k) (IN(k) && IN((k) + 1))
template <int l> __device__ __forceinline__ void layer_phases(const int lo, const int hi, const int wave_s) {
    extern __shared__ __attribute__((aligned(16))) unsigned char lds[];
    Frame F; unsigned char* ws;
        const int pb = (l == 0) ? PH_IN0 : PH_IN1;
        if (IN(pb)) for (int rep_ = 0; rep_ < PROBE_REPS(pb); ++rep_) { MKFRAME(); ws = F.ws;
            if (l == 0) {
                if (blockIdx.x < 32) cumsum_seq(F, blockIdx.x);
                { pg8::Gemm g{F.XB, (const bf16*)(ws + WS_WIN0), T, N_IN0, D}; pg8::StaticOrder S; S.init(T, N_IN0, F.G, (int)blockIdx.x);
                  pg8::EpiIn0 E{F.BIG, N_IN0, rs_prepare(F, S), F.in[19], F.in[20], FOX_C2};
                  pg8::gemm_phase<pg8::EpiIn0, pg8::StaticOrder, PG8_ALIGN, PG8_SP2>(F.lds + RING_OFF, g, S, E, F.tid); }
            } else {
                pg8::Gemm g{F.XB, (const bf16*)(ws + WS_WIN1), T, N_IN1, D}; pg8::StaticOrder S; S.init(T, N_IN1, F.G, (int)blockIdx.x);
                pg8::EpiIn1 E{F.BIG, Z1P, rs_prepare(F, S)};
                pg8::gemm_phase<pg8::EpiIn1, pg8::StaticOrder, PG8_ALIGN, PG8_SP2>(F.lds + RING_OFF, g, S, E, F.tid);
            }
            if (BOTH(pb)) GRID_BAR();
        }
        if (IN(pb + 1)) for (int rep_ = 0; rep_ < PROBE_REPS(pb + 1); ++rep_) { MKFRAME(); ws = F.ws;
            if (l == 0) {
                for (;;) {
                    MKFRAME();
                    volatile LAS unsigned* mail = F.MISC + 16;
                    __syncthreads();
                    if (F.tid == 0) mail[0] = __hip_atomic_fetch_add((unsigned*)(F.ctl + CW_Q0), 1u, __ATOMIC_RELAXED, __HIP_MEMORY_SCOPE_AGENT);
                    __syncthreads();
                    const int it = __builtin_amdgcn_readfirstlane((int)mail[0]);
                    if (it >= 32 + 1024 + 256) break;
                    if (it < 32) {
                        const int l2 = it >> 4;
                        pg8::Gemm g{F.MEMN, lw(F, l2, L_WKV), MROWS, D, D}; pg8::OneUnit S; S.u.pm = (it >> 2) & 3; S.u.pn = it & 3;
                        pg8::EpiPlain E{F.KVRAW + (size_t)l2 * MROWS * D, D, nullptr};
                        pg8::gemm_phase<pg8::EpiPlain, pg8::OneUnit, PG8_ALIGN, PG8_SP2>(F.lds + RING_OFF, g, S, E, F.tid);
                    } else if (it < 32 + 1024) {
                        const int j = it - 32, hh = 7 - (j >> 7), qb = 31 - ((j & 127) >> 2), b = j & 3;
                        float th;
                        { const float gm = fabsf(F.in[19][F.lane] * F.in[20][F.lane]); float mx = gm;
        #pragma unroll
                          for (int o = 1; o < 64; o <<= 1) mx = fmaxf(mx, __shfl_xor(mx, o));
                          th = 2.0f * (64.0f * FOX_C2 * mx * 1.02f) + 40.0f; }
                        attn_body::attn_unit<MK_THRL>(b, hh, qb, (const attn_body::bf16*)(F.BIG + 1024), (const attn_body::bf16*)(F.BIG + 1536), (const attn_body::bf16*)(F.BIG + 2048), (attn_body::bf16*)(F.Y + 512), F.CUM, th, (char*)lds + RING_OFF, F.tid);
                    } else {
                        const int blk = it - 1056;
                        gmlp_item(F, blk);
                    }
                }
            } else {
                mix1_phase(F);
            }
            if (BOTH(pb + 1)) GRID_BAR();
        }
        if (IN(pb + 2)) for (int rep_ = 0; rep_ < PROBE_REPS(pb + 2); ++rep_) { MKFRAME(); ws = F.ws;
            if (l == 0 && blockIdx.x < 32) xa_kv_finalize(F, blockIdx.x);
            pg8::Gemm g{F.Y, (const bf16*)(ws + (l == 0 ? WS_WOUT0 : WS_WOUT1)), T, D, D}; pg8::StaticOrder S; S.init(T, D, F.G, (int)blockIdx.x);
            pg8::EpiRes E{nullptr, F.XB, nullptr, F.SSQ, D, 1.0f};
            pg8::gemm_phase<pg8::EpiRes, pg8::StaticOrder, PG8_ALIGN, PG8_SP2>(F.lds + RING_OFF, g, S, E, F.tid, PROBE_EPI(pb + 2));
            if (BOTH(pb + 2)) GRID_BAR();
        }
        if (IN(pb + 3)) for (int rep_ = 0; rep_ < PROBE_REPS(pb + 3); ++rep_) { MKFRAME(); ws = F.ws;
            pg8::Gemm g{F.XB, lw(F, l, L_WQ), T, XAW, D}; pg8::StaticOrder S; S.init(T, XAW, F.G, (int)blockIdx.x);
            pg8::EpiPlain E{F.XQ, XAW, rs_prepare(F, S)};
            pg8::gemm_phase<pg8::EpiPlain, pg8::StaticOrder, PG8_ALIGN, PG8_SP2>(F.lds + RING_OFF, g, S, E, F.tid);
            VM_WAIT(); __syncthreads();
            __builtin_amdgcn_fence(__ATOMIC_ACQUIRE, "agent"); VM_WAIT(); __syncthreads();
            pg8::Unit u;
            for (int i = 0; S.next(i, u); ++i) for (int xr_ = 0; xr_ < PROBE_XA(pb + 3); ++xr_) xa_attn_unit(F, l, u.pm, u.pn);
            if (BOTH(pb + 3)) GRID_BAR();
        }
        if (IN(pb + 4)) for (int rep_ = 0; rep_ < PROBE_REPS(pb + 4); ++rep_) { MKFRAME(); ws = F.ws;
            constexpr bool f8 = MK_F8XO != 0;
            pg8::Gemm g{F.XO, lw(F, l, L_WO), T, D, f8 ? XAW / 2 : XAW}; pg8::StaticOrder S; S.init(T, D, F.G, (int)blockIdx.x);
            pg8::EpiResT<f8> E{nullptr, F.XB, nullptr, F.SSQ, D, f8 ? 1.0f / (F8_XOASCALE * F8_XOWSCALE) : 1.0f};
            pg8::gemm_phase<pg8::EpiResT<f8>, pg8::StaticOrder, PG8_ALIGN, PG8_SP2>(F.lds + RING_OFF, g, S, E, F.tid);
            if (BOTH(pb + 4)) GRID_BAR();
        }
        if (IN(pb + 5)) for (int rep_ = 0; rep_ < PROBE_REPS(pb + 5); ++rep_) { MKFRAME(); ws = F.ws;
            pg8::Gemm g{F.XB, lw(F, l, L_WGU), T, 2 * DFF, D}; pg8::StaticOrder S; S.init(T, 2 * DFF, F.G, (int)blockIdx.x);
            constexpr bool f8 = (MK_F8DN >> l) & 1;
            pg8::EpiSwigluT<f8> E{F.BIG, DFF, rs_prepare(F, S), F8_HSCALE};
            pg8::gemm_phase<pg8::EpiSwigluT<f8>, pg8::StaticOrder, PG8_ALIGN, PG8_SP2>(F.lds + RING_OFF, g, S, E, F.tid, PROBE_EPI(pb + 5));
            if (BOTH(pb + 5)) GRID_BAR();
        }
        if (IN(pb + 6)) for (int rep_ = 0; rep_ < PROBE_REPS(pb + 6); ++rep_) { MKFRAME(); ws = F.ws;
            constexpr bool f8 = (MK_F8DN >> l) & 1;
            pg8::Gemm g{F.BIG, lw(F, l, L_WD), T, D, f8 ? DFF / 2 : DFF}; pg8::StaticOrder S; S.init(T, D, F.G, (int)blockIdx.x);
            pg8::EpiResT<f8> E{nullptr, F.XB, l == 0 ? nullptr : F.out, F.SSQ, D, 1.0f / (F8_HSCALE * F8_WSCALE)};
            pg8::gemm_phase<pg8::EpiResT<f8>, pg8::StaticOrder, PG8_ALIGN, PG8_SP2>(F.lds + RING_OFF, g, S, E, F.tid);
            if (BOTH(pb + 6)) GRID_BAR();
        }
    }
__global__ void __launch_bounds__(NWAVES * 64, 2) mk_fwd(Args args) {
    extern __shared__ __attribute__((aligned(16))) unsigned char lds[];
    int wave_s = __builtin_amdgcn_readfirstlane((int)threadIdx.x >> 6); asm volatile("" : "+s"(wave_s));
    Frame F;
    MKFRAME();
    for (int u = F.tid; u < (LDS_BYTES - LDSCTL_OFF) / 4; u += NWAVES * 64) ((LAS unsigned*)(F.lds + LDSCTL_OFF))[u] = 0u;
    __syncthreads();
    if (N_LAUNCHES == 1) (void)xcd_barrier_post((unsigned*)(F.ctl + CW_BAR), F.MISC + 8, F.tid);
    const int lo = args.ph_lo, hi = args.ph_hi;
    if (IN(PH_PRO)) for (int rep_ = 0; rep_ < PROBE_REPS(PH_PRO); ++rep_) { MKFRAME(); p0_prologue(F); if (BOTH(PH_PRO)) GRID_BAR(); }
    layer_phases<0>(lo, hi, wave_s);
    layer_phases<1>(lo, hi, wave_s);
#ifdef PROBE_BARS
    for (int pb_ = 0; pb_ < PROBE_BARS; ++pb_) { MKFRAME(); GRID_BAR(); }
#endif
}
#undef MKFRAME
#undef IN
#undef BOTH
#undef GRID_BAR

extern "C" void kernel_launch(void* const* d_in, const int* in_sizes, int n_in, void* d_out, int out_size, void* d_ws, size_t ws_size, hipStream_t stream) {
    static int grid = 0;
    if (grid == 0) {
        if (n_in != 27 || in_sizes[0] != T * D || out_size != T * D || ws_size < WS_END) { fprintf(stderr, "kernel_launch: built for 27 inputs, x and out of %d floats, >= %zu bytes of workspace; got n_in %d, in0 %d, out %d, ws %zu; nothing launched\n", T * D, (size_t)WS_END, n_in, n_in > 0 ? in_sizes[0] : -1, out_size, ws_size); grid = -1; return; }
        int dev = 0, cus = 0, per_cu = 0;
        if (hipGetDevice(&dev) != hipSuccess || hipDeviceGetAttribute(&cus, hipDeviceAttributeMultiprocessorCount, dev) != hipSuccess) { fprintf(stderr, "kernel_launch: hipGetDevice / hipDeviceGetAttribute failed; nothing launched\n"); grid = -1; return; }
        if (hipFuncSetAttribute((const void*)mk_fwd, hipFuncAttributeMaxDynamicSharedMemorySize, LDS_BYTES) != hipSuccess) { fprintf(stderr, "kernel_launch: hipFuncSetAttribute failed\n"); grid = -1; return; }
        if (hipOccupancyMaxActiveBlocksPerMultiprocessor(&per_cu, (const void*)mk_fwd, NWAVES * 64, LDS_BYTES) != hipSuccess || per_cu < 1)
            fprintf(stderr, "kernel_launch: note: the occupancy query reports %d workgroups per CU\n", per_cu);
        (void)hipGetLastError();
        grid = cus;
        if (grid != 256) fprintf(stderr, "kernel_launch: %d CUs; the attention schedule is built for 256\n", grid);
    }
    if (grid < 0) return;
    if (hipMemsetAsync((char*)d_ws + WS_CTL, 0, CTL_ZERO_BYTES, stream) != hipSuccess) { fprintf(stderr, "kernel_launch: hipMemsetAsync of the control words failed; nothing launched\n"); return; }
    Args a{};
    for (int i = 0; i < 27; ++i) a.in[i] = (const float*)d_in[i];
    a.out = (float*)d_out; a.ws = (unsigned char*)d_ws;
    for (int li = 0; li < N_LAUNCHES; ++li) {
        a.ph_lo = (N_LAUNCHES == 1) ? 0 : li; a.ph_hi = (N_LAUNCHES == 1) ? N_PHASES : li + 1; a.li = li;
        hipLaunchKernelGGL(mk_fwd, dim3(grid), dim3(NWAVES * 64), LDS_BYTES, stream, a);
        const hipError_t le = hipPeekAtLastError();
        if (le != hipSuccess) { fprintf(stderr, "kernel_launch: launch %d failed: %s\n", li, hipGetErrorName(le)); break; }
    }
}
```

```cpp
#include <hip/hip_runtime.h>
#include <cstdio>
#include <cstdint>
namespace pg8 {
#define PG8_LAS __attribute__((address_space(3)))
typedef unsigned short bf16_t;
typedef short bf16x8 __attribute__((ext_vector_type(8)));
typedef float f32x4 __attribute__((ext_vector_type(4)));
typedef float f32x2 __attribute__((ext_vector_type(2)));
typedef unsigned u32x4 __attribute__((ext_vector_type(4)));
typedef unsigned u32x2 __attribute__((ext_vector_type(2)));
typedef int i32x4 __attribute__((ext_vector_type(4)));
typedef int i32x8 __attribute__((ext_vector_type(8)));
constexpr int BM = 256, BK = 64, HALF = 128, HTB = HALF * BK * 2  , STAGE_BYTES = 8 * HTB, NXCD = 8, WGM = 8;

__host__ __device__ __forceinline__ int lds_byte(int r, int c) { const int st = (r >> 4) * 2 + (c >> 5), rr = r & 15, cc = c & 31, ob = rr * 64 + cc * 2; return st * 1024 + (ob ^ (((ob >> 9) & 1) << 5)); }
__host__ __device__ __forceinline__ void stage_rc(int b, int& R, int& C) { const int st = b / 1024, sb = b % 1024, swz = sb ^ (((sb >> 9) & 1) << 5); R = (st >> 1) * 16 + swz / 64; C = (st & 1) * 32 + (swz % 64) / 2; }
__host__ __device__ __forceinline__ int perm32(int rho) { const int n = rho >> 4, i = rho & 15; return 8 * (i >> 2) + 4 * n + (i & 3); }

struct Unit { int pm, pn; };
struct Gemm { const bf16_t* A; const bf16_t* Bt; int M, N, K; };

struct StaticOrder {
    int nM, nN, nwg, G, c;
    __host__ __device__ __forceinline__ void init(int M, int N, int G_, int c_) { nM = M / BM; nN = N / BM; nwg = nM * nN; G = G_; c = c_; }
    __host__ __device__ __forceinline__ bool next(int i, Unit& u) const {
        const long L = (long)i * G + c; if (L >= nwg) return false;
        int wgid = (int)L; { const int q = nwg / NXCD, r = nwg % NXCD, xcd = wgid % NXCD, off = wgid / NXCD; wgid = (xcd < r ? xcd * (q + 1) : r * (q + 1) + (xcd - r) * q) + off; }
        const int nig = WGM * nN, gid = wgid / nig, fm = gid * WGM, gsz = (nM - fm) < WGM ? (nM - fm) : WGM;
        u.pm = fm + ((wgid % nig) % gsz); u.pn = (wgid % nig) / gsz; return true;
    }
    __device__ __forceinline__ void a_ready(const Unit&) const {}
    __device__ __forceinline__ void done(const Unit&) const {}
};
struct OneUnit { Unit u;
    __device__ __forceinline__ bool next(int i, Unit& o) const { if (i != 0) return false; o = u; return true; }
    __device__ __forceinline__ void a_ready(const Unit&) const {}
    __device__ __forceinline__ void done(const Unit&) const {}
};

__device__ __forceinline__ unsigned cvt_pk_bf16(float lo, float hi) { unsigned r; asm volatile("v_cvt_pk_bf16_f32 %0, %1, %2" : "=v"(r) : "v"(lo), "v"(hi)); return r; }
__device__ __forceinline__ u32x4 pack8(const f32x4 a, const f32x4 b) { u32x4 w; w.x = cvt_pk_bf16(a[0], a[1]); w.y = cvt_pk_bf16(a[2], a[3]); w.z = cvt_pk_bf16(b[0], b[1]); w.w = cvt_pk_bf16(b[2], b[3]); return w; }
constexpr float RMS_EPS = 1e-6f;
__device__ __forceinline__ float row_rstd(const float* ssq, int row) {
    const f32x4* p = (const f32x4*)(ssq + (size_t)row * 16);
    const f32x4 a = p[0], b = p[1], c = p[2], d = p[3];
    const float s = (((a[0] + a[1]) + (a[2] + a[3])) + ((b[0] + b[1]) + (b[2] + b[3]))) + (((c[0] + c[1]) + (c[2] + c[3])) + ((d[0] + d[1]) + (d[2] + d[3])));
    return __builtin_amdgcn_rsqf(s * (1.0f / 1024.0f) + RMS_EPS);
}
struct RsTab { const PG8_LAS float* t;
    __device__ __forceinline__ int slot(int pm) const { int s = 0;
#pragma unroll
        for (int k = 1; k < 4; ++k) s = (__builtin_bit_cast(int, t[k]) == pm) ? k : s; return s; }
    __device__ __forceinline__ float get(int slot, int r) const { return t[16 + 256 * slot + r]; }
};
__device__ __forceinline__ void ssq4(f32x2& s2, const f32x4 x) { const f32x2 lo = {x[0], x[1]}, hi = {x[2], x[3]}; s2 += lo * lo; s2 += hi * hi; }
__device__ __forceinline__ float sigmoid_fast(float t) { return __builtin_amdgcn_rcpf(1.0f + __builtin_amdgcn_exp2f(-1.4426950408889634f * t)); }
__device__ __forceinline__ float gelu_tanh(float x) { const float t = 1.5957691216057308f * (x + 0.044715f * x * x * x); return x * sigmoid_fast(t); }
__device__ __forceinline__ float silu_f(float x) { return x * sigmoid_fast(x); }

struct EpiPlain {
    static constexpr bool PERM = true, AFTER_DRAIN = false, F8 = false; static constexpr int NVM = 16;
    bf16_t* O; int ldc; const PG8_LAS float* rst;
    __device__ __forceinline__ void operator()(const f32x4 (&acc)[2][2][4][2], const Unit& u, int wr, int wc, int fr, int fq) const {
        const int row0 = u.pm * BM + wr * 64 + fr, col0 = u.pn * BM + wc * 32 + 8 * fq;
        const RsTab R{rst}; const int rsl = rst ? R.slot(u.pm) : 0;
#pragma unroll
        for (int ai = 0; ai < 2; ++ai)
#pragma unroll
            for (int m = 0; m < 4; ++m) { const int row = row0 + ai * HALF + m * 16; const float rs = rst ? R.get(rsl, ai * HALF + wr * 64 + m * 16 + fr) : 1.0f; bf16_t* rowp = O + (size_t)row * ldc + col0;
#pragma unroll
                for (int bj = 0; bj < 2; ++bj) *(u32x4*)(rowp + bj * HALF) = pack8(acc[ai][bj][m][0] * rs, acc[ai][bj][m][1] * rs); }
    }
};
struct EpiIn0 {
    static constexpr bool PERM = true, AFTER_DRAIN = false, F8 = false; static constexpr int NVM = 16;
    bf16_t* O; int ldc; const PG8_LAS float* rst; const float* gq; const float* gk; float qscale;
    __device__ __forceinline__ void operator()(const f32x4 (&acc)[2][2][4][2], const Unit& u, int wr, int wc, int fr, int fq) const {
        const int row0 = u.pm * BM + wr * 64 + fr; const int pn = u.pn;
        const bool headed = (pn >= 4 && pn < 8);
        const RsTab R{rst}; const int rsl = R.slot(u.pm);
        f32x4 gn[2][2];
#pragma unroll
        for (int bj = 0; bj < 2; ++bj)
#pragma unroll
            for (int n = 0; n < 2; ++n) { gn[bj][n] = (f32x4){1.f, 1.f, 1.f, 1.f};
                if (pn == 4 || pn == 5) { const int d = 32 * bj + 8 * fq + 4 * n; const f32x4 a = *(const f32x4*)(gq + d), b = *(const f32x4*)(gk + d); gn[bj][n] = a * b * qscale; } }
#pragma unroll
        for (int ai = 0; ai < 2; ++ai)
#pragma unroll
            for (int m = 0; m < 4; ++m) { const int row = row0 + ai * HALF + m * 16; const float rs = R.get(rsl, ai * HALF + wr * 64 + m * 16 + fr);
                f32x4 v[2][2];
#pragma unroll
                for (int bj = 0; bj < 2; ++bj)
#pragma unroll
                    for (int n = 0; n < 2; ++n) v[bj][n] = acc[ai][bj][m][n] * rs;
                if (pn < 4) {
#pragma unroll
                    for (int bj = 0; bj < 2; ++bj)
#pragma unroll
                        for (int n = 0; n < 2; ++n) { const f32x4 x = v[bj][n]; const f32x4 in = (x * x) * 0.044715f + 1.0f; const f32x4 tt = (x * in) * (-1.5957691216057308f * 1.4426950408889634f);
                            f32x4 ex;
#pragma unroll
                            for (int e = 0; e < 4; ++e) ex[e] = __builtin_amdgcn_exp2f(tt[e]);
                            const f32x4 d = ex + 1.0f; f32x4 r;
#pragma unroll
                            for (int e = 0; e < 4; ++e) r[e] = __builtin_amdgcn_rcpf(d[e]);
                            v[bj][n] = x * r; }
                } else if (headed) {
                    f32x2 s2 = {0.f, 0.f};
#pragma unroll
                    for (int bj = 0; bj < 2; ++bj)
#pragma unroll
                        for (int n = 0; n < 2; ++n) ssq4(s2, v[bj][n]);
                    float ss = s2[0] + s2[1];
                    ss += __shfl_xor(ss, 16); ss += __shfl_xor(ss, 32);
                    const float r = __builtin_amdgcn_rsqf(ss * (1.0f / 64.0f) + RMS_EPS);
#pragma unroll
                    for (int bj = 0; bj < 2; ++bj)
#pragma unroll
                        for (int n = 0; n < 2; ++n) v[bj][n] = v[bj][n] * r * gn[bj][n];
                }
                bf16_t* rowp = O + (size_t)row * ldc + pn * BM + 8 * fq;
#pragma unroll
                for (int bj = 0; bj < 2; ++bj) { const int c = headed ? (64 * wc + 32 * bj) : (128 * bj + 32 * wc); *(u32x4*)(rowp + c) = pack8(v[bj][0], v[bj][1]); } }
    }
};
struct EpiIn1 {
    static constexpr bool PERM = true, AFTER_DRAIN = false, F8 = false; static constexpr int NVM = 8;
    bf16_t* O; int ldc; const PG8_LAS float* rst;
    __device__ __forceinline__ void operator()(const f32x4 (&acc)[2][2][4][2], const Unit& u, int wr, int wc, int fr, int fq) const {
        const int row0 = u.pm * BM + wr * 64 + fr; const int pn = u.pn;
        const RsTab R{rst}; const int rsl = R.slot(u.pm);
        const bool pair = (pn >= 2 && pn < 6);
        const int cbase = pair ? 512 + 128 * (pn - 2) + wc * 32 + 8 * fq : (pn < 2 ? 256 * pn : 1024 + 256 * (pn - 6)) + wc * 32 + 8 * fq;
#pragma unroll
        for (int ai = 0; ai < 2; ++ai)
#pragma unroll
            for (int m = 0; m < 4; ++m) { const int row = row0 + ai * HALF + m * 16; const float rs = R.get(rsl, ai * HALF + wr * 64 + m * 16 + fr); bf16_t* rowp = O + (size_t)row * ldc + cbase;
                if (pair) { const float r2 = rs * rs; *(u32x4*)rowp = pack8(acc[ai][0][m][0] * acc[ai][1][m][0] * r2, acc[ai][0][m][1] * acc[ai][1][m][1] * r2); }
                else {
#pragma unroll
                    for (int bj = 0; bj < 2; ++bj) *(u32x4*)(rowp + bj * HALF) = pack8(acc[ai][bj][m][0] * rs, acc[ai][bj][m][1] * rs); } }
    }
};
__device__ __forceinline__ float clamp_f8(float v) { return __builtin_amdgcn_fmed3f(v, -448.0f, 448.0f); }
__device__ __forceinline__ unsigned pk4_f8(float a, float b, float c, float d) { int r = __builtin_amdgcn_cvt_pk_fp8_f32(clamp_f8(a), clamp_f8(b), 0, false); r = __builtin_amdgcn_cvt_pk_fp8_f32(clamp_f8(c), clamp_f8(d), r, true); return (unsigned)r; }
template <bool OUT8> struct EpiSwigluT {
    static constexpr bool PERM = true, AFTER_DRAIN = false, F8 = false; static constexpr int NVM = 8;
    bf16_t* O; int ldc; const PG8_LAS float* rst; float hscale;
    __device__ __forceinline__ void operator()(const f32x4 (&acc)[2][2][4][2], const Unit& u, int wr, int wc, int fr, int fq) const {
        const int row0 = u.pm * BM + wr * 64 + fr, col0 = u.pn * HALF + wc * 32 + 8 * fq;
        const RsTab R{rst}; const int rsl = R.slot(u.pm);
#pragma unroll
        for (int ai = 0; ai < 2; ++ai)
#pragma unroll
            for (int m = 0; m < 4; ++m) { const int row = row0 + ai * HALF + m * 16; const float rs = R.get(rsl, ai * HALF + wr * 64 + m * 16 + fr);
                const float c1 = -1.4426950408889634f * rs, rs2 = OUT8 ? rs * rs * hscale : rs * rs;
                f32x4 o[2];
#pragma unroll
                for (int n = 0; n < 2; ++n) { const f32x4 g = acc[ai][0][m][n], up = acc[ai][1][m][n];
                    const f32x4 t = g * c1; f32x4 ex;
#pragma unroll
                    for (int e = 0; e < 4; ++e) ex[e] = __builtin_amdgcn_exp2f(t[e]);
                    const f32x4 d = ex + 1.0f; f32x4 r;
#pragma unroll
                    for (int e = 0; e < 4; ++e) r[e] = __builtin_amdgcn_rcpf(d[e]);
                    o[n] = ((g * up) * rs2) * r; }
                if constexpr (OUT8) { u32x2 w; w.x = pk4_f8(o[0][0], o[0][1], o[0][2], o[0][3]); w.y = pk4_f8(o[1][0], o[1][1], o[1][2], o[1][3]);
                    __builtin_nontemporal_store(w, (u32x2*)((unsigned char*)O + (size_t)row * ldc + col0)); }
                else __builtin_nontemporal_store(pack8(o[0], o[1]), (u32x4*)(O + (size_t)row * ldc + col0)); }
    }
};
__device__ __forceinline__ f32x4 bf_lo4(const u32x4 w) { return (f32x4){__builtin_bit_cast(float, w.x << 16), __builtin_bit_cast(float, w.x & 0xffff0000u), __builtin_bit_cast(float, w.y << 16), __builtin_bit_cast(float, w.y & 0xffff0000u)}; }
__device__ __forceinline__ f32x4 bf_hi4(const u32x4 w) { return (f32x4){__builtin_bit_cast(float, w.z << 16), __builtin_bit_cast(float, w.z & 0xffff0000u), __builtin_bit_cast(float, w.w << 16), __builtin_bit_cast(float, w.w & 0xffff0000u)}; }
typedef __bf16 bf16x2_t __attribute__((ext_vector_type(2)));
__device__ __forceinline__ float dot2bf(unsigned w, float c) { const bf16x2_t v = __builtin_bit_cast(bf16x2_t, w); return __builtin_amdgcn_fdot2_f32_bf16(v, v, c, false); }
template <bool F8_> struct EpiResT {
    static constexpr bool PERM = true, AFTER_DRAIN = false, F8 = F8_; static constexpr int NVM = 16;
    const float* base32; bf16_t* xb; float* out32; float* ssq; int ldc; float ascale;
    __device__ __forceinline__ void operator()(const f32x4 (&acc)[2][2][4][2], const Unit& u, int wr, int wc, int fr, int fq) const {
        const int row0 = u.pm * BM + wr * 64 + fr, col0 = u.pn * BM + wc * 32 + 8 * fq;
        u32x4 pre[2][4][2];
        if (!base32) {
#pragma unroll
            for (int ai = 0; ai < 2; ++ai)
#pragma unroll
                for (int m = 0; m < 4; ++m)
#pragma unroll
                    for (int bj = 0; bj < 2; ++bj) pre[ai][m][bj] = *(const u32x4*)(xb + (size_t)(row0 + ai * HALF + m * 16) * ldc + col0 + bj * HALF);
        }
#pragma unroll
        for (int ai = 0; ai < 2; ++ai) {
#pragma unroll
            for (int m = 0; m < 4; ++m) { const int row = row0 + ai * HALF + m * 16; const size_t off = (size_t)row * ldc + col0;
                f32x4 v[2][2]; float ss = 0.f;
#pragma unroll
                for (int bj = 0; bj < 2; ++bj) {
                    f32x4 b0, b1;
                    if (base32) { b0 = *(const f32x4*)(base32 + off + bj * HALF); b1 = *(const f32x4*)(base32 + off + bj * HALF + 4); }
                    else { b0 = bf_lo4(pre[ai][m][bj]); b1 = bf_hi4(pre[ai][m][bj]); }
                    if constexpr (F8_) { v[bj][0] = b0 + acc[ai][bj][m][0] * ascale; v[bj][1] = b1 + acc[ai][bj][m][1] * ascale; } else { v[bj][0] = b0 + acc[ai][bj][m][0]; v[bj][1] = b1 + acc[ai][bj][m][1]; }
                }
                if (out32) {
#pragma unroll
                    for (int bj = 0; bj < 2; ++bj) { *(f32x4*)(out32 + off + bj * HALF) = v[bj][0]; *(f32x4*)(out32 + off + bj * HALF + 4) = v[bj][1]; }
                } else {
                    float sq = 0.f;
#pragma unroll
                    for (int bj = 0; bj < 2; ++bj) { const u32x4 w = pack8(v[bj][0], v[bj][1]); *(u32x4*)(xb + off + bj * HALF) = w;
                        sq = dot2bf(w.x, sq); sq = dot2bf(w.y, sq); sq = dot2bf(w.z, sq); sq = dot2bf(w.w, sq); }
                    ss = sq;
                    ss += __shfl_xor(ss, 16); ss += __shfl_xor(ss, 32);
                    if (fq == 0) ssq[(size_t)row * 16 + 4 * u.pn + wc] = ss; }
            }
            asm volatile("" ::: "memory");
        }
    }
};
using EpiRes = EpiResT<false>;

#ifndef PG8_ZOPAQUE
#define PG8_ZOPAQUE 1
#endif
#ifndef PG8_F8SCALE
#define PG8_F8SCALE 0
#endif
__device__ __forceinline__ i32x8 cat8(const bf16x8 a, const bf16x8 b) { const i32x4 x = __builtin_bit_cast(i32x4, a), y = __builtin_bit_cast(i32x4, b); return __builtin_shufflevector(x, y, 0, 1, 2, 3, 4, 5, 6, 7); }
template <class Epi, class Sched, bool ALIGN_EPI = false, bool SP2 = false>
__device__ __forceinline__ void gemm_phase(PG8_LAS unsigned char* lds, const Gemm g, const Sched& S, const Epi& E, const int tid_in, const int epi_reps = 1) {
    int tid_ = tid_in; asm volatile("" : "+v"(tid_));
    const int tid = tid_, wid = __builtin_amdgcn_readfirstlane(tid >> 6), lane = tid & 63, wr = wid >> 2, wc = wid & 3, fr = lane & 15, fq = lane >> 4;
    const int K = g.K, nt = K / BK;
    unsigned voffA[2], voffB[2];
#pragma unroll
    for (int i = 0; i < 2; ++i) { int R, C; stage_rc(tid * 16 + i * 8192, R, C); const int Rb = Epi::PERM ? ((R & ~31) + perm32(R & 31)) : R;
        voffA[i] = (unsigned)(R * K + C) * 2u; voffB[i] = (unsigned)(Rb * K + C) * 2u; }
    const size_t kstep = (size_t)(BK * 2);
    const size_t hstep = (size_t)HALF * K * 2;
    const size_t tstep = 2 * hstep;
    const unsigned ldsw = (unsigned)wid * 1024u;
    const unsigned ldsb = (unsigned)__builtin_amdgcn_readfirstlane((int)((unsigned)(uintptr_t)lds + ldsw));
    const int aoff = lds_byte(wr * 64 + fr, fq * 8), boff = lds_byte(wc * 32 + fr, fq * 8);
#define PG8_SA(b, h) (((b) * 2 + (h)) * HTB)
#define PG8_SB(b, h) ((4 + (b) * 2 + (h)) * HTB)
#define PG8_STAGE(bufoff, gbase, voff) do { _Pragma("unroll") for (int _i = 0; _i < 2; ++_i) { unsigned keep_; \
        asm volatile("s_nop 4\n\ts_mov_b32 %0, m0\n\ts_mov_b32 m0, %2\n\ts_nop 0\n\tglobal_load_lds_dwordx4 %1, %3\n\ts_mov_b32 m0, %0" : "=&s"(keep_) \
            : "v"((voff)[_i]), "s"(ldsb + (unsigned)((bufoff) + _i * 8192)), "s"((const char*)(gbase)) : "memory"); } } while (0)
#define PG8_LDA(dst, b, h) do { _Pragma("unroll") for (int m = 0; m < 4; ++m) _Pragma("unroll") for (int k = 0; k < 2; ++k) dst[m][k] = *(const PG8_LAS bf16x8*)(lds + PG8_SA(b, h) + aoff + m * 2048 + k * 1024); } while (0)
#define PG8_LDB(dst, b, h) do { _Pragma("unroll") for (int n = 0; n < 2; ++n) _Pragma("unroll") for (int k = 0; k < 2; ++k) dst[n][k] = *(const PG8_LAS bf16x8*)(lds + PG8_SB(b, h) + boff + n * 2048 + k * 1024); } while (0)
#define PG8_MMA(ai, bj, At, Bt) do { __builtin_amdgcn_s_setprio(1); _Pragma("unroll") for (int m = 0; m < 4; ++m) _Pragma("unroll") for (int n = 0; n < 2; ++n) { \
        if constexpr (Epi::F8) acc[ai][bj][m][n] = __builtin_amdgcn_mfma_scale_f32_16x16x128_f8f6f4(cat8(Bt[n][0], Bt[n][1]), cat8(At[m][0], At[m][1]), acc[ai][bj][m][n], 0, 0, 0, PG8_F8SCALE, 0, PG8_F8SCALE); \
        else { _Pragma("unroll") for (int k = 0; k < 2; ++k) acc[ai][bj][m][n] = __builtin_amdgcn_mfma_f32_16x16x32_bf16(Bt[n][k], At[m][k], acc[ai][bj][m][n], 0, 0, 0); } } __builtin_amdgcn_s_setprio(0); } while (0)
#define PG8_WAIT_V(n) asm volatile("s_waitcnt vmcnt(" #n ")" ::: "memory")
#define PG8_WAIT_L(n) asm volatile("s_waitcnt lgkmcnt(" #n ")" ::: "memory")
#define PG8_WAIT_VF() asm volatile("s_waitcnt vmcnt(%0)" :: "n"(8 + Epi::NVM) : "memory")
#define PG8_TRIP_SP2(W12) do { \
            PG8_LDB(B0, 0, 0); PG8_LDB(B1, 0, 1); PG8_SCHED; PG8_LDA(At, 0, 0); PG8_STAGE(PG8_SA(1, 1), a1 + hstep, voffA); \
            W12; PG8_WAIT_L(0); PG8_BAR; PG8_MMA(0, 0, At, B0); PG8_MMA(0, 1, At, B1); PG8_BAR; PG8_SCHED; \
            PG8_LDA(At, 0, 1); PG8_STAGE(PG8_SB(0, 0), b2, voffB); PG8_STAGE(PG8_SB(0, 1), b2 + hstep, voffB); PG8_STAGE(PG8_SA(0, 0), a2, voffA); \
            W12; PG8_WAIT_L(0); PG8_BAR; PG8_MMA(1, 0, At, B0); PG8_MMA(1, 1, At, B1); PG8_BAR; PG8_SCHED; \
            PG8_LDB(B0, 1, 0); PG8_LDB(B1, 1, 1); PG8_SCHED; PG8_LDA(At, 1, 0); PG8_STAGE(PG8_SA(0, 1), a2 + hstep, voffA); \
            PG8_WAIT_V(8); PG8_WAIT_L(0); PG8_BAR; PG8_MMA(0, 0, At, B0); PG8_MMA(0, 1, At, B1); PG8_BAR; PG8_SCHED; \
            PG8_LDA(At, 1, 1); PG8_STAGE(PG8_SB(1, 0), b3, voffB); PG8_STAGE(PG8_SB(1, 1), b3 + hstep, voffB); PG8_STAGE(PG8_SA(1, 0), a3, voffA); \
            PG8_WAIT_V(8); PG8_WAIT_L(0); PG8_BAR; PG8_MMA(1, 0, At, B0); PG8_MMA(1, 1, At, B1); PG8_BAR; PG8_SCHED; } while (0)
#define PG8_BAR __builtin_amdgcn_s_barrier()
#define PG8_SCHED __builtin_amdgcn_sched_barrier(0)
    Unit cur, nxt; int ui = 0;
    if (!S.next(0, cur)) return;
    f32x4 acc[2][2][4][2];
#pragma unroll
    for (int a = 0; a < 2; ++a)
#pragma unroll
        for (int b = 0; b < 2; ++b)
#pragma unroll
            for (int m = 0; m < 4; ++m)
#pragma unroll
                for (int n = 0; n < 2; ++n) acc[a][b][m][n] = (f32x4){0.f, 0.f, 0.f, 0.f};
    bf16x8 At[4][2], B0[2][2], B1[2][2];
    const char* cA = (const char*)g.A + (size_t)cur.pm * tstep; const char* cB = (const char*)g.Bt + (size_t)cur.pn * tstep;
    S.a_ready(cur);
    if constexpr (SP2) {
        PG8_STAGE(PG8_SB(0, 0), cB, voffB); PG8_STAGE(PG8_SB(0, 1), cB + hstep, voffB); PG8_STAGE(PG8_SA(0, 0), cA, voffA); PG8_STAGE(PG8_SA(0, 1), cA + hstep, voffA);
        if (wr == 1) PG8_BAR;
        PG8_WAIT_V(2); PG8_BAR;
        PG8_STAGE(PG8_SB(1, 0), cB + kstep, voffB); PG8_STAGE(PG8_SA(1, 0), cA + kstep, voffA); PG8_STAGE(PG8_SB(1, 1), cB + hstep + kstep, voffB);
        PG8_WAIT_V(6); PG8_BAR;
    } else {
        PG8_STAGE(PG8_SB(0, 0), cB, voffB); PG8_STAGE(PG8_SA(0, 0), cA, voffA); PG8_STAGE(PG8_SB(0, 1), cB + hstep, voffB); PG8_STAGE(PG8_SA(0, 1), cA + hstep, voffA);
        if (wr == 1) PG8_BAR;
        PG8_WAIT_V(4); PG8_BAR;
        PG8_STAGE(PG8_SB(1, 0), cB + kstep, voffB); PG8_STAGE(PG8_SA(1, 0), cA + kstep, voffA); PG8_STAGE(PG8_SB(1, 1), cB + hstep + kstep, voffB);
        PG8_WAIT_V(6); PG8_BAR;
    }
    for (;;) {
        const bool has_next = S.next(ui + 1, nxt);
        const char* nA = has_next ? (const char*)g.A + (size_t)nxt.pm * tstep : cA; const char* nB = has_next ? (const char*)g.Bt + (size_t)nxt.pn * tstep : cB;
        int t = 0;
        if constexpr (SP2) { if (ui > 0) {
            const char* a1 = cA + kstep; const char* a2 = cA + 2 * kstep; const char* b2 = cB + 2 * kstep; const char* a3 = a2 + kstep; const char* b3 = b2 + kstep;
            PG8_TRIP_SP2(PG8_WAIT_VF()); t = 2; } }
        for (; t < nt; t += 2) {
            const bool last = (t == nt - 2);
            const char* a1 = cA + (size_t)(t + 1) * kstep;
            const char* a2 = last ? nA : cA + (size_t)(t + 2) * kstep; const char* b2 = last ? nB : cB + (size_t)(t + 2) * kstep;
            const char* a3 = a2 + kstep; const char* b3 = b2 + kstep;
            if (last && has_next) S.a_ready(nxt);
            if constexpr (SP2) {
            PG8_LDB(B0, 0, 0); PG8_LDB(B1, 0, 1); PG8_SCHED; PG8_LDA(At, 0, 0); PG8_STAGE(PG8_SA(1, 1), a1 + hstep, voffA);
            PG8_WAIT_V(8); PG8_WAIT_L(0); PG8_BAR; PG8_MMA(0, 0, At, B0); PG8_MMA(0, 1, At, B1); PG8_BAR; PG8_SCHED;
            PG8_LDA(At, 0, 1); PG8_STAGE(PG8_SB(0, 0), b2, voffB); PG8_STAGE(PG8_SB(0, 1), b2 + hstep, voffB); PG8_STAGE(PG8_SA(0, 0), a2, voffA);
            PG8_WAIT_V(8); PG8_WAIT_L(0); PG8_BAR; PG8_MMA(1, 0, At, B0); PG8_MMA(1, 1, At, B1); PG8_BAR; PG8_SCHED;
            PG8_LDB(B0, 1, 0); PG8_LDB(B1, 1, 1); PG8_SCHED; PG8_LDA(At, 1, 0); PG8_STAGE(PG8_SA(0, 1), a2 + hstep, voffA);
            PG8_WAIT_V(8); PG8_WAIT_L(0); PG8_BAR; PG8_MMA(0, 0, At, B0); PG8_MMA(0, 1, At, B1); PG8_BAR; PG8_SCHED;
            PG8_LDA(At, 1, 1); PG8_STAGE(PG8_SB(1, 0), b3, voffB); PG8_STAGE(PG8_SB(1, 1), b3 + hstep, voffB); PG8_STAGE(PG8_SA(1, 0), a3, voffA);
            PG8_WAIT_V(8); PG8_WAIT_L(0); PG8_BAR; PG8_MMA(1, 0, At, B0); PG8_MMA(1, 1, At, B1); PG8_BAR; PG8_SCHED;
            } else {
            PG8_LDB(B0, 0, 0); PG8_SCHED; PG8_LDA(At, 0, 0); PG8_STAGE(PG8_SA(1, 1), a1 + hstep, voffA);
            PG8_WAIT_L(8); PG8_BAR; PG8_WAIT_L(0); PG8_MMA(0, 0, At, B0); PG8_BAR; PG8_SCHED;
            PG8_LDB(B1, 0, 1); PG8_STAGE(PG8_SB(0, 0), b2, voffB);
            PG8_BAR; PG8_WAIT_L(0); PG8_MMA(0, 1, At, B1); PG8_BAR;
            PG8_LDA(At, 0, 1); PG8_STAGE(PG8_SA(0, 0), a2, voffA);
            PG8_BAR; PG8_WAIT_L(0); PG8_MMA(1, 0, At, B0); PG8_BAR; PG8_SCHED;
            PG8_STAGE(PG8_SB(0, 1), b2 + hstep, voffB);
            PG8_WAIT_V(6); PG8_BAR; PG8_MMA(1, 1, At, B1); PG8_BAR;
            PG8_LDB(B0, 1, 0); PG8_SCHED; PG8_LDA(At, 1, 0); PG8_STAGE(PG8_SA(0, 1), a2 + hstep, voffA);
            PG8_WAIT_L(8); PG8_BAR; PG8_WAIT_L(0); PG8_MMA(0, 0, At, B0); PG8_BAR; PG8_SCHED;
            PG8_LDB(B1, 1, 1); PG8_STAGE(PG8_SB(1, 0), b3, voffB);
            PG8_BAR; PG8_WAIT_L(0); PG8_MMA(0, 1, At, B1); PG8_BAR;
            PG8_LDA(At, 1, 1); PG8_STAGE(PG8_SA(1, 0), a3, voffA);
            PG8_BAR; PG8_WAIT_L(0); PG8_MMA(1, 0, At, B0); PG8_BAR; PG8_SCHED;
            PG8_STAGE(PG8_SB(1, 1), b3 + hstep, voffB);
            PG8_WAIT_V(6); PG8_BAR; PG8_MMA(1, 1, At, B1); PG8_BAR;
            }
        }
        if constexpr (ALIGN_EPI) { if (wr == 0) PG8_BAR; }
        if constexpr (!Epi::AFTER_DRAIN) { int ln_; asm volatile("v_mbcnt_lo_u32_b32 %0, -1, 0\n\tv_mbcnt_hi_u32_b32 %0, -1, %0" : "=v"(ln_)); const int fr_ = ln_ & 15, fq_ = ln_ >> 4;
            for (int er_ = 0; er_ < epi_reps; ++er_) E(acc, cur, wr, wc, fr_, fq_); S.done(cur); }
        if (!has_next) break;
        { float z_ = 0.f; if (PG8_ZOPAQUE) asm volatile("" : "+v"(z_));
#pragma unroll
        for (int a = 0; a < 2; ++a)
#pragma unroll
            for (int b = 0; b < 2; ++b)
#pragma unroll
                for (int m = 0; m < 4; ++m)
#pragma unroll
                    for (int n = 0; n < 2; ++n) acc[a][b][m][n] = (f32x4){z_, z_, z_, z_}; }
        cur = nxt; cA = nA; cB = nB; ++ui;
        if constexpr (ALIGN_EPI) { if (wr == 1) PG8_BAR; }
    }
    PG8_WAIT_V(0);
    if constexpr (!ALIGN_EPI) { if (wr == 0) PG8_BAR; }
    PG8_BAR;
    if constexpr (Epi::AFTER_DRAIN) { E.fused(acc, cur, wr, wc, fr, fq, lds, wid, lane); S.done(cur); }
#undef PG8_SA
#undef PG8_SB
#undef PG8_STAGE
#undef PG8_LDA
#undef PG8_LDB
#undef PG8_MMA
#undef PG8_WAIT_V
#undef PG8_WAIT_L
#undef PG8_WAIT_VF
#undef PG8_TRIP_SP2
#undef PG8_BAR
#undef PG8_SCHED
}
}

#ifndef PG8_SP2
#define PG8_SP2 true
#endif
#ifndef PG8_ALIGN
#define PG8_ALIGN true
#endif
#include <hip/hip_bf16.h>
#include <cmath>
namespace attn_body {
using bf16=__hip_bfloat16;
using bf16x8=__attribute__((ext_vector_type(8)))short;
using s16x4=__attribute__((ext_vector_type(4)))short;
using f32x16=__attribute__((ext_vector_type(16)))float;
using u32x4=__attribute__((ext_vector_type(4)))unsigned;
constexpr int BATCH=4,NHEAD=8,SEQ=8192,D=64,PQ=2560,PO=1024;
constexpr int NW=8,QBLK=32,QB=QBLK*NW,KVBLK=64,NQB=SEQ/QB;
constexpr int ATTN_UNIT_ROWS=QB;
__device__ __forceinline__ int crow(int r,int hi){return (r&3)+8*(r>>2)+4*hi;}
#define SBAR() __builtin_amdgcn_sched_barrier(0)
__device__ __forceinline__ void cmask(f32x16&p0,f32x16&p1,int jb,int qrel,int hi){
  const float NEG=-INFINITY; int kb=64*jb+4*hi;
  #pragma unroll
  for(int r=0;r<16;++r){int kv=kb+(r&3)+8*(r>>2); if(kv>qrel)p0[r]=NEG; if(kv+32>qrel)p1[r]=NEG;}
}

constexpr int NSLOT=3, SLOTB=8192;
constexpr int LDS_K=0, LDS_V=NSLOT*SLOTB, LDS_WS=2*NSLOT*SLOTB, LDS_OST=LDS_WS+NW*64*4, LDS_CT=LDS_OST+NW*4096+2048, LDS_BYTES=LDS_CT+SEQ*4;
constexpr float C2=0.125f*1.4426950408889634f;
__device__ __forceinline__ void glds16(const void*sbase,unsigned voff,unsigned lds_dst){unsigned keep;
  asm volatile("s_nop 4\n\ts_mov_b32 %0, m0\n\ts_mov_b32 m0, %2\n\ts_nop 0\n\tglobal_load_lds_dwordx4 %1, %3\n\ts_mov_b32 m0, %0":"=&s"(keep):"v"(voff),"s"(lds_dst),"s"(sbase):"memory");}
__device__ __forceinline__ float max3f(float a,float b,float c){float r;asm("v_max3_f32 %0, %1, %2, %3":"=v"(r):"v"(a),"v"(b),"v"(c));return r;}
__device__ __forceinline__ float max2f(float a,float b){float r;asm("v_max_f32_e32 %0, %1, %2":"=v"(r):"v"(a),"v"(b));return r;}
__device__ __forceinline__ float fadd_s(float a,float b){float r;asm("v_add_f32_e32 %0, %1, %2":"=v"(r):"v"(a),"v"(b));return r;}
__device__ __forceinline__ float fsub_s(float a,float b){float r;asm("v_sub_f32_e32 %0, %1, %2":"=v"(r):"v"(a),"v"(b));return r;}
typedef float f32x2_t __attribute__((ext_vector_type(2))); typedef float f32x4_t __attribute__((ext_vector_type(4))); typedef __bf16 bf16x2_t __attribute__((ext_vector_type(2)));
__device__ __forceinline__ unsigned cvtpk_s(float lo,float hi){f32x2_t v={lo,hi};bf16x2_t b=__builtin_convertvector(v,bf16x2_t);return __builtin_bit_cast(unsigned,b);}
#define WAIT_BAR(N) asm volatile("s_waitcnt vmcnt(" #N ") lgkmcnt(0)\n\ts_barrier":::"memory")

__device__ __forceinline__ void qkt(f32x16&p0,f32x16&p1,const char*Kslot,const bf16x8*qr,const f32x16&negm,int r32,int hi){
  const char*kb=Kslot+hi*1024+r32*16;
  #pragma unroll
  for(int d0=0;d0<4;++d0){
    const bf16x8 b0=*reinterpret_cast<const bf16x8*>(kb+d0*2048);
    const bf16x8 b1=*reinterpret_cast<const bf16x8*>(kb+d0*2048+512);
    if(d0==0){p0=__builtin_amdgcn_mfma_f32_32x32x16_bf16(b0,qr[0],negm,0,0,0);p1=__builtin_amdgcn_mfma_f32_32x32x16_bf16(b1,qr[0],negm,0,0,0);}
    else{p0=__builtin_amdgcn_mfma_f32_32x32x16_bf16(b0,qr[d0],p0,0,0,0);p1=__builtin_amdgcn_mfma_f32_32x32x16_bf16(b1,qr[d0],p1,0,0,0);}}
}
typedef __attribute__((address_space(3))) const char* lds_cptr;
typedef short v4i16_t __attribute__((ext_vector_type(4)));
__device__ __forceinline__ void kload8(bf16x8*kf,lds_cptr kp){
  kf[0]=*(const __attribute__((address_space(3))) bf16x8*)(kp);      kf[1]=*(const __attribute__((address_space(3))) bf16x8*)(kp+512);
  kf[2]=*(const __attribute__((address_space(3))) bf16x8*)(kp+2048); kf[3]=*(const __attribute__((address_space(3))) bf16x8*)(kp+2560);
  kf[4]=*(const __attribute__((address_space(3))) bf16x8*)(kp+4096); kf[5]=*(const __attribute__((address_space(3))) bf16x8*)(kp+4608);
  kf[6]=*(const __attribute__((address_space(3))) bf16x8*)(kp+6144); kf[7]=*(const __attribute__((address_space(3))) bf16x8*)(kp+6656);
}
__device__ __forceinline__ void kload2(bf16x8*kf,lds_cptr kp,int j){ kf[2*j]=*(const __attribute__((address_space(3))) bf16x8*)(kp+j*2048); kf[2*j+1]=*(const __attribute__((address_space(3))) bf16x8*)(kp+j*2048+512); }
__device__ __forceinline__ s16x4 vtr(lds_cptr p){ return __builtin_bit_cast(s16x4,__builtin_amdgcn_ds_read_tr16_b64_v4i16((__attribute__((address_space(3))) v4i16_t*)p)); }
__device__ __forceinline__ float rowmax(const f32x16&p0,const f32x16&p1){
  float a=max3f(p0[0],p0[1],p1[0]),b=max3f(p0[2],p0[3],p1[1]);a=max3f(a,p1[2],p1[3]);
  #pragma unroll
  for(int r=4;r<16;r+=4){a=max3f(a,p0[r],p0[r+1]);b=max3f(b,p0[r+2],p0[r+3]);a=max3f(a,p1[r],p1[r+1]);b=max3f(b,p1[r+2],p1[r+3]);}
  const float m=max2f(a,b);
  auto rr=__builtin_amdgcn_permlane32_swap(__float_as_uint(m),__float_as_uint(m),false,false);
  return max2f(__uint_as_float(rr[0]),__uint_as_float(rr[1]));
}
__device__ __forceinline__ void pv(f32x16*o,int vb,bf16x8 pa0,bf16x8 pa1,bf16x8 pa2,bf16x8 pa3){
  #pragma unroll
  for(int d0=0;d0<2;++d0){s16x4 lo[4],hi[4];
    #pragma unroll
    for(int ks=0;ks<4;++ks){
      asm volatile("ds_read_b64_tr_b16 %0,%1 offset:%c2":"=&v"(lo[ks]):"v"(vb),"i"(d0*4096+ks*1024):"memory");
      asm volatile("ds_read_b64_tr_b16 %0,%1 offset:%c2":"=&v"(hi[ks]):"v"(vb),"i"(d0*4096+ks*1024+512):"memory");}
    asm volatile("s_waitcnt lgkmcnt(0)":::"memory");SBAR();
    #define PK(k) (bf16x8){lo[k][0],lo[k][1],lo[k][2],lo[k][3],hi[k][0],hi[k][1],hi[k][2],hi[k][3]}
    o[d0]=__builtin_amdgcn_mfma_f32_32x32x16_bf16(pa0,PK(0),o[d0],0,0,0);
    o[d0]=__builtin_amdgcn_mfma_f32_32x32x16_bf16(pa1,PK(1),o[d0],0,0,0);
    o[d0]=__builtin_amdgcn_mfma_f32_32x32x16_bf16(pa2,PK(2),o[d0],0,0,0);
    o[d0]=__builtin_amdgcn_mfma_f32_32x32x16_bf16(pa3,PK(3),o[d0],0,0,0);
    #undef PK
  }
}

#ifndef ATTN_STORE16
#define ATTN_STORE16(p,v) (*(u32x4*)(p)=(v))
#endif
template<int THRL> __device__ __forceinline__ void attn_unit(int b,int h,int qb,const bf16*Q,const bf16*__restrict__ K,const bf16*__restrict__ V,bf16*O,const float*__restrict__ CT,const float TH,char*shm,const int tid_in){
  int tid_=tid_in; asm volatile("":"+v"(tid_)); const int tid=tid_,lane=tid&63,r32=lane&31,hi=lane>>5; const int wid=__builtin_amdgcn_readfirstlane(tid>>6);
  const long rowbase=(long)b*SEQ; const int q0=qb*QB;
  const bf16*Qw=Q+(rowbase+q0+wid*QBLK)*PQ+h*D;
  const float*ctg=CT+(long)(b*NHEAD+h)*SEQ;
  int t0;
  { const int NTf=(q0+QB)/KVBLK; const float cq0=ctg[q0];
    const bool k0=(lane>=NTf-4)||!(cq0-ctg[64*lane+63]<-TH);
    const int l1=lane+64; const bool k1=(l1>=NTf-4)||!(cq0-ctg[64*(l1<NTf?l1:NTf-1)+63]<-TH);
    const unsigned long long m0=__ballot(k0),m1=__ballot(k1);
    const int first=m0?__builtin_ctzll(m0):64+(m1?__builtin_ctzll(m1):63);
    t0=__builtin_amdgcn_readfirstlane(first)&~1; if(t0>NTf-4)t0=NTf-4; }
  const int tbase=t0*KVBLK;
  const bf16*Kh=K+(rowbase+tbase)*PQ+h*D,*Vh=V+(rowbase+tbase)*PQ+h*D;
  const unsigned lds0=(unsigned)(uintptr_t)shm;
  float*wsf=(float*)(shm+LDS_WS)+wid*64;
  const unsigned koff=(unsigned)(lane*PQ+wid*8)*2u;
  const unsigned voff=(unsigned)((16*(wid&3)+(lane>>2))*PQ+(wid>>2)*32+(lane&3)*8)*2u;
  const unsigned kdst=lds0+LDS_K+wid*1024, vdst=lds0+LDS_V+wid*1024;
  #define DMA_K(t,slot) glds16(Kh+(long)(t)*KVBLK*PQ,koff,(unsigned)__builtin_amdgcn_readfirstlane(kdst+(slot)))
  #define DMA_V(t,slot) glds16(Vh+(long)(t)*KVBLK*PQ,voff,(unsigned)__builtin_amdgcn_readfirstlane(vdst+(slot)))
  const int vb0=(int)(lds0+LDS_V)+((lane>>4)&1)*32+(lane&3)*8+(4*hi+((lane&15)>>2))*64;
  const char*Kbase=shm+LDS_K; bf16x8 kf[8];
  const lds_cptr shm3=(lds_cptr)shm; const lds_cptr kp0=shm3+LDS_K+hi*1024+r32*16; const lds_cptr vp0=shm3+LDS_V+((lane>>4)&1)*32+(lane&3)*8+(4*hi+((lane&15)>>2))*64;
  const int NT=(q0+QB)/KVBLK-t0;
  { typedef __attribute__((address_space(3))) u32x4 lv4; const u32x4*src=(const u32x4*)(ctg+tbase); lv4*dst=(lv4*)(shm3+LDS_CT); const int n4=(q0+QB-tbase)/4;
    for(int i=tid;i<n4;i+=NW*64)dst[i]=src[i]; }
  const float ctl=ctg[q0+wid*QBLK+r32];
  const __attribute__((address_space(3))) float*ctab=(const __attribute__((address_space(3))) float*)(shm3+LDS_CT)+4*hi;
  DMA_K(0,0);DMA_V(0,0);DMA_K(1,SLOTB);
  bf16x8 qr[4];
  #pragma unroll
  for(int d0=0;d0<4;++d0)qr[d0]=*reinterpret_cast<const bf16x8*>(&Qw[(long)r32*PQ+d0*16+hi*8]);
  float mhat=-ctl,l_reg=0.f;     f32x16 o[2];o[0]=f32x16{};o[1]=f32x16{};f32x16 negm;
  _Pragma("unroll") for(int r=0;r<16;++r)negm[r]=ctl; asm volatile("":"+v"(negm));
  #define CBIAS(C0,C1,t) do{ const __attribute__((address_space(3))) float*tb_=ctab+64*(t); \
    _Pragma("unroll") for(int g_=0;g_<4;++g_){ const f32x4_t a_=*(const __attribute__((address_space(3))) f32x4_t*)(tb_+8*g_), b_=*(const __attribute__((address_space(3))) f32x4_t*)(tb_+32+8*g_); \
      _Pragma("unroll") for(int e_=0;e_<4;++e_){ C0[4*g_+e_]-=a_[e_]; C1[4*g_+e_]-=b_[e_]; } } }while(0)
  const int qrel=wid*QBLK+r32;
  #define CMASK(P0,P1,t) do{int jb_=(t)-(NT-4); if(jb_>=0)cmask(P0,P1,jb_,qrel,hi);}while(0)
  bool resc=false;
  #define START(P0,P1) do{ const float rm=rowmax(P0,P1); resc=false; \
    { const float dl=rm; mhat=fadd_s(mhat,dl); \
      _Pragma("unroll") for(int r=0;r<16;++r){P0[r]=fsub_s(P0[r],dl);P1[r]=fsub_s(P1[r],dl);} \
      _Pragma("unroll") for(int r=0;r<16;++r)negm[r]=-mhat; asm volatile("":"+v"(negm)); } \
    _Pragma("unroll") for(int r=0;r<16;++r)P0[r]=__builtin_amdgcn_exp2f(P0[r]); }while(0)
  #define RESC() do{ if(resc){ asm volatile("s_waitcnt lgkmcnt(0)":::"memory"); \
      _Pragma("unroll") for(int d_=0;d_<2;++d_) _Pragma("unroll") for(int r=0;r<16;++r)o[d_][r]*=wsf[crow(r,hi)]; } }while(0)
  f32x16 pA0,pA1,pB0,pB1;
  int sl_prev=0,sl_cur=0,sl_next=SLOTB;
  #define ROT() do{sl_prev=sl_cur;sl_cur=sl_next;sl_next=(sl_next==(NSLOT-1)*SLOTB)?0:sl_next+SLOTB;}while(0)
  DMA_K(2,2*SLOTB);
  WAIT_BAR(3);
  qkt(pA0,pA1,Kbase,qr,negm,r32,hi);asm volatile("s_nop 15\n\ts_nop 7":"+v"(pA0),"+v"(pA1));CBIAS(pA0,pA1,0);asm volatile("s_nop 1":"+v"(pA0),"+v"(pA1));CMASK(pA0,pA1,0);
  START(pA0,pA1);
  _Pragma("unroll") for(int r=0;r<16;++r)pA1[r]=__builtin_amdgcn_exp2f(pA1[r]);
  WAIT_BAR(0);
  DMA_K(3,0);DMA_V(1,SLOTB);
  ROT();
  kload8(kf,kp0+sl_cur);
  WAIT_BAR(2);
  s16x4 vlo[8],vhi[8]; u32x4 pw0,pw1,pw2,pw3;
  #define PKW(P,B) cvtpk_s(P[B],P[B+1])
  #define PAF(k) __builtin_bit_cast(bf16x8,pw##k)
  #define VFR(i) (bf16x8){vlo[i][0],vlo[i][1],vlo[i][2],vlo[i][3],vhi[i][0],vhi[i][1],vhi[i][2],vhi[i][3]}
  #define PIN(x) asm volatile("":"+v"(x))
  #define MX3(a,b,c) __builtin_fmaxf(__builtin_fmaxf((a),(b)),(c))
  #define GAPA(MF,A0,A1,A2,A3,W0,W1,PW) do{ MF; sacc+=A0; sacc+=A1; sacc+=A2; sacc+=A3; PIN(sacc); W0; W1; PIN(PW); SBAR(); }while(0)
  #define EX(v) __builtin_amdgcn_exp2f(v)
  #define GAPB(MF,X,B) do{ MF; X[B]=EX(X[B]); X[B+1]=EX(X[B+1]); X[B+2]=EX(X[B+2]); X[B+3]=EX(X[B+3]); PIN(X); SBAR(); }while(0)
  #define VRD(i) do{ vlo[i]=vtr(vp_+(((i)>>2)*4096+((i)&3)*1024)); vhi[i]=vtr(vp_+(((i)>>2)*4096+((i)&3)*1024+512)); }while(0)
  #define KRD(G,j) do{ if(G){ kload2(kf,kp0+sl_next,j); SBAR(); } }while(0)
  #define STEP(C0,C1,P0,P1,t,GK,GV,GL) do{ SBAR(); \
    const lds_cptr vp_=vp0+sl_prev; \
    VRD(0); SBAR(); float sacc=(P0[0]+P0[1]); \
    GAPA(C0=__builtin_amdgcn_mfma_f32_32x32x16_bf16(kf[0],qr[0],negm,0,0,0), P0[2],P0[3],P0[4],P0[5],     pw0[0]=PKW(P0,0), pw0[1]=PKW(P0,2), pw0); \
    VRD(4); SBAR(); GAPA(C1=__builtin_amdgcn_mfma_f32_32x32x16_bf16(kf[1],qr[0],negm,0,0,0), P0[6],P0[7],P0[8],P0[9],     pw0[2]=PKW(P0,4), pw0[3]=PKW(P0,6), pw0); \
    VRD(1); SBAR(); GAPA(C0=__builtin_amdgcn_mfma_f32_32x32x16_bf16(kf[2],qr[1],C0,0,0,0),   P0[10],P0[11],P0[12],P0[13], pw1[0]=PKW(P0,8), pw1[1]=PKW(P0,10), pw1); \
    VRD(5); SBAR(); GAPA(C1=__builtin_amdgcn_mfma_f32_32x32x16_bf16(kf[3],qr[1],C1,0,0,0),   P0[14],P0[15],P1[0],P1[1],   pw1[2]=PKW(P0,12),pw1[3]=PKW(P0,14), pw1); \
    VRD(2); SBAR(); GAPA(C0=__builtin_amdgcn_mfma_f32_32x32x16_bf16(kf[4],qr[2],C0,0,0,0),   P1[2],P1[3],P1[4],P1[5],     pw2[0]=PKW(P1,0), pw2[1]=PKW(P1,2), pw2); \
    VRD(6); SBAR(); GAPA(C1=__builtin_amdgcn_mfma_f32_32x32x16_bf16(kf[5],qr[2],C1,0,0,0),   P1[6],P1[7],P1[8],P1[9],     pw2[2]=PKW(P1,4), pw2[3]=PKW(P1,6), pw2); \
    VRD(3); SBAR(); GAPA(C0=__builtin_amdgcn_mfma_f32_32x32x16_bf16(kf[6],qr[3],C0,0,0,0),   P1[10],P1[11],P1[12],P1[13], pw3[0]=PKW(P1,8), pw3[1]=PKW(P1,10), pw3); \
    VRD(7); SBAR(); GAPA(C1=__builtin_amdgcn_mfma_f32_32x32x16_bf16(kf[7],qr[3],C1,0,0,0),   P1[14],P1[15],0.f,0.f,       pw3[2]=PKW(P1,12),pw3[3]=PKW(P1,14), pw3); \
    l_reg+=sacc; \
    if(GK){DMA_K((t)+3,sl_cur);} if(GV){DMA_V((t)+1,sl_next);} \
    CBIAS(C0,C1,t); CMASK(C0,C1,t); \
    { float a=MX3(C0[0],C0[1],C1[0]),b=MX3(C0[2],C0[3],C1[1]); a=MX3(a,C1[2],C1[3]); \
      _Pragma("unroll") for(int r=4;r<16;r+=4){a=MX3(a,C0[r],C0[r+1]);b=MX3(b,C0[r+2],C0[r+3]);a=MX3(a,C1[r],C1[r+1]);b=MX3(b,C1[r+2],C1[r+3]);} \
      float rm=__builtin_fmaxf(a,b); { auto rr=__builtin_amdgcn_permlane32_swap(__float_as_uint(rm),__float_as_uint(rm),false,false); rm=__builtin_fmaxf(__uint_as_float(rr[0]),__uint_as_float(rr[1])); } \
      resc=false; \
      if(__builtin_expect(__any(rm>(float)THRL),0)){ const float dl=__builtin_fmaxf(rm,0.f); mhat+=dl; \
        _Pragma("unroll") for(int r=0;r<16;++r){C0[r]-=dl;C1[r]-=dl;} \
        _Pragma("unroll") for(int r=0;r<16;++r)negm[r]=-mhat; asm volatile("":"+v"(negm)); \
        const float f=__builtin_amdgcn_exp2f(-dl); l_reg*=f; if(hi==0)wsf[r32]=f; resc=true; } } \
    SBAR(); \
    GAPB(o[0]=__builtin_amdgcn_mfma_f32_32x32x16_bf16(PAF(0),VFR(0),o[0],0,0,0), C0,0); \
    GAPB(o[1]=__builtin_amdgcn_mfma_f32_32x32x16_bf16(PAF(0),VFR(4),o[1],0,0,0), C0,4); \
    KRD(GL,0); GAPB(o[0]=__builtin_amdgcn_mfma_f32_32x32x16_bf16(PAF(1),VFR(1),o[0],0,0,0), C0,8); \
    KRD(GL,1); GAPB(o[1]=__builtin_amdgcn_mfma_f32_32x32x16_bf16(PAF(1),VFR(5),o[1],0,0,0), C0,12); \
    KRD(GL,2); GAPB(o[0]=__builtin_amdgcn_mfma_f32_32x32x16_bf16(PAF(2),VFR(2),o[0],0,0,0), C1,0); \
    KRD(GL,3); GAPB(o[1]=__builtin_amdgcn_mfma_f32_32x32x16_bf16(PAF(2),VFR(6),o[1],0,0,0), C1,4); \
    GAPB(o[0]=__builtin_amdgcn_mfma_f32_32x32x16_bf16(PAF(3),VFR(3),o[0],0,0,0), C1,8); \
    GAPB(o[1]=__builtin_amdgcn_mfma_f32_32x32x16_bf16(PAF(3),VFR(7),o[1],0,0,0), C1,12); \
    }while(0)
  int t=1;
  #undef CMASK
  #define CMASK(P0,P1,t) do{}while(0)
  for(;t+5<NT;t+=2){
    STEP(pB0,pB1,pA0,pA1,t,true,true,true);     WAIT_BAR(2); RESC(); ROT();
    STEP(pA0,pA1,pB0,pB1,t+1,true,true,true);   WAIT_BAR(2); RESC(); ROT();
  }
  #undef CMASK
  #define CMASK(P0,P1,t) do{int jb_=(t)-(NT-4); if(jb_>=0)cmask(P0,P1,jb_,qrel,hi);}while(0)
  #define ENDW(tt) do{ if((tt)+3<NT){WAIT_BAR(2);} else if((tt)+2<NT){WAIT_BAR(1);} else {WAIT_BAR(0);} }while(0)
  for(;t+1<NT;t+=2){
    STEP(pB0,pB1,pA0,pA1,t,(t+3<NT),(t+1<NT),(t+1<NT));       ENDW(t);   RESC(); ROT();
    STEP(pA0,pA1,pB0,pB1,t+1,(t+4<NT),(t+2<NT),(t+2<NT));     ENDW(t+1); RESC(); ROT();
  }
  STEP(pB0,pB1,pA0,pA1,NT-1,false,false,false); RESC();
  { float sacc=pB0[0]+pB0[1]; _Pragma("unroll") for(int r=2;r<16;++r)sacc+=pB0[r]; _Pragma("unroll") for(int r=0;r<16;++r)sacc+=pB1[r]; l_reg+=sacc;
    pw0=(u32x4){PKW(pB0,0),PKW(pB0,2),PKW(pB0,4),PKW(pB0,6)};pw1=(u32x4){PKW(pB0,8),PKW(pB0,10),PKW(pB0,12),PKW(pB0,14)};pw2=(u32x4){PKW(pB1,0),PKW(pB1,2),PKW(pB1,4),PKW(pB1,6)};pw3=(u32x4){PKW(pB1,8),PKW(pB1,10),PKW(pB1,12),PKW(pB1,14)};
    SBAR(); pv(o,vb0+sl_cur,PAF(0),PAF(1),PAF(2),PAF(3)); }
  #undef PKW
  #undef PAF
  #undef VFR
  #undef PIN
  #undef MX3
  #undef GAPA
  #undef GAPB
  #undef EX
  #undef VRD
  #undef KRD
  #undef STEP
  #undef ENDW
  {auto rr=__builtin_amdgcn_permlane32_swap(__float_as_uint(l_reg),__float_as_uint(l_reg),false,false);l_reg=__uint_as_float(rr[0])+__uint_as_float(rr[1]);}
  if(hi==0)wsf[32+r32]=l_reg;asm volatile("s_waitcnt lgkmcnt(0)":::"memory");
  float rli[16];
  #pragma unroll
  for(int r=0;r<16;++r)rli[r]=__builtin_amdgcn_rcpf(wsf[32+crow(r,hi)]);
  bf16*Ow=O+(rowbase+q0+wid*QBLK)*PO+h*D;
  { bf16*stg=(bf16*)(shm+LDS_OST)+wid*2048;
    #pragma unroll
    for(int r=0;r<16;++r){const int orow=crow(r,hi);
      #pragma unroll
      for(int d0=0;d0<2;++d0)stg[orow*64+d0*32+r32]=__float2bfloat16(o[d0][r]*rli[r]);}
    asm volatile("s_waitcnt lgkmcnt(0)":::"memory");
    #pragma unroll
    for(int i=0;i<4;++i){const int row=i*8+(lane>>3),ch=lane&7; const u32x4 v=*(const u32x4*)(stg+row*64+ch*8); ATTN_STORE16(Ow+(long)row*PO+ch*8,v);} }
  asm volatile("s_waitcnt lgkmcnt(0)\n\ts_barrier":::"memory");
  #undef DMA_K
  #undef DMA_V
  #undef CMASK
  #undef CBIAS
  #undef START
  #undef RESC
  #undef ROT
}
constexpr int ATTN_LDS_BYTES=LDS_BYTES;
struct AttnTensors { const bf16* Q; const bf16* K; const bf16* V; bf16* O; const float* CT; float TH; };
struct AttnUnit { int bh; int qb; };
struct StaticOrder {
  int vcu;
  __device__ __forceinline__ explicit StaticOrder(int grid,int block):vcu((block%8)*(grid/8)+block/8){}
  __device__ __forceinline__ bool next(int i,AttnUnit&u)const{ if(i>=4)return false; const int s=vcu&7; u.bh=vcu>>3; u.qb=(i==0)?s:(i==1)?15-s:(i==2)?16+s:31-s; return true; }
  __device__ __forceinline__ void a_ready(const AttnUnit&)const{}
  __device__ __forceinline__ void done(const AttnUnit&)const{}
};
template<class Sched,int THRL=8> __device__ __forceinline__ void attn_phase(char*lds,const AttnTensors&T,const Sched&S,const int tid_in){
  AttnUnit u;
  for(int i=0;S.next(i,u);++i){ S.a_ready(u); attn_unit<THRL>(u.bh/NHEAD,u.bh%NHEAD,u.qb,T.Q,T.K,T.V,T.O,T.CT,T.TH,lds,tid_in); S.done(u); }
}
#undef SBAR
#undef WAIT_BAR
}

constexpr int NWAVES = 8;
#ifndef MK_N_LAUNCHES
#define MK_N_LAUNCHES 1
#endif
enum Phase { PH_PRO = 0, PH_IN0, PH_MIX0, PH_OUT0, PH_XQ0, PH_XO0, PH_UP0, PH_DN0, PH_IN1, PH_MIX1, PH_OUT1, PH_XQ1, PH_XO1, PH_UP1, PH_DN1, N_PHASES };
constexpr int N_LAUNCHES = MK_N_LAUNCHES;
static_assert(N_LAUNCHES == 1 || N_LAUNCHES == N_PHASES, "MK_N_LAUNCHES is 1 or 15");

#ifndef MK_F8DN
#define MK_F8DN 2
#endif
#ifndef MK_F8XO
#define MK_F8XO 1
#endif
constexpr float F8_XOASCALE = 64.0f, F8_XOWSCALE = 512.0f;
constexpr float F8_HSCALE = 16.0f, F8_WSCALE = 1024.0f;
constexpr int BATCH = 4, SEQ = 8192, D = 1024, T = BATCH * SEQ;
constexpr int NMEM = 256, MROWS = BATCH * NMEM;
constexpr int EVEN_IN = 2568, N_IN0 = 2560, N_IN1 = 2048, DFF = 2816, XAW = 512;
constexpr int Z1P = 1536;
constexpr float EPS = 1e-6f, LOG2E = 1.4426950408889634f;
constexpr float FOX_C2 = 0.125f * LOG2E;
constexpr float XA_C2 = 0.08838834764831845f * LOG2E;

constexpr size_t MiB = 1u << 20;
constexpr size_t WS_CTL = 0, CTL_ZERO_BYTES = 64 * 1024;
constexpr size_t WS_WIN0 = 2 * MiB, WS_WOUT0 = 7 * MiB, WS_WIN1 = 9 * MiB, WS_WOUT1 = 13 * MiB;
constexpr size_t WS_LAYER = 15 * MiB, LAYER_STRIDE = 21 * MiB, L_WQ = 0, L_WKV = 1 * MiB, L_WO = 3 * MiB, L_WGU = 4 * MiB, L_WD = 15 * MiB;
constexpr size_t WS_WSP = 57 * MiB;
constexpr size_t WS_MEMN = 58 * MiB, WS_KVRAW = 60 * MiB, WS_KN = 64 * MiB, WS_VT = 66 * MiB;
constexpr size_t WS_LOGF = 68 * MiB, WS_CUM = 69 * MiB, WS_SSQ = 70 * MiB;
constexpr size_t WS_XB = 72 * MiB, WS_Y = 136 * MiB, WS_XQ = WS_Y, WS_XO = WS_Y + 32 * MiB, WS_BIG = 200 * MiB, WS_END = 376 * MiB;
constexpr int CW_TMO = 0, CW_CODE = 1;
constexpr int CW_BAR = 4096;
constexpr int CW_Q0 = 64;

constexpr int RING_OFF = 0, RING_BYTES = 131072;
constexpr int XA_KROW = 272, XA_VROW = 528, XA_KBYTES = 256 * XA_KROW, XA_VBYTES = 128 * XA_VROW;
constexpr int LDSCTL_OFF = 139264, MISC_OFF = LDSCTL_OFF + 320;
constexpr int LDS_BYTES = 147456;
static_assert(XA_KBYTES + XA_VBYTES <= LDSCTL_OFF && MISC_OFF + 128 <= LDS_BYTES, "LDS map");
#define GAS __attribute__((address_space(1)))
#define LAS __attribute__((address_space(3)))
typedef unsigned short bf16;
typedef unsigned v4u __attribute__((ext_vector_type(4)));
typedef float f32x4 __attribute__((ext_vector_type(4)));
typedef short bf16x8 __attribute__((ext_vector_type(8)));
typedef GAS unsigned gu32;
typedef GAS unsigned long long gu64;
#define RLX_AGENT __ATOMIC_RELAXED, __HIP_MEMORY_SCOPE_AGENT
#define LDS_WAIT() asm volatile("s_waitcnt lgkmcnt(0)" ::: "memory")
#define VM_WAIT() asm volatile("s_waitcnt vmcnt(0)" ::: "memory")
__device__ __forceinline__ unsigned long long rt() { return __builtin_amdgcn_s_memrealtime(); }
__device__ __forceinline__ unsigned f2bf(float f) { unsigned u = __builtin_bit_cast(unsigned, f); return (u + 0x7fffu + ((u >> 16) & 1u)) >> 16; }
__device__ __forceinline__ unsigned pk2(float lo, float hi) { return f2bf(lo) | (f2bf(hi) << 16); }
typedef float pk_f32x2 __attribute__((ext_vector_type(2))); typedef __bf16 pk_bf16x2 __attribute__((ext_vector_type(2)));
__device__ __forceinline__ unsigned pk2h(float lo, float hi) { const pk_f32x2 v = {lo, hi}; return __builtin_bit_cast(unsigned, __builtin_convertvector(v, pk_bf16x2)); }

#define XB_TMO      128
#define XB_XCNT(j)  (256  + 64 * (j))
#define XB_XSUB(j)  (1280 + 64 * (j))
#define XB_XGEN(j)  (2304 + 64 * (j))
#define XB_TOP      3328
#define XB_TOPGEN   3392
#define XCD_BAR_WORDS 3456
#define XB_SPIN_CAP (1u << 18)

__device__ __forceinline__ unsigned xb_ld(unsigned* p)              { return __hip_atomic_load(p, __ATOMIC_RELAXED, __HIP_MEMORY_SCOPE_AGENT); }
__device__ __forceinline__ unsigned xb_add(unsigned* p, unsigned v) { return __hip_atomic_fetch_add(p, v, __ATOMIC_RELAXED, __HIP_MEMORY_SCOPE_AGENT); }
__device__ __forceinline__ unsigned xb_xcc_id() { return (unsigned)__builtin_amdgcn_s_getreg((3 << 11) | 20) & 0xFu; }
#define XB_SPIN(cond, bar) do { unsigned _sp = 0; while (cond) { __builtin_amdgcn_s_sleep(1); \
    if ((++_sp & 255u) == 0u) { if (xb_ld(&(bar)[XB_TMO])) break; if (_sp > XB_SPIN_CAP) { atomicAdd(&(bar)[XB_TMO], 1u); break; } } } } while (0)

struct XcdBarrier {
    unsigned* bar; unsigned x;
    volatile LAS unsigned* st;
};

__device__ __forceinline__ XcdBarrier xcd_barrier_post(unsigned* bar, volatile LAS unsigned* st, const int tid_in) {
    XcdBarrier b; b.bar = bar; b.x = xb_xcc_id(); b.st = st;
    if (tid_in == 0) (void)xb_add(&bar[XB_XCNT(b.x)], 1u);
    return b;
}
__device__ __forceinline__ void xcd_barrier_complete(unsigned* bar, unsigned x, unsigned& nloc, unsigned& nx) {
    const unsigned G = gridDim.x * gridDim.y * gridDim.z;
    unsigned sum, cnt, mine, sp = 0u;
    for (;;) {
        sum = 0u; cnt = 0u; mine = 0u;
#pragma unroll
        for (unsigned j = 0; j < 16; ++j) { const unsigned c = xb_ld(&bar[XB_XCNT(j)]); sum += c; cnt += (c > 0u) ? 1u : 0u; mine = (j == x) ? c : mine; }
        if (sum == G) break;
        __builtin_amdgcn_s_sleep(1);
        if ((++sp & 255u) == 0u) { if (xb_ld(&bar[XB_TMO])) break; if (sp > XB_SPIN_CAP) { atomicAdd(&bar[XB_TMO], 1u); break; } }
    }
    nloc = mine > 0u ? mine : 1u; nx = cnt > 0u ? cnt : 1u;
}

__device__ __forceinline__ void xcd_barrier(const XcdBarrier& b, const int tid_in) {
    asm volatile("s_waitcnt vmcnt(0)" ::: "memory");
    __syncthreads();
    int t0_ = tid_in; asm volatile("" : "+v"(t0_));
    if (t0_ == 0) {
        unsigned* bar = b.bar; asm volatile("" : "+v"(bar));
        __builtin_amdgcn_s_waitcnt(0);
        unsigned nloc = b.st[0], nx = b.st[1];
        if (nloc == 0u) { xcd_barrier_complete(bar, b.x, nloc, nx); b.st[0] = nloc; b.st[1] = nx; }
        const unsigned old = xb_add(&bar[XB_XSUB(b.x)], 1u);
        const unsigned gen = old / nloc;
        if (old + 1u == (gen + 1u) * nloc) {
            __builtin_amdgcn_fence(__ATOMIC_RELEASE, "agent");
            asm volatile("s_waitcnt vmcnt(0)" ::: "memory");
            const unsigned og = xb_add(&bar[XB_TOP], 1u);
            const unsigned tg = og / nx;
            if (og + 1u == (tg + 1u) * nx) xb_add(&bar[XB_TOPGEN], 1u);
            else XB_SPIN(xb_ld(&bar[XB_TOPGEN]) == tg, bar);
            __builtin_amdgcn_fence(__ATOMIC_ACQUIRE, "agent");
            xb_add(&bar[XB_XGEN(b.x)], 1u);
            asm volatile("s_waitcnt vmcnt(0)" ::: "memory");
        } else {
            XB_SPIN(xb_ld(&bar[XB_XGEN(b.x)]) == gen, bar);
            __builtin_amdgcn_fence(__ATOMIC_ACQUIRE, "agent");
            asm volatile("s_waitcnt vmcnt(0)" ::: "memory");
        }
    }
    __syncthreads();
}

typedef float f32x16 __attribute__((ext_vector_type(16)));
typedef unsigned u32x2 __attribute__((ext_vector_type(2)));
__device__ __forceinline__ float bf2f(short s) { return __builtin_bit_cast(float, (unsigned)(unsigned short)s << 16); }
__device__ __forceinline__ float bfu2f(unsigned u16) { return __builtin_bit_cast(float, u16 << 16); }
__device__ __forceinline__ float rsq(float x) { return __builtin_amdgcn_rsqf(x); }

typedef const float* cfp_t;
struct Frame {
    LAS unsigned char* lds;
    volatile LAS unsigned* MISC;
    gu32* ctl;
    int tid, lane, wave;
    int vcu, G;
    const __attribute__((address_space(4))) cfp_t* in;
    const float* x; float* out;
    unsigned char* ws;
    bf16 *XB, *Y, *XQ, *XO, *BIG, *MEMN, *KVRAW, *KN, *VT, *WSP;
    float *LOGF, *CUM, *SSQ;
};
__device__ __forceinline__ bf16* lw(Frame& F, int l, size_t off) { return (bf16*)(F.ws + WS_LAYER + (size_t)l * LAYER_STRIDE + off); }

__device__ __forceinline__ float wave_sum(float v) {
#pragma unroll
    for (int o = 1; o < 64; o <<= 1) v += __shfl_xor(v, o);
    return v;
}
typedef float f32x2 __attribute__((ext_vector_type(2)));
__device__ __forceinline__ int p0_drow(int n, int map) {
    if (map == 1) { if (n >= 1024 && n < 2048) { const int tile = n >> 8, ll = n & 255; return tile * 256 + 128 * ((ll >> 5) & 1) + 32 * (ll >> 6) + (ll & 31); } return n; }
    if (map == 2) return 256 * (n >> 7) + (n & 127);
    if (map == 3) return 256 * (n >> 7) + 128 + (n & 127);
    if (map == 4) {
        if (n < 512) return n; if (n < 1024) return 512 + 256 * ((n - 512) >> 7) + (n & 127); if (n < 1536) return 1536 + (n - 1024); return 512 + 256 * ((n - 1536) >> 7) + 128 + (n & 127); }
    return n;
}
__device__ __forceinline__ void p0_transpose_item(const float* W, int ldn, const float* ks, bf16* WT, int ldk, int koff, int k0, int n0, int map, LAS unsigned char* scr, int lane) {
    const float* src = W + (size_t)k0 * ldn + n0 + 2 * lane;
    f32x2 v[4][16];
#define P0_LD(b) do { _Pragma("unroll") for (int i = 0; i < 16; ++i) v[b][i] = __builtin_nontemporal_load((const GAS f32x2*)(src + (size_t)(16 * (b) + i) * ldn)); } while (0)
#define P0_ST(b) do { _Pragma("unroll") for (int i = 0; i < 16; i += 2) { const int kk = 16 * (b) + i; float s0 = 1.f, s1 = 1.f; if (ks) { s0 = ks[k0 + kk]; s1 = ks[k0 + kk + 1]; } \
        *(LAS unsigned*)(scr + (2 * lane) * 136 + kk * 2) = pk2h(v[b][i].x * s0, v[b][i + 1].x * s1); \
        *(LAS unsigned*)(scr + (2 * lane + 1) * 136 + kk * 2) = pk2h(v[b][i].y * s0, v[b][i + 1].y * s1); } } while (0)
    P0_LD(0); P0_LD(1); P0_LD(2); P0_ST(0); P0_LD(3); P0_ST(1); P0_ST(2); P0_ST(3);
#undef P0_LD
#undef P0_ST
    LDS_WAIT(); asm volatile("" ::: "memory");
    const int c = lane & 7;
#pragma unroll
    for (int j = 0; j < 16; ++j) { const int n = (lane >> 3) + 8 * j; const LAS unsigned char* p = scr + n * 136 + c * 16;
        const u32x2 lo = *(const LAS u32x2*)p, hi = *(const LAS u32x2*)(p + 8);
        v4u o; o.x = lo.x; o.y = lo.y; o.z = hi.x; o.w = hi.y;
        *(GAS v4u*)(WT + (size_t)p0_drow(n0 + n, map) * ldk + koff + k0 + 8 * c) = o; }
    LDS_WAIT(); asm volatile("" ::: "memory");
}
__device__ __forceinline__ void p0_transpose_item8(const float* W, int ldn, float sc, unsigned char* WT, int ldk, int k0, int n0, LAS unsigned char* scr, int lane) {
    const float* src = W + (size_t)k0 * ldn + n0 + 2 * lane;
    f32x2 v[4][16];
#define P0_LD(b) do { _Pragma("unroll") for (int i = 0; i < 16; ++i) v[b][i] = __builtin_nontemporal_load((const GAS f32x2*)(src + (size_t)(16 * (b) + i) * ldn)); } while (0)
#define P0_ST(b) do { _Pragma("unroll") for (int i = 0; i < 16; i += 4) { const int kk = 16 * (b) + i; \
        *(LAS unsigned*)(scr + (2 * lane) * 72 + kk) = pg8::pk4_f8(v[b][i].x * sc, v[b][i + 1].x * sc, v[b][i + 2].x * sc, v[b][i + 3].x * sc); \
        *(LAS unsigned*)(scr + (2 * lane + 1) * 72 + kk) = pg8::pk4_f8(v[b][i].y * sc, v[b][i + 1].y * sc, v[b][i + 2].y * sc, v[b][i + 3].y * sc); } } while (0)
    P0_LD(0); P0_LD(1); P0_LD(2); P0_ST(0); P0_LD(3); P0_ST(1); P0_ST(2); P0_ST(3);
#undef P0_LD
#undef P0_ST
    LDS_WAIT(); asm volatile("" ::: "memory");
    const int c = lane & 3;
#pragma unroll
    for (int j = 0; j < 8; ++j) { const int n = (lane >> 2) + 16 * j; const LAS unsigned char* p = scr + n * 72 + c * 16;
        const u32x2 lo = *(const LAS u32x2*)p, hi = *(const LAS u32x2*)(p + 8);
        v4u o; o.x = lo.x; o.y = lo.y; o.z = hi.x; o.w = hi.y;
        *(GAS v4u*)(WT + (size_t)(n0 + n) * ldk + k0 + 16 * c) = o; }
    LDS_WAIT(); asm volatile("" ::: "memory");
}
__device__ __forceinline__ bool p0_job8(int& r, const float* src, int ldn, int K, int N, float sc, unsigned char* dst, int ldk, LAS unsigned char* scr, int lane) {
    const int nblk = N / 128, items = (K / 64) * nblk;
    if (r >= items) { r -= items; return false; }
    const int kb = r / nblk, nb = r % nblk;
    p0_transpose_item8(src, ldn, sc, dst, ldk, 64 * kb, 128 * nb, scr, lane);
    return true;
}
__device__ __forceinline__ bool p0_job(int& r, const float* src, int ldn, int K, int N, const float* ks, bf16* dst, int ldk, int koff, int map, LAS unsigned char* scr, int lane) {
    const int nblk = N / 128, items = (K / 64) * nblk;
    if (r >= items) { r -= items; return false; }
    const int kb = r / nblk, nb = r % nblk;
    p0_transpose_item(src, ldn, ks, dst, ldk, koff, 64 * kb, 128 * nb, map, scr, lane);
    return true;
}
__device__ __forceinline__ void p0_prologue(Frame& F) {
    LAS unsigned char* scr = F.lds + RING_OFF + F.wave * 17408;
    const int gw = F.vcu * NWAVES + F.wave, NGW = F.G * NWAVES, lane = F.lane;
    const __attribute__((address_space(4))) cfp_t* in = F.in;
    constexpr int I_IN0 = 16 * 20, I_SQ = 16 * 8, I_IN1 = 16 * 16, I_O1 = 8 * 8, I_Q = 16 * 4, I_KV = 16 * 8, I_XO = 8 * 8, I_G = 16 * 22, I_DN = 44 * 8;
    constexpr int NITEMS = I_IN0 + I_SQ + I_IN1 + I_O1 + 2 * (I_Q + I_KV + I_XO + 2 * I_G + I_DN);
#ifdef PROBE_PHASE
#define P0REP(k) for (int prep_ = 0; prep_ < ((PROBE_PHASE == 100 + (k)) ? 2 : 1); ++prep_)
#else
#define P0REP(k)
#endif
    P0REP(1)
    for (int it = gw; it < NITEMS; it += NGW) {
        int r = it;
        if (p0_job(r, in[14], EVEN_IN, D, N_IN0, in[2], (bf16*)(F.ws + WS_WIN0), D, 0, 1, scr, lane)) continue;
        if (p0_job(r, in[21], D, D, D, nullptr, (bf16*)(F.ws + WS_WOUT0), D, 0, 0, scr, lane)) continue;
        if (p0_job(r, in[22], N_IN1, D, N_IN1, in[2] + D, (bf16*)(F.ws + WS_WIN1), D, 0, 4, scr, lane)) continue;
        if (p0_job(r, in[26] + (size_t)512 * D, D, 512, D, nullptr, (bf16*)(F.ws + WS_WOUT1), D, 512, 0, scr, lane)) continue;
        bool done = false;
#pragma unroll
        for (int l = 0; l < 2; ++l) {
            if (done) break;
            if (p0_job(r, in[5] + (size_t)l * D * XAW, XAW, D, XAW, in[3] + l * D, lw(F, l, L_WQ), D, 0, 0, scr, lane)) { done = true; break; }
            if (p0_job(r, in[6] + (size_t)l * D * D, D, D, D, in[4] + l * D, lw(F, l, L_WKV), D, 0, 0, scr, lane)) { done = true; break; }
            if (MK_F8XO) { if (p0_job8(r, in[7] + (size_t)l * XAW * D, D, XAW, D, F8_XOWSCALE, (unsigned char*)lw(F, l, L_WO), XAW, scr, lane)) { done = true; break; } }
            else if (p0_job(r, in[7] + (size_t)l * XAW * D, D, XAW, D, nullptr, lw(F, l, L_WO), XAW, 0, 0, scr, lane)) { done = true; break; }
            if (p0_job(r, in[11] + (size_t)l * D * DFF, DFF, D, DFF, in[10] + l * D, lw(F, l, L_WGU), D, 0, 2, scr, lane)) { done = true; break; }
            if (p0_job(r, in[12] + (size_t)l * D * DFF, DFF, D, DFF, in[10] + l * D, lw(F, l, L_WGU), D, 0, 3, scr, lane)) { done = true; break; }
            if ((MK_F8DN >> l) & 1) { if (p0_job8(r, in[13] + (size_t)l * DFF * D, D, DFF, D, F8_WSCALE, (unsigned char*)lw(F, l, L_WD), DFF, scr, lane)) { done = true; break; } }
            else if (p0_job(r, in[13] + (size_t)l * DFF * D, D, DFF, D, nullptr, lw(F, l, L_WD), DFF, 0, 0, scr, lane)) { done = true; break; }
        }
    }
    P0REP(2)
    for (int it = gw; it < 128 * 16; it += NGW) {
        const int kk0 = (it >> 4) * 4, n0 = (it & 15) * 64, g = kk0 >> 7;
        const float* wp = in[23] + (size_t)kk0 * 128; const float* sp = in[24] + g * 128; const float* wo = in[26] + (size_t)(g * 128) * D + n0 + lane;
        float acc[4];
#pragma unroll
        for (int j = 0; j < 4; ++j) acc[j] = 0.f;
#pragma unroll 32
        for (int d = 0; d < 128; ++d) { const float w = wo[(size_t)d * D] * sp[d];
#pragma unroll
            for (int j = 0; j < 4; ++j) acc[j] += wp[j * 128 + d] * w; }
        u32x2 o; o.x = pk2h(acc[0], acc[1]); o.y = pk2h(acc[2], acc[3]);
        *(GAS u32x2*)((bf16*)(F.ws + WS_WOUT1) + (size_t)(n0 + lane) * D + kk0) = o;
    }
    for (int i = gw * 64 + lane; i < 4 * 128 * 128; i += NGW * 64) { const int t = (i >> 7) & 127, s = i & 127; const float w = in[17][i]; F.WSP[i] = (bf16)f2bf((t >> 6) >= (s >> 6) ? w : 0.f); }
    for (int row = gw; row < MROWS; row += NGW) {
        const GAS f32x4* xr = (const GAS f32x4*)(in[1] + (size_t)row * D) + lane;
        f32x4 v[4]; float s = 0.f;
#pragma unroll
        for (int j = 0; j < 4; ++j) { v[j] = xr[64 * j]; s += (v[j].x * v[j].x + v[j].y * v[j].y) + (v[j].z * v[j].z + v[j].w * v[j].w); }
        const float rstd = rsq(wave_sum(s) * (1.f / D) + EPS);
        GAS unsigned long long* o8 = (GAS unsigned long long*)(F.MEMN + (size_t)row * D) + lane;
#pragma unroll
        for (int j = 0; j < 4; ++j) o8[64 * j] = (unsigned long long)pk2h(v[j].x * rstd, v[j].y * rstd) | ((unsigned long long)pk2h(v[j].z * rstd, v[j].w * rstd) << 32);
    }
    {
        LAS float* wl = (LAS float*)(F.lds + RING_OFF);
        __syncthreads();
#pragma unroll
        for (int r = 0; r < 2; ++r) { const int k = F.tid + 512 * r; const float g = in[2][k]; const float* p = in[14] + (size_t)k * EVEN_IN + N_IN0;
            const f32x4 a = *(const f32x4*)p, b = *(const f32x4*)(p + 4);
            wl[0 * 1024 + k] = a.x * g; wl[1 * 1024 + k] = a.y * g; wl[2 * 1024 + k] = a.z * g; wl[3 * 1024 + k] = a.w * g;
            wl[4 * 1024 + k] = b.x * g; wl[5 * 1024 + k] = b.y * g; wl[6 * 1024 + k] = b.z * g; wl[7 * 1024 + k] = b.w * g; }
        __syncthreads();
        float wf[8][16];
#pragma unroll
        for (int j = 0; j < 8; ++j)
#pragma unroll
            for (int jj = 0; jj < 4; ++jj) { const f32x4 w = *(const LAS f32x4*)(wl + j * 1024 + 4 * lane + 256 * jj); wf[j][jj * 4 + 0] = w.x; wf[j][jj * 4 + 1] = w.y; wf[j][jj * 4 + 2] = w.z; wf[j][jj * 4 + 3] = w.w; }
        const float bfl = in[15][lane & 7];
        P0REP(3) {
        int row = gw;
        f32x4 v[4], v1[4];
        if (row < T) { const GAS f32x4* xr = (const GAS f32x4*)(F.x + (size_t)row * D) + lane;
#pragma unroll
            for (int j = 0; j < 4; ++j) v[j] = __builtin_nontemporal_load(xr + 64 * j); }
        if (row + NGW < T) { const GAS f32x4* xr = (const GAS f32x4*)(F.x + (size_t)(row + NGW) * D) + lane;
#pragma unroll
            for (int j = 0; j < 4; ++j) v1[j] = __builtin_nontemporal_load(xr + 64 * j); }
        while (row < T) {
            const int nrow = row + NGW; f32x4 vn[4];
            if (nrow + NGW < T) { const GAS f32x4* xr = (const GAS f32x4*)(F.x + (size_t)(nrow + NGW) * D) + lane;
#pragma unroll
                for (int j = 0; j < 4; ++j) vn[j] = __builtin_nontemporal_load(xr + 64 * j); }
            float s = 0.f;
#pragma unroll
            for (int j = 0; j < 4; ++j) s += (v[j].x * v[j].x + v[j].y * v[j].y) + (v[j].z * v[j].z + v[j].w * v[j].w);
            float a[8];
#pragma unroll
            for (int j2 = 0; j2 < 8; ++j2) { float t = 0.f;
#pragma unroll
                for (int jj = 0; jj < 4; ++jj) t += (v[jj].x * wf[j2][jj * 4 + 0] + v[jj].y * wf[j2][jj * 4 + 1]) + (v[jj].z * wf[j2][jj * 4 + 2] + v[jj].w * wf[j2][jj * 4 + 3]);
                a[j2] = t; }
            float b4[4], b2[2], b1;
#pragma unroll
            for (int i = 0; i < 4; ++i) { const float keep = (lane & 1) ? a[2 * i + 1] : a[2 * i], give = (lane & 1) ? a[2 * i] : a[2 * i + 1]; b4[i] = keep + __shfl_xor(give, 1); }
#pragma unroll
            for (int i = 0; i < 2; ++i) { const float keep = (lane & 2) ? b4[2 * i + 1] : b4[2 * i], give = (lane & 2) ? b4[2 * i] : b4[2 * i + 1]; b2[i] = keep + __shfl_xor(give, 2); }
            { const float keep = (lane & 4) ? b2[1] : b2[0], give = (lane & 4) ? b2[0] : b2[1]; b1 = keep + __shfl_xor(give, 4); }
            b1 += __shfl_xor(b1, 8); b1 += __shfl_xor(b1, 16); b1 += __shfl_xor(b1, 32);
            s = wave_sum(s);
            const float rstd = rsq(s * (1.f / D) + EPS);
            if (lane < 16) F.SSQ[(size_t)row * 16 + lane] = (lane == 0) ? s : 0.f;
            GAS unsigned long long* o8 = (GAS unsigned long long*)(F.XB + (size_t)row * D) + lane;
#pragma unroll
            for (int j = 0; j < 4; ++j) o8[64 * j] = (unsigned long long)pk2h(v[j].x, v[j].y) | ((unsigned long long)pk2h(v[j].z, v[j].w) << 32);
            if (lane < 8) { const float fl = b1 * rstd + bfl; const float lf = fminf(fl, 0.f) - log1pf(expf(-fabsf(fl)));
                F.LOGF[((size_t)(row / SEQ) * 8 + lane) * SEQ + (row % SEQ)] = lf * LOG2E; }
#pragma unroll
            for (int j = 0; j < 4; ++j) { v[j] = v1[j]; v1[j] = vn[j]; }
            row = nrow;
        }
        }
    }
}
__device__ __forceinline__ void cumsum_seq(Frame& F, int bh) {
    const int tid = F.tid, lane = F.lane;
    const f32x4* src = (const f32x4*)(F.LOGF + (size_t)bh * SEQ + tid * 16);
    f32x4 q[4];
#pragma unroll
    for (int i = 0; i < 4; ++i) q[i] = src[i];
    float run = 0.f;
#pragma unroll
    for (int i = 0; i < 4; ++i) { q[i].x += run; q[i].y += q[i].x; q[i].z += q[i].y; q[i].w += q[i].z; run = q[i].w; }
    float incl = run;
#pragma unroll
    for (int o = 1; o < 64; o <<= 1) { const float t = __shfl_up(incl, o); if (lane >= o) incl += t; }
    LAS float* sc = (LAS float*)F.lds;
    __syncthreads();
    if (lane == 63) sc[F.wave] = incl;
    __syncthreads();
    float woff = 0.f;
#pragma unroll
    for (int w = 0; w < NWAVES; ++w) woff += (w < F.wave) ? sc[w] : 0.f;
    const float off = woff + (incl - run);
    f32x4* dst = (f32x4*)(F.CUM + (size_t)bh * SEQ + tid * 16);
#pragma unroll
    for (int i = 0; i < 4; ++i) dst[i] = q[i] + off;
    __syncthreads();
}
__device__ __forceinline__ void xa_kv_finalize(Frame& F, int item) {
    const int tid = F.tid, l = item >> 4, b = (item >> 2) & 3, h = item & 3;
    const int kvr = tid >> 1, half = tid & 1;
    const bf16* kp = F.KVRAW + (size_t)l * MROWS * D + (size_t)(b * NMEM + kvr) * D + h * 128 + 64 * half;
    const size_t obase = (size_t)((l * 4 + b) * 4 + h) * (NMEM * 128);
    bf16x8 x[8]; float ss = 0.f;
#pragma unroll
    for (int i = 0; i < 8; ++i) { x[i] = *(const GAS bf16x8*)(kp + 8 * i);
#pragma unroll
        for (int e = 0; e < 8; ++e) { const float f = bf2f(x[i][e]); ss += f * f; } }
    ss += __shfl_xor(ss, 1);
    const float rstd = rsq(ss * (1.f / 128.f) + EPS);
    const float* gk = F.in[9] + l * 128 + 64 * half;
    bf16* ko = F.KN + obase + (size_t)kvr * 128 + 64 * half;
#pragma unroll
    for (int i = 0; i < 8; ++i) { v4u o;
        o.x = pk2(bf2f(x[i][0]) * rstd * gk[8 * i + 0], bf2f(x[i][1]) * rstd * gk[8 * i + 1]); o.y = pk2(bf2f(x[i][2]) * rstd * gk[8 * i + 2], bf2f(x[i][3]) * rstd * gk[8 * i + 3]);
        o.z = pk2(bf2f(x[i][4]) * rstd * gk[8 * i + 4], bf2f(x[i][5]) * rstd * gk[8 * i + 5]); o.w = pk2(bf2f(x[i][6]) * rstd * gk[8 * i + 6], bf2f(x[i][7]) * rstd * gk[8 * i + 7]);
        *(GAS v4u*)(ko + 8 * i) = o; }
    const bf16* vp = kp + XAW;
    const int pk = (kvr & ~12) | ((kvr & 4) << 1) | ((kvr & 8) >> 1);
    LAS unsigned short* vl = (LAS unsigned short*)F.lds;
    __syncthreads();
#pragma unroll
    for (int i = 0; i < 8; ++i) { const bf16x8 v = *(const GAS bf16x8*)(vp + 8 * i);
#pragma unroll
        for (int e = 0; e < 8; ++e) vl[(64 * half + 8 * i + e) * NMEM + pk] = (unsigned short)v[e]; }
    __syncthreads();
    bf16* vo = F.VT + obase;
#pragma unroll
    for (int i = 0; i < 8; ++i) { const int id = tid + 512 * i; *(GAS v4u*)(vo + id * 8) = *(const LAS v4u*)(vl + id * 8); }
    __syncthreads();
}
__device__ __forceinline__ void gmlp_loads(Frame& F, int r0, int g, bf16x8 (&x)[4], v4u (&up)[4], float (&bp)[4]) {
    const int tid = F.tid, lane = F.lane; const bf16* Z = F.BIG;
    { const int row = tid >> 2, q = tid & 3; const bf16* vp = Z + (size_t)(r0 + row) * N_IN0 + 512 + g * 128 + 32 * q;
#pragma unroll
      for (int i = 0; i < 4; ++i) x[i] = __builtin_nontemporal_load((const GAS bf16x8*)(vp + 8 * i)); }
    const int tb = F.wave & 3, chh = F.wave >> 2;
#pragma unroll
    for (int i = 0; i < 4; ++i) { const int t = (lane >> 3) + 8 * i, ch = lane & 7, row = r0 + 32 * tb + t;
        up[i] = __builtin_nontemporal_load((const GAS v4u*)(Z + (size_t)row * N_IN0 + g * 128 + 64 * chh + 8 * ch)); bp[i] = F.in[18][g * 128 + 32 * tb + t]; }
}
__device__ __forceinline__ void gmlp_compute(Frame& F, int r0, int g, const bf16x8 (&x)[4], const v4u (&up)[4], const float (&bp)[4], bool has_next, bf16x8 (&nx)[4], v4u (&nup)[4], float (&nbp)[4]) {
    const int tid = F.tid, lane = F.lane, wid = F.wave, r32 = lane & 31, hi = lane >> 5;
    LAS unsigned char* vT = F.lds;
    __syncthreads();
    { const int row = tid >> 2, q = tid & 3; float ss = 0.f;
#pragma unroll
      for (int i = 0; i < 4; ++i)
#pragma unroll
          for (int e = 0; e < 8; ++e) { const float f = bf2f(x[i][e]); ss += f * f; }
      ss += __shfl_xor(ss, 1); ss += __shfl_xor(ss, 2);
      const float rstd = rsq(ss * (1.f / 128.f) + EPS);
      const float* gv = F.in[16] + g * 128 + 32 * q;
#pragma unroll
      for (int i = 0; i < 4; ++i)
#pragma unroll
          for (int e = 0; e < 8; e += 2) { const int c = 32 * q + 8 * i + e; const unsigned w = pk2h(bf2f(x[i][e]) * rstd * gv[8 * i + e], bf2f(x[i][e + 1]) * rstd * gv[8 * i + e + 1]);
              *(LAS unsigned short*)(vT + c * 272 + row * 2) = (unsigned short)(w & 0xffffu); *(LAS unsigned short*)(vT + (c + 1) * 272 + row * 2) = (unsigned short)(w >> 16); }
    }
    if (has_next) gmlp_loads(F, r0, g + 1, nx, nup, nbp);
    __syncthreads();
    const int tb = wid & 3, chh = wid >> 2;
    f32x16 acc[2]; acc[0] = f32x16{}; acc[1] = f32x16{};
    const bf16* Wg = F.WSP + (size_t)g * 128 * 128 + (size_t)(32 * tb + r32) * 128 + 8 * hi;
#pragma unroll
    for (int ks = 0; ks < 8; ++ks) { const bf16x8 bfr = *(const GAS bf16x8*)(Wg + 16 * ks);
#pragma unroll
        for (int c2 = 0; c2 < 2; ++c2) { const bf16x8 a = *(const LAS bf16x8*)(vT + (32 * (2 * chh + c2) + r32) * 272 + (16 * ks + 8 * hi) * 2);
            acc[c2] = __builtin_amdgcn_mfma_f32_32x32x16_bf16(a, bfr, acc[c2], 0, 0, 0); } }
    LAS unsigned char* stg = F.lds + 40960 + wid * (32 * 272);
#pragma unroll
    for (int c2 = 0; c2 < 2; ++c2)
#pragma unroll
        for (int g4 = 0; g4 < 4; ++g4) { const f32x4 v = (f32x4){acc[c2][4 * g4 + 0], acc[c2][4 * g4 + 1], acc[c2][4 * g4 + 2], acc[c2][4 * g4 + 3]};
            *(LAS f32x4*)(stg + r32 * 272 + (32 * c2 + 8 * g4 + 4 * hi) * 4) = v; }
    LDS_WAIT(); asm volatile("" ::: "memory");
#pragma unroll
    for (int i = 0; i < 4; ++i) { const int t = (lane >> 3) + 8 * i, ch = lane & 7, row = r0 + 32 * tb + t;
        const f32x4 s0 = *(const LAS f32x4*)(stg + t * 272 + ch * 32), s1 = *(const LAS f32x4*)(stg + t * 272 + ch * 32 + 16);
        const float bs = bp[i]; const v4u u = up[i];
        v4u o; o.x = pk2h(bfu2f(u.x & 0xffffu) * (s0.x + bs), bfu2f(u.x >> 16) * (s0.y + bs)); o.y = pk2h(bfu2f(u.y & 0xffffu) * (s0.z + bs), bfu2f(u.y >> 16) * (s0.w + bs));
        o.z = pk2h(bfu2f(u.z & 0xffffu) * (s1.x + bs), bfu2f(u.z >> 16) * (s1.y + bs)); o.w = pk2h(bfu2f(u.w & 0xffffu) * (s1.z + bs), bfu2f(u.w >> 16) * (s1.w + bs));
        *(GAS v4u*)(F.Y + (size_t)row * D + g * 128 + 64 * chh + 8 * ch) = o; }
}
__device__ __forceinline__ void gmlp_item(Frame& F, int blk) {
    const int r0 = blk * 128;
    bf16x8 xa[4], xb[4]; v4u ua[4], ub[4]; float ba[4], bb[4];
    gmlp_loads(F, r0, 0, xa, ua, ba);
    gmlp_compute(F, r0, 0, xa, ua, ba, true, xb, ub, bb);
    gmlp_compute(F, r0, 1, xb, ub, bb, true, xa, ua, ba);
    gmlp_compute(F, r0, 2, xa, ua, ba, true, xb, ub, bb);
    gmlp_compute(F, r0, 3, xb, ub, bb, false, xa, ua, ba);
}
__device__ __forceinline__ void mix1_phase(Frame& F) {
    const bf16* Z = F.BIG;
    const int tid = F.tid;
    for (int it = F.vcu; it < T / 128; it += F.G) {
        const int rc = it * 4 + (tid >> 7), cc = tid & 127, t0 = rc * 32, pos0 = t0 % SEQ;
        if (cc < 64) {
            const int w = 2 << (cc >> 4); const bf16* zp = Z + (size_t)t0 * Z1P + 8 * cc; bf16* yp = F.Y + (size_t)t0 * D + 8 * cc;
            float s[8];
#pragma unroll
            for (int e = 0; e < 8; ++e) s[e] = 0.f;
            for (int j = 1; j < w; ++j) if (pos0 - j >= 0) { const bf16x8 z = *(const GAS bf16x8*)(zp - (size_t)j * Z1P);
#pragma unroll
                for (int e = 0; e < 8; ++e) s[e] += bf2f(z[e]); }
            for (int i = 0; i < 32; ++i) { const int pos = pos0 + i; const bf16x8 z = *(const GAS bf16x8*)(zp + (size_t)i * Z1P);
                float zf[8];
#pragma unroll
                for (int e = 0; e < 8; ++e) { zf[e] = bf2f(z[e]); s[e] += zf[e]; }
                const float inv = 1.0f / (float)((pos + 1 < w) ? pos + 1 : w);
                v4u o; o.x = pk2h(s[0] * inv - zf[0], s[1] * inv - zf[1]); o.y = pk2h(s[2] * inv - zf[2], s[3] * inv - zf[3]); o.z = pk2h(s[4] * inv - zf[4], s[5] * inv - zf[5]); o.w = pk2h(s[6] * inv - zf[6], s[7] * inv - zf[7]);
                *(GAS v4u*)(yp + (size_t)i * D) = o;
                if (pos + 1 >= w) { const bf16x8 zo = *(const GAS bf16x8*)(zp + (long)(i - w + 1) * Z1P);
#pragma unroll
                    for (int e = 0; e < 8; ++e) s[e] -= bf2f(zo[e]); } }
        } else {
            const int c8 = (cc - 64) * 8; const bf16* xp = Z + (size_t)t0 * Z1P + 512 + c8; bf16* yp = F.Y + (size_t)t0 * D + 512 + c8;
            const float* cw = F.in[25];
            float w0[8], w1[8], w2[8], x1[8], x2[8];
#pragma unroll
            for (int e = 0; e < 8; ++e) { w0[e] = cw[c8 + e]; w1[e] = cw[512 + c8 + e]; w2[e] = cw[1024 + c8 + e]; x1[e] = 0.f; x2[e] = 0.f; }
            if (pos0 >= 2) { const bf16x8 a2 = *(const GAS bf16x8*)(xp - 2 * (size_t)Z1P), a1 = *(const GAS bf16x8*)(xp - (size_t)Z1P);
#pragma unroll
                for (int e = 0; e < 8; ++e) { x2[e] = bf2f(a2[e]); x1[e] = bf2f(a1[e]); } }
            for (int i = 0; i < 32; ++i) { const bf16* p = xp + (size_t)i * Z1P; const bf16x8 xv = __builtin_nontemporal_load((const GAS bf16x8*)p), gb = __builtin_nontemporal_load((const GAS bf16x8*)(p + 512));
                float y[8];
#pragma unroll
                for (int e = 0; e < 8; ++e) { const float x0 = bf2f(xv[e]); y[e] = bf2f(gb[e]) * (w0[e] * x2[e] + w1[e] * x1[e] + w2[e] * x0); x2[e] = x1[e]; x1[e] = x0; }
                v4u o; o.x = pk2h(y[0], y[1]); o.y = pk2h(y[2], y[3]); o.z = pk2h(y[4], y[5]); o.w = pk2h(y[6], y[7]);
                *(GAS v4u*)(yp + (size_t)i * D) = o; }
        }
    }
}
__device__ __forceinline__ void xa_attn_unit(Frame& F, int l, int pm, int pn) {
    const int b = pm / (SEQ / 256);
    for (int hh = 0; hh < 2; ++hh) {
        int tid = F.tid; asm volatile("" : "+v"(tid));
        const int lane = tid & 63, wid = F.wave, r32 = lane & 31, hi = lane >> 5;
        LAS unsigned char* Kl = F.lds; LAS unsigned char* Vl = F.lds + XA_KBYTES;
        const unsigned q = (unsigned)(pm * 256 + wid * 32 + r32);
        const int h = 2 * pn + hh;
        const bf16* Kg = F.KN + (size_t)((l * 4 + b) * 4 + h) * (NMEM * 128);
        const bf16* Vg = F.VT + (size_t)((l * 4 + b) * 4 + h) * (NMEM * 128);
        const bf16* Qp = F.XQ + (q * XAW + h * 128 + 8 * hi);
        bf16x8 qf[8];
#pragma unroll
        for (int ks = 0; ks < 8; ++ks) qf[ks] = *(const GAS bf16x8*)(Qp + 16 * ks);
        __syncthreads();
#pragma unroll
        for (int i = 0; i < 8; ++i) { const int id = tid + 512 * i, row = id >> 4, ch = id & 15; const v4u x = *(const GAS v4u*)(Kg + row * 128 + ch * 8); *(LAS v4u*)(Kl + row * XA_KROW + ch * 16) = x; }
#pragma unroll
        for (int i = 0; i < 8; ++i) { const int id = tid + 512 * i, row = id >> 5, ch = id & 31; const v4u x = *(const GAS v4u*)(Vg + row * 256 + ch * 8); *(LAS v4u*)(Vl + row * XA_VROW + ch * 16) = x; }
        float ss = 0.f;
#pragma unroll
        for (int ks = 0; ks < 8; ++ks)
#pragma unroll
            for (int e = 0; e < 8; ++e) { const float f = bf2f(qf[ks][e]); ss += f * f; }
        ss += __shfl_xor(ss, 32);
        const float sc = rsq(ss * (1.f / 128.f) + EPS) * XA_C2;
        const float* gq = F.in[8] + l * 128 + 8 * hi;
#pragma unroll
        for (int ks = 0; ks < 8; ++ks) { const f32x4 ga = *(const f32x4*)(gq + 16 * ks), gb = *(const f32x4*)(gq + 16 * ks + 4);
            v4u w; w.x = pk2(bf2f(qf[ks][0]) * sc * ga.x, bf2f(qf[ks][1]) * sc * ga.y); w.y = pk2(bf2f(qf[ks][2]) * sc * ga.z, bf2f(qf[ks][3]) * sc * ga.w);
            w.z = pk2(bf2f(qf[ks][4]) * sc * gb.x, bf2f(qf[ks][5]) * sc * gb.y); w.w = pk2(bf2f(qf[ks][6]) * sc * gb.z, bf2f(qf[ks][7]) * sc * gb.w);
            qf[ks] = __builtin_bit_cast(bf16x8, w); }
        __syncthreads();
        f32x16 s[8];
#pragma unroll
        for (int kvb = 0; kvb < 8; ++kvb) s[kvb] = f32x16{};
        const LAS unsigned char* kbase = Kl + r32 * XA_KROW + hi * 16;
        bf16x8 fa[4], fb[4];
#define XA_LDK(dst, st) do { _Pragma("unroll") for (int j_ = 0; j_ < 4; ++j_) dst[j_] = *(const LAS bf16x8*)(kbase + ((st) >> 1) * (32 * XA_KROW) + (4 * ((st) & 1) + j_) * 32); } while (0)
#define XA_MMK(src, st) do { _Pragma("unroll") for (int j_ = 0; j_ < 4; ++j_) s[(st) >> 1] = __builtin_amdgcn_mfma_f32_32x32x16_bf16(src[j_], qf[4 * ((st) & 1) + j_], s[(st) >> 1], 0, 0, 0); } while (0)
        XA_LDK(fa, 0);
#pragma unroll
        for (int st = 0; st < 16; st += 2) {
            XA_LDK(fb, st + 1); XA_MMK(fa, st); __builtin_amdgcn_sched_barrier(0);
            if (st + 2 < 16) XA_LDK(fa, st + 2);
            XA_MMK(fb, st + 1); __builtin_amdgcn_sched_barrier(0);
        }
#undef XA_LDK
#undef XA_MMK
        __syncthreads();
        float m = -INFINITY;
#pragma unroll
        for (int kvb = 0; kvb < 8; ++kvb)
#pragma unroll
            for (int r = 0; r < 16; ++r) m = fmaxf(m, s[kvb][r]);
        m = fmaxf(m, __shfl_xor(m, 32));
        float lsum = 0.f;
        bf16x8 pf[8][2];
#pragma unroll
        for (int kvb = 0; kvb < 8; ++kvb) {
#pragma unroll
            for (int r = 0; r < 16; ++r) { const float p = __builtin_amdgcn_exp2f(s[kvb][r] - m); s[kvb][r] = p; lsum += p; }
#pragma unroll
            for (int s2 = 0; s2 < 2; ++s2) { v4u w; w.x = pk2h(s[kvb][8 * s2 + 0], s[kvb][8 * s2 + 1]); w.y = pk2h(s[kvb][8 * s2 + 2], s[kvb][8 * s2 + 3]); w.z = pk2h(s[kvb][8 * s2 + 4], s[kvb][8 * s2 + 5]); w.w = pk2h(s[kvb][8 * s2 + 6], s[kvb][8 * s2 + 7]);
                pf[kvb][s2] = __builtin_bit_cast(bf16x8, w); } }
        lsum += __shfl_xor(lsum, 32);
        f32x16 o[4];
#pragma unroll
        for (int db = 0; db < 4; ++db) o[db] = f32x16{};
        const LAS unsigned char* vbase = Vl + r32 * XA_VROW + hi * 16;
#define XA_LDV(dst, st) do { _Pragma("unroll") for (int j_ = 0; j_ < 4; ++j_) dst[j_] = *(const LAS bf16x8*)(vbase + j_ * (32 * XA_VROW) + (st) * 32); } while (0)
#define XA_MMV(src, st) do { _Pragma("unroll") for (int j_ = 0; j_ < 4; ++j_) o[j_] = __builtin_amdgcn_mfma_f32_32x32x16_bf16(src[j_], pf[(st) >> 1][(st) & 1], o[j_], 0, 0, 0); } while (0)
        XA_LDV(fa, 0);
#pragma unroll
        for (int st = 0; st < 16; st += 2) {
            XA_LDV(fb, st + 1); XA_MMV(fa, st); __builtin_amdgcn_sched_barrier(0);
            if (st + 2 < 16) XA_LDV(fa, st + 2);
            XA_MMV(fb, st + 1); __builtin_amdgcn_sched_barrier(0);
        }
#undef XA_LDV
#undef XA_MMV
        LAS unsigned char* stg = Kl + wid * (32 * XA_KROW);
        if constexpr (MK_F8XO) {
            const float inv = F8_XOASCALE / lsum;
#pragma unroll
            for (int db = 0; db < 4; ++db)
#pragma unroll
                for (int g4 = 0; g4 < 4; ++g4) { const int d0 = 32 * db + 8 * g4 + 4 * hi;
                    *(LAS unsigned*)(stg + r32 * 144 + d0) = pg8::pk4_f8(o[db][4 * g4 + 0] * inv, o[db][4 * g4 + 1] * inv, o[db][4 * g4 + 2] * inv, o[db][4 * g4 + 3] * inv); }
            LDS_WAIT(); asm volatile("" ::: "memory");
            unsigned char* Ob8 = (unsigned char*)F.XO + ((unsigned)(pm * 256 + wid * 32) * XAW + h * 128);
#pragma unroll
            for (int i = 0; i < 4; ++i) { const int row = 8 * i + (lane >> 3), ch = lane & 7; const v4u v = *(const LAS v4u*)(stg + row * 144 + ch * 16); *(GAS v4u*)(Ob8 + row * XAW + ch * 16) = v; }
            continue;
        }
        const float inv = 1.0f / lsum;
#pragma unroll
        for (int db = 0; db < 4; ++db)
#pragma unroll
            for (int g4 = 0; g4 < 4; ++g4) { const int d0 = 32 * db + 8 * g4 + 4 * hi; u32x2 w; w.x = pk2(o[db][4 * g4 + 0] * inv, o[db][4 * g4 + 1] * inv); w.y = pk2(o[db][4 * g4 + 2] * inv, o[db][4 * g4 + 3] * inv);
                *(LAS u32x2*)(stg + r32 * XA_KROW + d0 * 2) = w; }
        LDS_WAIT(); asm volatile("" ::: "memory");
        bf16* Ob = F.XO + ((unsigned)(pm * 256 + wid * 32) * XAW + h * 128);
#pragma unroll
        for (int i = 0; i < 8; ++i) { const int row = 4 * i + (lane >> 4), ch = lane & 15; const v4u v = *(const LAS v4u*)(stg + row * XA_KROW + ch * 16); *(GAS v4u*)(Ob + row * XAW + ch * 8) = v; }
    }
}

constexpr int RS_OFF = 131072;
template <class Sched> __device__ __forceinline__ const LAS float* rs_prepare(Frame& F, const Sched& S) {
    LAS float* t = (LAS float*)(F.lds + RS_OFF);
    int p0 = -1, p1 = -1, p2 = -1, p3 = -1; pg8::Unit u;
    for (int i = 0; S.next(i, u); ++i) { const int pm = u.pm; if (pm == p0 || pm == p1 || pm == p2 || pm == p3) continue; if (p0 < 0) p0 = pm; else if (p1 < 0) p1 = pm; else if (p2 < 0) p2 = pm; else if (p3 < 0) p3 = pm; }
    __syncthreads();
    if (F.tid < 4) t[F.tid] = __builtin_bit_cast(float, F.tid == 0 ? p0 : F.tid == 1 ? p1 : F.tid == 2 ? p2 : p3);
#pragma unroll
    for (int pass = 0; pass < 2; ++pass) { const int sl = 2 * pass + (F.tid >> 8); const int pm = sl == 0 ? p0 : sl == 1 ? p1 : sl == 2 ? p2 : p3;
        if (pm >= 0) t[16 + 256 * sl + (F.tid & 255)] = pg8::row_rstd(F.SSQ, pm * 256 + (F.tid & 255)); }
    __syncthreads();
    return t;
}

struct Args { cfp_t in[27]; float* out; unsigned char* ws; int ph_lo, ph_hi, li, pad; };
#define MKFRAME() do { int t_; asm volatile("v_mbcnt_lo_u32_b32 %0, -1, 0\n\tv_mbcnt_hi_u32_b32 %0, -1, %0\n\tv_lshl_add_u32 %0, %1, 6, %0" : "=&v"(t_) : "s"(wave_s));     \
    const __attribute__((address_space(4))) Args* ap_ = (const __attribute__((address_space(4))) Args*)__builtin_amdgcn_kernarg_segment_ptr(); asm volatile("" : "+s"(ap_)); unsigned char* ws_ = ap_->ws; \
    F.lds = (LAS unsigned char*)lds; F.MISC = (volatile LAS unsigned*)(F.lds + MISC_OFF); \
    F.tid = t_; F.lane = F.tid & 63; F.wave = __builtin_amdgcn_readfirstlane(F.tid >> 6); \
    F.G = gridDim.x; { const int bx = blockIdx.x; F.vcu = (F.G % 8 == 0) ? (bx % 8) * (F.G / 8) + bx / 8 : bx; } \
    F.ws = ws_; F.in = ap_->in; F.x = ap_->in[0]; F.out = ap_->out; F.ctl = (gu32*)(ws_ + WS_CTL); \
    F.XB = (bf16*)(ws_ + WS_XB); F.Y = (bf16*)(ws_ + WS_Y); F.XQ = (bf16*)(ws_ + WS_XQ); F.XO = (bf16*)(ws_ + WS_XO); F.BIG = (bf16*)(ws_ + WS_BIG); \
    F.MEMN = (bf16*)(ws_ + WS_MEMN); F.KVRAW = (bf16*)(ws_ + WS_KVRAW); F.KN = (bf16*)(ws_ + WS_KN); F.VT = (bf16*)(ws_ + WS_VT); F.WSP = (bf16*)(ws_ + WS_WSP); \
    F.LOGF = (float*)(ws_ + WS_LOGF); F.CUM = (float*)(ws_ + WS_CUM); F.SSQ = (float*)(ws_ + WS_SSQ); } while (0)
#define GRID_BAR() do { if (N_LAUNCHES == 1) { MKFRAME(); XcdBarrier b_; b_.bar = (unsigned*)(F.ctl + CW_BAR); b_.x = xb_xcc_id(); b_.st = F.MISC + 8; xcd_barrier(b_, F.tid); } } while (0)
#define IN(k) (lo <= (k) && (k) < hi)
#ifdef PROBE_PHASE
#define PROBE_REPS(k) (((k) == PROBE_PHASE) ? 2 : 1)
#else
#define PROBE_REPS(k) 1
#endif
#ifdef PROBE_XA_PHASE
#define PROBE_XA(k) (((k) == PROBE_XA_PHASE) ? 2 : 1)
#else
#define PROBE_XA(k) 1
#endif
#ifdef PROBE_EPI_PHASE
#define PROBE_EPI(k) (((k) == PROBE_EPI_PHASE) ? 2 : 1)
#else
#define PROBE_EPI(k) 1
#endif
#define BOTH(k) (IN(k) && IN((k) + 1))
template <int l> __device__ __forceinline__ void layer_phases(const int lo, const int hi, const int wave_s) {
    extern __shared__ __attribute__((aligned(16))) unsigned char lds[];
    Frame F; unsigned char* ws;
        const int pb = (l == 0) ? PH_IN0 : PH_IN1;
        if (IN(pb)) for (int rep_ = 0; rep_ < PROBE_REPS(pb); ++rep_) { MKFRAME(); ws = F.ws;
            if (l == 0) {
                if (blockIdx.x < 32) cumsum_seq(F, blockIdx.x);
                { pg8::Gemm g{F.XB, (const bf16*)(ws + WS_WIN0), T, N_IN0, D}; pg8::StaticOrder S; S.init(T, N_IN0, F.G, (int)blockIdx.x);
                  pg8::EpiIn0 E{F.BIG, N_IN0, rs_prepare(F, S), F.in[19], F.in[20], FOX_C2};
                  pg8::gemm_phase<pg8::EpiIn0, pg8::StaticOrder, PG8_ALIGN, PG8_SP2>(F.lds + RING_OFF, g, S, E, F.tid); }
            } else {
                pg8::Gemm g{F.XB, (const bf16*)(ws + WS_WIN1), T, N_IN1, D}; pg8::StaticOrder S; S.init(T, N_IN1, F.G, (int)blockIdx.x);
                pg8::EpiIn1 E{F.BIG, Z1P, rs_prepare(F, S)};
                pg8::gemm_phase<pg8::EpiIn1, pg8::StaticOrder, PG8_ALIGN, PG8_SP2>(F.lds + RING_OFF, g, S, E, F.tid);
            }
            if (BOTH(pb)) GRID_BAR();
        }
        if (IN(pb + 1)) for (int rep_ = 0; rep_ < PROBE_REPS(pb + 1); ++rep_) { MKFRAME(); ws = F.ws;
            if (l == 0) {
                for (;;) {
                    MKFRAME();
                    volatile LAS unsigned* mail = F.MISC + 16;
                    __syncthreads();
                    if (F.tid == 0) mail[0] = __hip_atomic_fetch_add((unsigned*)(F.ctl + CW_Q0), 1u, __ATOMIC_RELAXED, __HIP_MEMORY_SCOPE_AGENT);
                    __syncthreads();
                    const int it = __builtin_amdgcn_readfirstlane((int)mail[0]);
                    if (it >= 32 + 1024 + 256) break;
                    if (it < 32) {
                        const int l2 = it >> 4;
                        pg8::Gemm g{F.MEMN, lw(F, l2, L_WKV), MROWS, D, D}; pg8::OneUnit S; S.u.pm = (it >> 2) & 3; S.u.pn = it & 3;
                        pg8::EpiPlain E{F.KVRAW + (size_t)l2 * MROWS * D, D, nullptr};
                        pg8::gemm_phase<pg8::EpiPlain, pg8::OneUnit, PG8_ALIGN, PG8_SP2>(F.lds + RING_OFF, g, S, E, F.tid);
                    } else if (it < 32 + 1024) {
                        const int j = it - 32, hh = 7 - (j >> 7), qb = 31 - ((j & 127) >> 2), b = j & 3;
                        float th;
                        { const float gm = fabsf(F.in[19][F.lane] * F.in[20][F.lane]); float mx = gm;
        #pragma unroll
                          for (int o = 1; o < 64; o <<= 1) mx = fmaxf(mx, __shfl_xor(mx, o));
                          th = 2.0f * (64.0f * FOX_C2 * mx * 1.02f) + 40.0f; }
                        attn_body::attn_unit<8>(b, hh, qb, (const attn_body::bf16*)(F.BIG + 1024), (const attn_body::bf16*)(F.BIG + 1536), (const attn_body::bf16*)(F.BIG + 2048), (attn_body::bf16*)(F.Y + 512), F.CUM, th, (char*)lds + RING_OFF, F.tid);
                    } else {
                        const int blk = it - 1056;
                        gmlp_item(F, blk);
                    }
                }
            } else {
                mix1_phase(F);
            }
            if (BOTH(pb + 1)) GRID_BAR();
        }
        if (IN(pb + 2)) for (int rep_ = 0; rep_ < PROBE_REPS(pb + 2); ++rep_) { MKFRAME(); ws = F.ws;
            if (l == 0 && blockIdx.x < 32) xa_kv_finalize(F, blockIdx.x);
            pg8::Gemm g{F.Y, (const bf16*)(ws + (l == 0 ? WS_WOUT0 : WS_WOUT1)), T, D, D}; pg8::StaticOrder S; S.init(T, D, F.G, (int)blockIdx.x);
            pg8::EpiRes E{nullptr, F.XB, nullptr, F.SSQ, D, 1.0f};
            pg8::gemm_phase<pg8::EpiRes, pg8::StaticOrder, PG8_ALIGN, PG8_SP2>(F.lds + RING_OFF, g, S, E, F.tid, PROBE_EPI(pb + 2));
            if (BOTH(pb + 2)) GRID_BAR();
        }
        if (IN(pb + 3)) for (int rep_ = 0; rep_ < PROBE_REPS(pb + 3); ++rep_) { MKFRAME(); ws = F.ws;
            pg8::Gemm g{F.XB, lw(F, l, L_WQ), T, XAW, D}; pg8::StaticOrder S; S.init(T, XAW, F.G, (int)blockIdx.x);
            pg8::EpiPlain E{F.XQ, XAW, rs_prepare(F, S)};
            pg8::gemm_phase<pg8::EpiPlain, pg8::StaticOrder, PG8_ALIGN, PG8_SP2>(F.lds + RING_OFF, g, S, E, F.tid);
            VM_WAIT(); __syncthreads();
            __builtin_amdgcn_fence(__ATOMIC_ACQUIRE, "agent"); VM_WAIT(); __syncthreads();
            pg8::Unit u;
            for (int i = 0; S.next(i, u); ++i) for (int xr_ = 0; xr_ < PROBE_XA(pb + 3); ++xr_) xa_attn_unit(F, l, u.pm, u.pn);
            if (BOTH(pb + 3)) GRID_BAR();
        }
        if (IN(pb + 4)) for (int rep_ = 0; rep_ < PROBE_REPS(pb + 4); ++rep_) { MKFRAME(); ws = F.ws;
            constexpr bool f8 = MK_F8XO != 0;
            pg8::Gemm g{F.XO, lw(F, l, L_WO), T, D, f8 ? XAW / 2 : XAW}; pg8::StaticOrder S; S.init(T, D, F.G, (int)blockIdx.x);
            pg8::EpiResT<f8> E{nullptr, F.XB, nullptr, F.SSQ, D, f8 ? 1.0f / (F8_XOASCALE * F8_XOWSCALE) : 1.0f};
            pg8::gemm_phase<pg8::EpiResT<f8>, pg8::StaticOrder, PG8_ALIGN, PG8_SP2>(F.lds + RING_OFF, g, S, E, F.tid);
            if (BOTH(pb + 4)) GRID_BAR();
        }
        if (IN(pb + 5)) for (int rep_ = 0; rep_ < PROBE_REPS(pb + 5); ++rep_) { MKFRAME(); ws = F.ws;
            pg8::Gemm g{F.XB, lw(F, l, L_WGU), T, 2 * DFF, D}; pg8::StaticOrder S; S.init(T, 2 * DFF, F.G, (int)blockIdx.x);
            constexpr bool f8 = (MK_F8DN >> l) & 1;
            pg8::EpiSwigluT<f8> E{F.BIG, DFF, rs_prepare(F, S), F8_HSCALE};
            pg8::gemm_phase<pg8::EpiSwigluT<f8>, pg8::StaticOrder, PG8_ALIGN, PG8_SP2>(F.lds + RING_OFF, g, S, E, F.tid, PROBE_EPI(pb + 5));
            if (BOTH(pb + 5)) GRID_BAR();
        }
        if (IN(pb + 6)) for (int rep_ = 0; rep_ < PROBE_REPS(pb + 6); ++rep_) { MKFRAME(); ws = F.ws;
            constexpr bool f8 = (MK_F8DN >> l) & 1;
            pg8::Gemm g{F.BIG, lw(F, l, L_WD), T, D, f8 ? DFF / 2 : DFF}; pg8::StaticOrder S; S.init(T, D, F.G, (int)blockIdx.x);
            pg8::EpiResT<f8> E{nullptr, F.XB, l == 0 ? nullptr : F.out, F.SSQ, D, 1.0f / (F8_HSCALE * F8_WSCALE)};
            pg8::gemm_phase<pg8::EpiResT<f8>, pg8::StaticOrder, PG8_ALIGN, PG8_SP2>(F.lds + RING_OFF, g, S, E, F.tid);
            if (BOTH(pb + 6)) GRID_BAR();
        }
    }
__global__ void __launch_bounds__(NWAVES * 64, 2) mk_fwd(Args args) {
    extern __shared__ __attribute__((aligned(16))) unsigned char lds[];
    int wave_s = __builtin_amdgcn_readfirstlane((int)threadIdx.x >> 6); asm volatile("" : "+s"(wave_s));
    Frame F;
    MKFRAME();
    for (int u = F.tid; u < (LDS_BYTES - LDSCTL_OFF) / 4; u += NWAVES * 64) ((LAS unsigned*)(F.lds + LDSCTL_OFF))[u] = 0u;
    __syncthreads();
    if (N_LAUNCHES == 1) (void)xcd_barrier_post((unsigned*)(F.ctl + CW_BAR), F.MISC + 8, F.tid);
    const int lo = args.ph_lo, hi = args.ph_hi;
    if (IN(PH_PRO)) for (int rep_ = 0; rep_ < PROBE_REPS(PH_PRO); ++rep_) { MKFRAME(); p0_prologue(F); if (BOTH(PH_PRO)) GRID_BAR(); }
    layer_phases<0>(lo, hi, wave_s);
    layer_phases<1>(lo, hi, wave_s);
#ifdef PROBE_BARS
    for (int pb_ = 0; pb_ < PROBE_BARS; ++pb_) { MKFRAME(); GRID_BAR(); }
#endif
}
#undef MKFRAME
#undef IN
#undef BOTH
#undef GRID_BAR

extern "C" void kernel_launch(void* const* d_in, const int* in_sizes, int n_in, void* d_out, int out_size, void* d_ws, size_t ws_size, hipStream_t stream) {
    static int grid = 0;
    if (grid == 0) {
        if (n_in != 27 || in_sizes[0] != T * D || out_size != T * D || ws_size < WS_END) { fprintf(stderr, "kernel_launch: built for 27 inputs, x and out of %d floats, >= %zu bytes of workspace; got n_in %d, in0 %d, out %d, ws %zu; nothing launched\n", T * D, (size_t)WS_END, n_in, n_in > 0 ? in_sizes[0] : -1, out_size, ws_size); grid = -1; return; }
        int dev = 0, cus = 0, per_cu = 0;
        if (hipGetDevice(&dev) != hipSuccess || hipDeviceGetAttribute(&cus, hipDeviceAttributeMultiprocessorCount, dev) != hipSuccess) { fprintf(stderr, "kernel_launch: hipGetDevice / hipDeviceGetAttribute failed; nothing launched\n"); grid = -1; return; }
        if (hipFuncSetAttribute((const void*)mk_fwd, hipFuncAttributeMaxDynamicSharedMemorySize, LDS_BYTES) != hipSuccess) { fprintf(stderr, "kernel_launch: hipFuncSetAttribute failed\n"); grid = -1; return; }
        if (hipOccupancyMaxActiveBlocksPerMultiprocessor(&per_cu, (const void*)mk_fwd, NWAVES * 64, LDS_BYTES) != hipSuccess || per_cu < 1)
            fprintf(stderr, "kernel_launch: note: the occupancy query reports %d workgroups per CU\n", per_cu);
        (void)hipGetLastError();
        grid = cus;
        if (grid != 256) fprintf(stderr, "kernel_launch: %d CUs; the attention schedule is built for 256\n", grid);
    }
    if (grid < 0) return;
    if (hipMemsetAsync((char*)d_ws + WS_CTL, 0, CTL_ZERO_BYTES, stream) != hipSuccess) { fprintf(stderr, "kernel_launch: hipMemsetAsync of the control words failed; nothing launched\n"); return; }
    Args a{};
    for (int i = 0; i < 27; ++i) a.in[i] = (const float*)d_in[i];
    a.out = (float*)d_out; a.ws = (unsigned char*)d_ws;
    for (int li = 0; li < N_LAUNCHES; ++li) {
        a.ph_lo = (N_LAUNCHES == 1) ? 0 : li; a.ph_hi = (N_LAUNCHES == 1) ? N_PHASES : li + 1; a.li = li;
        hipLaunchKernelGGL(mk_fwd, dim3(grid), dim3(NWAVES * 64), LDS_BYTES, stream, a);
        const hipError_t le = hipPeekAtLastError();
        if (le != hipSuccess) { fprintf(stderr, "kernel_launch: launch %d failed: %s\n", li, hipGetErrorName(le)); break; }
    }
}
```

```cpp
#include <hip/hip_runtime.h>
#include <cstdio>
#include <cstdint>
namespace pg8 {
#define PG8_LAS __attribute__((address_space(3)))
typedef unsigned short bf16_t;
typedef short bf16x8 __attribute__((ext_vector_type(8)));
typedef float f32x4 __attribute__((ext_vector_type(4)));
typedef float f32x2 __attribute__((ext_vector_type(2)));
typedef unsigned u32x4 __attribute__((ext_vector_type(4)));
typedef unsigned u32x2 __attribute__((ext_vector_type(2)));
typedef int i32x4 __attribute__((ext_vector_type(4)));
typedef int i32x8 __attribute__((ext_vector_type(8)));
constexpr int BM = 256, BK = 64, HALF = 128, HTB = HALF * BK * 2  , STAGE_BYTES = 8 * HTB, NXCD = 8, WGM = 8;

__host__ __device__ __forceinline__ int lds_byte(int r, int c) { const int st = (r >> 4) * 2 + (c >> 5), rr = r & 15, cc = c & 31, ob = rr * 64 + cc * 2; return st * 1024 + (ob ^ (((ob >> 9) & 1) << 5)); }
__host__ __device__ __forceinline__ void stage_rc(int b, int& R, int& C) { const int st = b / 1024, sb = b % 1024, swz = sb ^ (((sb >> 9) & 1) << 5); R = (st >> 1) * 16 + swz / 64; C = (st & 1) * 32 + (swz % 64) / 2; }
__host__ __device__ __forceinline__ int perm32(int rho) { const int n = rho >> 4, i = rho & 15; return 8 * (i >> 2) + 4 * n + (i & 3); }

struct Unit { int pm, pn; };
struct Gemm { const bf16_t* A; const bf16_t* Bt; int M, N, K; };

struct StaticOrder {
    int nM, nN, nwg, G, c;
    __host__ __device__ __forceinline__ void init(int M, int N, int G_, int c_) { nM = M / BM; nN = N / BM; nwg = nM * nN; G = G_; c = c_; }
    __host__ __device__ __forceinline__ bool next(int i, Unit& u) const {
        const long L = (long)i * G + c; if (L >= nwg) return false;
        int wgid = (int)L; { const int q = nwg / NXCD, r = nwg % NXCD, xcd = wgid % NXCD, off = wgid / NXCD; wgid = (xcd < r ? xcd * (q + 1) : r * (q + 1) + (xcd - r) * q) + off; }
        const int nig = WGM * nN, gid = wgid / nig, fm = gid * WGM, gsz = (nM - fm) < WGM ? (nM - fm) : WGM;
        u.pm = fm + ((wgid % nig) % gsz); u.pn = (wgid % nig) / gsz; return true;
    }
    __device__ __forceinline__ void a_ready(const Unit&) const {}
    __device__ __forceinline__ void done(const Unit&) const {}
};
struct OneUnit { Unit u;
    __device__ __forceinline__ bool next(int i, Unit& o) const { if (i != 0) return false; o = u; return true; }
    __device__ __forceinline__ void a_ready(const Unit&) const {}
    __device__ __forceinline__ void done(const Unit&) const {}
};

__device__ __forceinline__ unsigned cvt_pk_bf16(float lo, float hi) { unsigned r; asm volatile("v_cvt_pk_bf16_f32 %0, %1, %2" : "=v"(r) : "v"(lo), "v"(hi)); return r; }
__device__ __forceinline__ u32x4 pack8(const f32x4 a, const f32x4 b) { u32x4 w; w.x = cvt_pk_bf16(a[0], a[1]); w.y = cvt_pk_bf16(a[2], a[3]); w.z = cvt_pk_bf16(b[0], b[1]); w.w = cvt_pk_bf16(b[2], b[3]); return w; }
constexpr float RMS_EPS = 1e-6f;
__device__ __forceinline__ float row_rstd(const float* ssq, int row) {
    const f32x4* p = (const f32x4*)(ssq + (size_t)row * 16);
    const f32x4 a = p[0], b = p[1], c = p[2], d = p[3];
    const float s = (((a[0] + a[1]) + (a[2] + a[3])) + ((b[0] + b[1]) + (b[2] + b[3]))) + (((c[0] + c[1]) + (c[2] + c[3])) + ((d[0] + d[1]) + (d[2] + d[3])));
    return __builtin_amdgcn_rsqf(s * (1.0f / 1024.0f) + RMS_EPS);
}
struct RsTab { const PG8_LAS float* t;
    __device__ __forceinline__ int slot(int pm) const { int s = 0;
#pragma unroll
        for (int k = 1; k < 4; ++k) s = (__builtin_bit_cast(int, t[k]) == pm) ? k : s; return s; }
    __device__ __forceinline__ float get(int slot, int r) const { return t[16 + 256 * slot + r]; }
};
__device__ __forceinline__ void ssq4(f32x2& s2, const f32x4 x) { const f32x2 lo = {x[0], x[1]}, hi = {x[2], x[3]}; s2 += lo * lo; s2 += hi * hi; }
__device__ __forceinline__ float sigmoid_fast(float t) { return __builtin_amdgcn_rcpf(1.0f + __builtin_amdgcn_exp2f(-1.4426950408889634f * t)); }
__device__ __forceinline__ float gelu_tanh(float x) { const float t = 1.5957691216057308f * (x + 0.044715f * x * x * x); return x * sigmoid_fast(t); }
__device__ __forceinline__ float silu_f(float x) { return x * sigmoid_fast(x); }

struct EpiPlain {
    static constexpr bool PERM = true, AFTER_DRAIN = false, F8 = false; static constexpr int NVM = 16;
    bf16_t* O; int ldc; const PG8_LAS float* rst;
    __device__ __forceinline__ void operator()(const f32x4 (&acc)[2][2][4][2], const Unit& u, int wr, int wc, int fr, int fq) const {
        const int row0 = u.pm * BM + wr * 64 + fr, col0 = u.pn * BM + wc * 32 + 8 * fq;
        const RsTab R{rst}; const int rsl = rst ? R.slot(u.pm) : 0;
#pragma unroll
        for (int ai = 0; ai < 2; ++ai)
#pragma unroll
            for (int m = 0; m < 4; ++m) { const int row = row0 + ai * HALF + m * 16; const float rs = rst ? R.get(rsl, ai * HALF + wr * 64 + m * 16 + fr) : 1.0f; bf16_t* rowp = O + (size_t)row * ldc + col0;
#pragma unroll
                for (int bj = 0; bj < 2; ++bj) *(u32x4*)(rowp + bj * HALF) = pack8(acc[ai][bj][m][0] * rs, acc[ai][bj][m][1] * rs); }
    }
};
struct EpiIn0 {
    static constexpr bool PERM = true, AFTER_DRAIN = false, F8 = false; static constexpr int NVM = 16;
    bf16_t* O; int ldc; const PG8_LAS float* rst; const float* gq; const float* gk; float qscale;
    __device__ __forceinline__ void operator()(const f32x4 (&acc)[2][2][4][2], const Unit& u, int wr, int wc, int fr, int fq) const {
        const int row0 = u.pm * BM + wr * 64 + fr; const int pn = u.pn;
        const bool headed = (pn >= 4 && pn < 8);
        const RsTab R{rst}; const int rsl = R.slot(u.pm);
        f32x4 gn[2][2];
#pragma unroll
        for (int bj = 0; bj < 2; ++bj)
#pragma unroll
            for (int n = 0; n < 2; ++n) { gn[bj][n] = (f32x4){1.f, 1.f, 1.f, 1.f};
                if (pn == 4 || pn == 5) { const int d = 32 * bj + 8 * fq + 4 * n; const f32x4 a = *(const f32x4*)(gq + d), b = *(const f32x4*)(gk + d); gn[bj][n] = a * b * qscale; } }
#pragma unroll
        for (int ai = 0; ai < 2; ++ai)
#pragma unroll
            for (int m = 0; m < 4; ++m) { const int row = row0 + ai * HALF + m * 16; const float rs = R.get(rsl, ai * HALF + wr * 64 + m * 16 + fr);
                f32x4 v[2][2];
#pragma unroll
                for (int bj = 0; bj < 2; ++bj)
#pragma unroll
                    for (int n = 0; n < 2; ++n) v[bj][n] = acc[ai][bj][m][n] * rs;
                if (pn < 4) {
#pragma unroll
                    for (int bj = 0; bj < 2; ++bj)
#pragma unroll
                        for (int n = 0; n < 2; ++n) { const f32x4 x = v[bj][n]; const f32x4 in = (x * x) * 0.044715f + 1.0f; const f32x4 tt = (x * in) * (-1.5957691216057308f * 1.4426950408889634f);
                            f32x4 ex;
#pragma unroll
                            for (int e = 0; e < 4; ++e) ex[e] = __builtin_amdgcn_exp2f(tt[e]);
                            const f32x4 d = ex + 1.0f; f32x4 r;
#pragma unroll
                            for (int e = 0; e < 4; ++e) r[e] = __builtin_amdgcn_rcpf(d[e]);
                            v[bj][n] = x * r; }
                } else if (headed) {
                    f32x2 s2 = {0.f, 0.f};
#pragma unroll
                    for (int bj = 0; bj < 2; ++bj)
#pragma unroll
                        for (int n = 0; n < 2; ++n) ssq4(s2, v[bj][n]);
                    float ss = s2[0] + s2[1];
                    ss += __shfl_xor(ss, 16); ss += __shfl_xor(ss, 32);
                    const float r = __builtin_amdgcn_rsqf(ss * (1.0f / 64.0f) + RMS_EPS);
#pragma unroll
                    for (int bj = 0; bj < 2; ++bj)
#pragma unroll
                        for (int n = 0; n < 2; ++n) v[bj][n] = v[bj][n] * r * gn[bj][n];
                }
                bf16_t* rowp = O + (size_t)row * ldc + pn * BM + 8 * fq;
#pragma unroll
                for (int bj = 0; bj < 2; ++bj) { const int c = headed ? (64 * wc + 32 * bj) : (128 * bj + 32 * wc); *(u32x4*)(rowp + c) = pack8(v[bj][0], v[bj][1]); } }
    }
};
struct EpiIn1 {
    static constexpr bool PERM = true, AFTER_DRAIN = false, F8 = false; static constexpr int NVM = 8;
    bf16_t* O; int ldc; const PG8_LAS float* rst;
    __device__ __forceinline__ void operator()(const f32x4 (&acc)[2][2][4][2], const Unit& u, int wr, int wc, int fr, int fq) const {
        const int row0 = u.pm * BM + wr * 64 + fr; const int pn = u.pn;
        const RsTab R{rst}; const int rsl = R.slot(u.pm);
        const bool pair = (pn >= 2 && pn < 6);
        const int cbase = pair ? 512 + 128 * (pn - 2) + wc * 32 + 8 * fq : (pn < 2 ? 256 * pn : 1024 + 256 * (pn - 6)) + wc * 32 + 8 * fq;
#pragma unroll
        for (int ai = 0; ai < 2; ++ai)
#pragma unroll
            for (int m = 0; m < 4; ++m) { const int row = row0 + ai * HALF + m * 16; const float rs = R.get(rsl, ai * HALF + wr * 64 + m * 16 + fr); bf16_t* rowp = O + (size_t)row * ldc + cbase;
                if (pair) { const float r2 = rs * rs; *(u32x4*)rowp = pack8(acc[ai][0][m][0] * acc[ai][1][m][0] * r2, acc[ai][0][m][1] * acc[ai][1][m][1] * r2); }
                else {
#pragma unroll
                    for (int bj = 0; bj < 2; ++bj) *(u32x4*)(rowp + bj * HALF) = pack8(acc[ai][bj][m][0] * rs, acc[ai][bj][m][1] * rs); } }
    }
};
__device__ __forceinline__ float clamp_f8(float v) { return __builtin_amdgcn_fmed3f(v, -448.0f, 448.0f); }
__device__ __forceinline__ unsigned pk4_f8(float a, float b, float c, float d) { int r = __builtin_amdgcn_cvt_pk_fp8_f32(clamp_f8(a), clamp_f8(b), 0, false); r = __builtin_amdgcn_cvt_pk_fp8_f32(clamp_f8(c), clamp_f8(d), r, true); return (unsigned)r; }
template <bool OUT8> struct EpiSwigluT {
    static constexpr bool PERM = true, AFTER_DRAIN = false, F8 = false; static constexpr int NVM = 8;
    bf16_t* O; int ldc; const PG8_LAS float* rst; float hscale;
    __device__ __forceinline__ void operator()(const f32x4 (&acc)[2][2][4][2], const Unit& u, int wr, int wc, int fr, int fq) const {
        const int row0 = u.pm * BM + wr * 64 + fr, col0 = u.pn * HALF + wc * 32 + 8 * fq;
        const RsTab R{rst}; const int rsl = R.slot(u.pm);
#pragma unroll
        for (int ai = 0; ai < 2; ++ai)
#pragma unroll
            for (int m = 0; m < 4; ++m) { const int row = row0 + ai * HALF + m * 16; const float rs = R.get(rsl, ai * HALF + wr * 64 + m * 16 + fr);
                const float c1 = -1.4426950408889634f * rs, rs2 = OUT8 ? rs * rs * hscale : rs * rs;
                f32x4 o[2];
#pragma unroll
                for (int n = 0; n < 2; ++n) { const f32x4 g = acc[ai][0][m][n], up = acc[ai][1][m][n];
                    const f32x4 t = g * c1; f32x4 ex;
#pragma unroll
                    for (int e = 0; e < 4; ++e) ex[e] = __builtin_amdgcn_exp2f(t[e]);
                    const f32x4 d = ex + 1.0f; f32x4 r;
#pragma unroll
                    for (int e = 0; e < 4; ++e) r[e] = __builtin_amdgcn_rcpf(d[e]);
                    o[n] = ((g * up) * rs2) * r; }
                if constexpr (OUT8) { u32x2 w; w.x = pk4_f8(o[0][0], o[0][1], o[0][2], o[0][3]); w.y = pk4_f8(o[1][0], o[1][1], o[1][2], o[1][3]);
                    __builtin_nontemporal_store(w, (u32x2*)((unsigned char*)O + (size_t)row * ldc + col0)); }
                else __builtin_nontemporal_store(pack8(o[0], o[1]), (u32x4*)(O + (size_t)row * ldc + col0)); }
    }
};
__device__ __forceinline__ f32x4 bf_lo4(const u32x4 w) { return (f32x4){__builtin_bit_cast(float, w.x << 16), __builtin_bit_cast(float, w.x & 0xffff0000u), __builtin_bit_cast(float, w.y << 16), __builtin_bit_cast(float, w.y & 0xffff0000u)}; }
__device__ __forceinline__ f32x4 bf_hi4(const u32x4 w) { return (f32x4){__builtin_bit_cast(float, w.z << 16), __builtin_bit_cast(float, w.z & 0xffff0000u), __builtin_bit_cast(float, w.w << 16), __builtin_bit_cast(float, w.w & 0xffff0000u)}; }
typedef __bf16 bf16x2_t __attribute__((ext_vector_type(2)));
__device__ __forceinline__ float dot2bf(unsigned w, float c) { const bf16x2_t v = __builtin_bit_cast(bf16x2_t, w); return __builtin_amdgcn_fdot2_f32_bf16(v, v, c, false); }
template <bool F8_> struct EpiResT {
    static constexpr bool PERM = true, AFTER_DRAIN = false, F8 = F8_; static constexpr int NVM = 16;
    const float* base32; bf16_t* xb; float* out32; float* ssq; int ldc; float ascale;
    __device__ __forceinline__ void operator()(const f32x4 (&acc)[2][2][4][2], const Unit& u, int wr, int wc, int fr, int fq) const {
        const int row0 = u.pm * BM + wr * 64 + fr, col0 = u.pn * BM + wc * 32 + 8 * fq;
        u32x4 pre[2][4][2];
        if (!base32) {
#pragma unroll
            for (int ai = 0; ai < 2; ++ai)
#pragma unroll
                for (int m = 0; m < 4; ++m)
#pragma unroll
                    for (int bj = 0; bj < 2; ++bj) pre[ai][m][bj] = *(const u32x4*)(xb + (size_t)(row0 + ai * HALF + m * 16) * ldc + col0 + bj * HALF);
        }
#pragma unroll
        for (int ai = 0; ai < 2; ++ai) {
#pragma unroll
            for (int m = 0; m < 4; ++m) { const int row = row0 + ai * HALF + m * 16; const size_t off = (size_t)row * ldc + col0;
                f32x4 v[2][2]; float ss = 0.f;
#pragma unroll
                for (int bj = 0; bj < 2; ++bj) {
                    f32x4 b0, b1;
                    if (base32) { b0 = *(const f32x4*)(base32 + off + bj * HALF); b1 = *(const f32x4*)(base32 + off + bj * HALF + 4); }
                    else { b0 = bf_lo4(pre[ai][m][bj]); b1 = bf_hi4(pre[ai][m][bj]); }
                    if constexpr (F8_) { v[bj][0] = b0 + acc[ai][bj][m][0] * ascale; v[bj][1] = b1 + acc[ai][bj][m][1] * ascale; } else { v[bj][0] = b0 + acc[ai][bj][m][0]; v[bj][1] = b1 + acc[ai][bj][m][1]; }
                }
                if (out32) {
#pragma unroll
                    for (int bj = 0; bj < 2; ++bj) { *(f32x4*)(out32 + off + bj * HALF) = v[bj][0]; *(f32x4*)(out32 + off + bj * HALF + 4) = v[bj][1]; }
                } else {
                    float sq = 0.f;
#pragma unroll
                    for (int bj = 0; bj < 2; ++bj) { const u32x4 w = pack8(v[bj][0], v[bj][1]); *(u32x4*)(xb + off + bj * HALF) = w;
                        sq = dot2bf(w.x, sq); sq = dot2bf(w.y, sq); sq = dot2bf(w.z, sq); sq = dot2bf(w.w, sq); }
                    ss = sq;
                    ss += __shfl_xor(ss, 16); ss += __shfl_xor(ss, 32);
                    if (fq == 0) ssq[(size_t)row * 16 + 4 * u.pn + wc] = ss; }
            }
            asm volatile("" ::: "memory");
        }
    }
};
using EpiRes = EpiResT<false>;

#ifndef PG8_ZOPAQUE
#define PG8_ZOPAQUE 1
#endif
#ifndef PG8_F8SCALE
#define PG8_F8SCALE 0
#endif
__device__ __forceinline__ i32x8 cat8(const bf16x8 a, const bf16x8 b) { const i32x4 x = __builtin_bit_cast(i32x4, a), y = __builtin_bit_cast(i32x4, b); return __builtin_shufflevector(x, y, 0, 1, 2, 3, 4, 5, 6, 7); }
template <class Epi, class Sched, bool ALIGN_EPI = false, bool SP2 = false>
__device__ __forceinline__ void gemm_phase(PG8_LAS unsigned char* lds, const Gemm g, const Sched& S, const Epi& E, const int tid_in, const int epi_reps = 1) {
    int tid_ = tid_in; asm volatile("" : "+v"(tid_));
    const int tid = tid_, wid = __builtin_amdgcn_readfirstlane(tid >> 6), lane = tid & 63, wr = wid >> 2, wc = wid & 3, fr = lane & 15, fq = lane >> 4;
    const int K = g.K, nt = K / BK;
    unsigned voffA[2], voffB[2];
#pragma unroll
    for (int i = 0; i < 2; ++i) { int R, C; stage_rc(tid * 16 + i * 8192, R, C); const int Rb = Epi::PERM ? ((R & ~31) + perm32(R & 31)) : R;
        voffA[i] = (unsigned)(R * K + C) * 2u; voffB[i] = (unsigned)(Rb * K + C) * 2u; }
    const size_t kstep = (size_t)(BK * 2);
    const size_t hstep = (size_t)HALF * K * 2;
    const size_t tstep = 2 * hstep;
    const unsigned ldsw = (unsigned)wid * 1024u;
    const unsigned ldsb = (unsigned)__builtin_amdgcn_readfirstlane((int)((unsigned)(uintptr_t)lds + ldsw));
    const int aoff = lds_byte(wr * 64 + fr, fq * 8), boff = lds_byte(wc * 32 + fr, fq * 8);
#define PG8_SA(b, h) (((b) * 2 + (h)) * HTB)
#define PG8_SB(b, h) ((4 + (b) * 2 + (h)) * HTB)
#define PG8_STAGE(bufoff, gbase, voff) do { _Pragma("unroll") for (int _i = 0; _i < 2; ++_i) { unsigned keep_; \
        asm volatile("s_nop 4\n\ts_mov_b32 %0, m0\n\ts_mov_b32 m0, %2\n\ts_nop 0\n\tglobal_load_lds_dwordx4 %1, %3\n\ts_mov_b32 m0, %0" : "=&s"(keep_) \
            : "v"((voff)[_i]), "s"(ldsb + (unsigned)((bufoff) + _i * 8192)), "s"((const char*)(gbase)) : "memory"); } } while (0)
#define PG8_LDA(dst, b, h) do { _Pragma("unroll") for (int m = 0; m < 4; ++m) _Pragma("unroll") for (int k = 0; k < 2; ++k) dst[m][k] = *(const PG8_LAS bf16x8*)(lds + PG8_SA(b, h) + aoff + m * 2048 + k * 1024); } while (0)
#define PG8_LDB(dst, b, h) do { _Pragma("unroll") for (int n = 0; n < 2; ++n) _Pragma("unroll") for (int k = 0; k < 2; ++k) dst[n][k] = *(const PG8_LAS bf16x8*)(lds + PG8_SB(b, h) + boff + n * 2048 + k * 1024); } while (0)
#define PG8_MMA(ai, bj, At, Bt) do { __builtin_amdgcn_s_setprio(1); _Pragma("unroll") for (int m = 0; m < 4; ++m) _Pragma("unroll") for (int n = 0; n < 2; ++n) { \
        if constexpr (Epi::F8) acc[ai][bj][m][n] = __builtin_amdgcn_mfma_scale_f32_16x16x128_f8f6f4(cat8(Bt[n][0], Bt[n][1]), cat8(At[m][0], At[m][1]), acc[ai][bj][m][n], 0, 0, 0, PG8_F8SCALE, 0, PG8_F8SCALE); \
        else { _Pragma("unroll") for (int k = 0; k < 2; ++k) acc[ai][bj][m][n] = __builtin_amdgcn_mfma_f32_16x16x32_bf16(Bt[n][k], At[m][k], acc[ai][bj][m][n], 0, 0, 0); } } __builtin_amdgcn_s_setprio(0); } while (0)
#define PG8_WAIT_V(n) asm volatile("s_waitcnt vmcnt(" #n ")" ::: "memory")
#define PG8_WAIT_L(n) asm volatile("s_waitcnt lgkmcnt(" #n ")" ::: "memory")
#define PG8_WAIT_VF() asm volatile("s_waitcnt vmcnt(%0)" :: "n"(8 + Epi::NVM) : "memory")
#define PG8_TRIP_SP2(W12) do { \
            PG8_LDB(B0, 0, 0); PG8_LDB(B1, 0, 1); PG8_SCHED; PG8_LDA(At, 0, 0); PG8_STAGE(PG8_SA(1, 1), a1 + hstep, voffA); \
            W12; PG8_WAIT_L(0); PG8_BAR; PG8_MMA(0, 0, At, B0); PG8_MMA(0, 1, At, B1); PG8_BAR; PG8_SCHED; \
            PG8_LDA(At, 0, 1); PG8_STAGE(PG8_SB(0, 0), b2, voffB); PG8_STAGE(PG8_SB(0, 1), b2 + hstep, voffB); PG8_STAGE(PG8_SA(0, 0), a2, voffA); \
            W12; PG8_WAIT_L(0); PG8_BAR; PG8_MMA(1, 0, At, B0); PG8_MMA(1, 1, At, B1); PG8_BAR; PG8_SCHED; \
            PG8_LDB(B0, 1, 0); PG8_LDB(B1, 1, 1); PG8_SCHED; PG8_LDA(At, 1, 0); PG8_STAGE(PG8_SA(0, 1), a2 + hstep, voffA); \
            PG8_WAIT_V(8); PG8_WAIT_L(0); PG8_BAR; PG8_MMA(0, 0, At, B0); PG8_MMA(0, 1, At, B1); PG8_BAR; PG8_SCHED; \
            PG8_LDA(At, 1, 1); PG8_STAGE(PG8_SB(1, 0), b3, voffB); PG8_STAGE(PG8_SB(1, 1), b3 + hstep, voffB); PG8_STAGE(PG8_SA(1, 0), a3, voffA); \
            PG8_WAIT_V(8); PG8_WAIT_L(0); PG8_BAR; PG8_MMA(1, 0, At, B0); PG8_MMA(1, 1, At, B1); PG8_BAR; PG8_SCHED; } while (0)
#define PG8_BAR __builtin_amdgcn_s_barrier()
#define PG8_SCHED __builtin_amdgcn_sched_barrier(0)
    Unit cur, nxt; int ui = 0;
    if (!S.next(0, cur)) return;
    f32x4 acc[2][2][4][2];
#pragma unroll
    for (int a = 0; a < 2; ++a)
#pragma unroll
        for (int b = 0; b < 2; ++b)
#pragma unroll
            for (int m = 0; m < 4; ++m)
#pragma unroll
                for (int n = 0; n < 2; ++n) acc[a][b][m][n] = (f32x4){0.f, 0.f, 0.f, 0.f};
    bf16x8 At[4][2], B0[2][2], B1[2][2];
    const char* cA = (const char*)g.A + (size_t)cur.pm * tstep; const char* cB = (const char*)g.Bt + (size_t)cur.pn * tstep;
    S.a_ready(cur);
    if constexpr (SP2) {
        PG8_STAGE(PG8_SB(0, 0), cB, voffB); PG8_STAGE(PG8_SB(0, 1), cB + hstep, voffB); PG8_STAGE(PG8_SA(0, 0), cA, voffA); PG8_STAGE(PG8_SA(0, 1), cA + hstep, voffA);
        if (wr == 1) PG8_BAR;
        PG8_WAIT_V(2); PG8_BAR;
        PG8_STAGE(PG8_SB(1, 0), cB + kstep, voffB); PG8_STAGE(PG8_SA(1, 0), cA + kstep, voffA); PG8_STAGE(PG8_SB(1, 1), cB + hstep + kstep, voffB);
        PG8_WAIT_V(6); PG8_BAR;
    } else {
        PG8_STAGE(PG8_SB(0, 0), cB, voffB); PG8_STAGE(PG8_SA(0, 0), cA, voffA); PG8_STAGE(PG8_SB(0, 1), cB + hstep, voffB); PG8_STAGE(PG8_SA(0, 1), cA + hstep, voffA);
        if (wr == 1) PG8_BAR;
        PG8_WAIT_V(4); PG8_BAR;
        PG8_STAGE(PG8_SB(1, 0), cB + kstep, voffB); PG8_STAGE(PG8_SA(1, 0), cA + kstep, voffA); PG8_STAGE(PG8_SB(1, 1), cB + hstep + kstep, voffB);
        PG8_WAIT_V(6); PG8_BAR;
    }
    for (;;) {
        const bool has_next = S.next(ui + 1, nxt);
        const char* nA = has_next ? (const char*)g.A + (size_t)nxt.pm * tstep : cA; const char* nB = has_next ? (const char*)g.Bt + (size_t)nxt.pn * tstep : cB;
        int t = 0;
        if constexpr (SP2) { if (ui > 0) {
            const char* a1 = cA + kstep; const char* a2 = cA + 2 * kstep; const char* b2 = cB + 2 * kstep; const char* a3 = a2 + kstep; const char* b3 = b2 + kstep;
            PG8_TRIP_SP2(PG8_WAIT_VF()); t = 2; } }
        for (; t < nt; t += 2) {
            const bool last = (t == nt - 2);
            const char* a1 = cA + (size_t)(t + 1) * kstep;
            const char* a2 = last ? nA : cA + (size_t)(t + 2) * kstep; const char* b2 = last ? nB : cB + (size_t)(t + 2) * kstep;
            const char* a3 = a2 + kstep; const char* b3 = b2 + kstep;
            if (last && has_next) S.a_ready(nxt);
            if constexpr (SP2) {
            PG8_LDB(B0, 0, 0); PG8_LDB(B1, 0, 1); PG8_SCHED; PG8_LDA(At, 0, 0); PG8_STAGE(PG8_SA(1, 1), a1 + hstep, voffA);
            PG8_WAIT_V(8); PG8_WAIT_L(0); PG8_BAR; PG8_MMA(0, 0, At, B0); PG8_MMA(0, 1, At, B1); PG8_BAR; PG8_SCHED;
            PG8_LDA(At, 0, 1); PG8_STAGE(PG8_SB(0, 0), b2, voffB); PG8_STAGE(PG8_SB(0, 1), b2 + hstep, voffB); PG8_STAGE(PG8_SA(0, 0), a2, voffA);
            PG8_WAIT_V(8); PG8_WAIT_L(0); PG8_BAR; PG8_MMA(1, 0, At, B0); PG8_MMA(1, 1, At, B1); PG8_BAR; PG8_SCHED;
            PG8_LDB(B0, 1, 0); PG8_LDB(B1, 1, 1); PG8_SCHED; PG8_LDA(At, 1, 0); PG8_STAGE(PG8_SA(0, 1), a2 + hstep, voffA);
            PG8_WAIT_V(8); PG8_WAIT_L(0); PG8_BAR; PG8_MMA(0, 0, At, B0); PG8_MMA(0, 1, At, B1); PG8_BAR; PG8_SCHED;
            PG8_LDA(At, 1, 1); PG8_STAGE(PG8_SB(1, 0), b3, voffB); PG8_STAGE(PG8_SB(1, 1), b3 + hstep, voffB); PG8_STAGE(PG8_SA(1, 0), a3, voffA);
            PG8_WAIT_V(8); PG8_WAIT_L(0); PG8_BAR; PG8_MMA(1, 0, At, B0); PG8_MMA(1, 1, At, B1); PG8_BAR; PG8_SCHED;
            } else {
            PG8_LDB(B0, 0, 0); PG8_SCHED; PG8_LDA(At, 0, 0); PG8_STAGE(PG8_SA(1, 1), a1 + hstep, voffA);
            PG8_WAIT_L(8); PG8_BAR; PG8_WAIT_L(0); PG8_MMA(0, 0, At, B0); PG8_BAR; PG8_SCHED;
            PG8_LDB(B1, 0, 1); PG8_STAGE(PG8_SB(0, 0), b2, voffB);
            PG8_BAR; PG8_WAIT_L(0); PG8_MMA(0, 1, At, B1); PG8_BAR;
            PG8_LDA(At, 0, 1); PG8_STAGE(PG8_SA(0, 0), a2, voffA);
            PG8_BAR; PG8_WAIT_L(0); PG8_MMA(1, 0, At, B0); PG8_BAR; PG8_SCHED;
            PG8_STAGE(PG8_SB(0, 1), b2 + hstep, voffB);
            PG8_WAIT_V(6); PG8_BAR; PG8_MMA(1, 1, At, B1); PG8_BAR;
            PG8_LDB(B0, 1, 0); PG8_SCHED; PG8_LDA(At, 1, 0); PG8_STAGE(PG8_SA(0, 1), a2 + hstep, voffA);
            PG8_WAIT_L(8); PG8_BAR; PG8_WAIT_L(0); PG8_MMA(0, 0, At, B0); PG8_BAR; PG8_SCHED;
            PG8_LDB(B1, 1, 1); PG8_STAGE(PG8_SB(1, 0), b3, voffB);
            PG8_BAR; PG8_WAIT_L(0); PG8_MMA(0, 1, At, B1); PG8_BAR;
            PG8_LDA(At, 1, 1); PG8_STAGE(PG8_SA(1, 0), a3, voffA);
            PG8_BAR; PG8_WAIT_L(0); PG8_MMA(1, 0, At, B0); PG8_BAR; PG8_SCHED;
            PG8_STAGE(PG8_SB(1, 1), b3 + hstep, voffB);
            PG8_WAIT_V(6); PG8_BAR; PG8_MMA(1, 1, At, B1); PG8_BAR;
            }
        }
        if constexpr (ALIGN_EPI) { if (wr == 0) PG8_BAR; }
        if constexpr (!Epi::AFTER_DRAIN) { int ln_; asm volatile("v_mbcnt_lo_u32_b32 %0, -1, 0\n\tv_mbcnt_hi_u32_b32 %0, -1, %0" : "=v"(ln_)); const int fr_ = ln_ & 15, fq_ = ln_ >> 4;
            for (int er_ = 0; er_ < epi_reps; ++er_) E(acc, cur, wr, wc, fr_, fq_); S.done(cur); }
        if (!has_next) break;
        { float z_ = 0.f; if (PG8_ZOPAQUE) asm volatile("" : "+v"(z_));
#pragma unroll
        for (int a = 0; a < 2; ++a)
#pragma unroll
            for (int b = 0; b < 2; ++b)
#pragma unroll
                for (int m = 0; m < 4; ++m)
#pragma unroll
                    for (int n = 0; n < 2; ++n) acc[a][b][m][n] = (f32x4){z_, z_, z_, z_}; }
        cur = nxt; cA = nA; cB = nB; ++ui;
        if constexpr (ALIGN_EPI) { if (wr == 1) PG8_BAR; }
    }
    PG8_WAIT_V(0);
    if constexpr (!ALIGN_EPI) { if (wr == 0) PG8_BAR; }
    PG8_BAR;
    if constexpr (Epi::AFTER_DRAIN) { E.fused(acc, cur, wr, wc, fr, fq, lds, wid, lane); S.done(cur); }
#undef PG8_SA
#undef PG8_SB
#undef PG8_STAGE
#undef PG8_LDA
#undef PG8_LDB
#undef PG8_MMA
#undef PG8_WAIT_V
#undef PG8_WAIT_L
#undef PG8_WAIT_VF
#undef PG8_TRIP_SP2
#undef PG8_BAR
#undef PG8_SCHED
}
}

#ifndef PG8_SP2
#define PG8_SP2 true
#endif
#ifndef PG8_ALIGN
#define PG8_ALIGN true
#endif
#include <hip/hip_bf16.h>
#include <cmath>
namespace attn_body {
using bf16=__hip_bfloat16;
using bf16x8=__attribute__((ext_vector_type(8)))short;
using s16x4=__attribute__((ext_vector_type(4)))short;
using f32x16=__attribute__((ext_vector_type(16)))float;
using u32x4=__attribute__((ext_vector_type(4)))unsigned;
constexpr int BATCH=4,NHEAD=8,SEQ=8192,D=64,PQ=2560,PO=1024;
constexpr int NW=8,QBLK=32,QB=QBLK*NW,KVBLK=64,NQB=SEQ/QB;
constexpr int ATTN_UNIT_ROWS=QB;
__device__ __forceinline__ int crow(int r,int hi){return (r&3)+8*(r>>2)+4*hi;}
#define SBAR() __builtin_amdgcn_sched_barrier(0)
__device__ __forceinline__ void cmask(f32x16&p0,f32x16&p1,int jb,int qrel,int hi){
  const float NEG=-INFINITY; int kb=64*jb+4*hi;
  #pragma unroll
  for(int r=0;r<16;++r){int kv=kb+(r&3)+8*(r>>2); if(kv>qrel)p0[r]=NEG; if(kv+32>qrel)p1[r]=NEG;}
}

constexpr int NSLOT=3, SLOTB=8192;
constexpr int LDS_K=0, LDS_V=NSLOT*SLOTB, LDS_WS=2*NSLOT*SLOTB, LDS_OST=LDS_WS+NW*64*4, LDS_CT=LDS_OST+NW*4096+2048, LDS_BYTES=LDS_CT+SEQ*4;
constexpr float C2=0.125f*1.4426950408889634f;
__device__ __forceinline__ void glds16(const void*sbase,unsigned voff,unsigned lds_dst){unsigned keep;
  asm volatile("s_nop 4\n\ts_mov_b32 %0, m0\n\ts_mov_b32 m0, %2\n\ts_nop 0\n\tglobal_load_lds_dwordx4 %1, %3\n\ts_mov_b32 m0, %0":"=&s"(keep):"v"(voff),"s"(lds_dst),"s"(sbase):"memory");}
__device__ __forceinline__ float max3f(float a,float b,float c){float r;asm("v_max3_f32 %0, %1, %2, %3":"=v"(r):"v"(a),"v"(b),"v"(c));return r;}
__device__ __forceinline__ float max2f(float a,float b){float r;asm("v_max_f32_e32 %0, %1, %2":"=v"(r):"v"(a),"v"(b));return r;}
__device__ __forceinline__ float fadd_s(float a,float b){float r;asm("v_add_f32_e32 %0, %1, %2":"=v"(r):"v"(a),"v"(b));return r;}
__device__ __forceinline__ float fsub_s(float a,float b){float r;asm("v_sub_f32_e32 %0, %1, %2":"=v"(r):"v"(a),"v"(b));return r;}
typedef float f32x2_t __attribute__((ext_vector_type(2))); typedef float f32x4_t __attribute__((ext_vector_type(4))); typedef __bf16 bf16x2_t __attribute__((ext_vector_type(2)));
__device__ __forceinline__ unsigned cvtpk_s(float lo,float hi){f32x2_t v={lo,hi};bf16x2_t b=__builtin_convertvector(v,bf16x2_t);return __builtin_bit_cast(unsigned,b);}
#define WAIT_BAR(N) asm volatile("s_waitcnt vmcnt(" #N ") lgkmcnt(0)\n\ts_barrier":::"memory")

__device__ __forceinline__ void qkt(f32x16&p0,f32x16&p1,const char*Kslot,const bf16x8*qr,const f32x16&negm,int r32,int hi){
  const char*kb=Kslot+hi*1024+r32*16;
  #pragma unroll
  for(int d0=0;d0<4;++d0){
    const bf16x8 b0=*reinterpret_cast<const bf16x8*>(kb+d0*2048);
    const bf16x8 b1=*reinterpret_cast<const bf16x8*>(kb+d0*2048+512);
    if(d0==0){p0=__builtin_amdgcn_mfma_f32_32x32x16_bf16(b0,qr[0],negm,0,0,0);p1=__builtin_amdgcn_mfma_f32_32x32x16_bf16(b1,qr[0],negm,0,0,0);}
    else{p0=__builtin_amdgcn_mfma_f32_32x32x16_bf16(b0,qr[d0],p0,0,0,0);p1=__builtin_amdgcn_mfma_f32_32x32x16_bf16(b1,qr[d0],p1,0,0,0);}}
}
typedef __attribute__((address_space(3))) const char* lds_cptr;
typedef short v4i16_t __attribute__((ext_vector_type(4)));
__device__ __forceinline__ void kload8(bf16x8*kf,lds_cptr kp){
  kf[0]=*(const __attribute__((address_space(3))) bf16x8*)(kp);      kf[1]=*(const __attribute__((address_space(3))) bf16x8*)(kp+512);
  kf[2]=*(const __attribute__((address_space(3))) bf16x8*)(kp+2048); kf[3]=*(const __attribute__((address_space(3))) bf16x8*)(kp+2560);
  kf[4]=*(const __attribute__((address_space(3))) bf16x8*)(kp+4096); kf[5]=*(const __attribute__((address_space(3))) bf16x8*)(kp+4608);
  kf[6]=*(const __attribute__((address_space(3))) bf16x8*)(kp+6144); kf[7]=*(const __attribute__((address_space(3))) bf16x8*)(kp+6656);
}
__device__ __forceinline__ void kload2(bf16x8*kf,lds_cptr kp,int j){ kf[2*j]=*(const __attribute__((address_space(3))) bf16x8*)(kp+j*2048); kf[2*j+1]=*(const __attribute__((address_space(3))) bf16x8*)(kp+j*2048+512); }
__device__ __forceinline__ s16x4 vtr(lds_cptr p){ return __builtin_bit_cast(s16x4,__builtin_amdgcn_ds_read_tr16_b64_v4i16((__attribute__((address_space(3))) v4i16_t*)p)); }
__device__ __forceinline__ float rowmax(const f32x16&p0,const f32x16&p1){
  float a=max3f(p0[0],p0[1],p1[0]),b=max3f(p0[2],p0[3],p1[1]);a=max3f(a,p1[2],p1[3]);
  #pragma unroll
  for(int r=4;r<16;r+=4){a=max3f(a,p0[r],p0[r+1]);b=max3f(b,p0[r+2],p0[r+3]);a=max3f(a,p1[r],p1[r+1]);b=max3f(b,p1[r+2],p1[r+3]);}
  const float m=max2f(a,b);
  auto rr=__builtin_amdgcn_permlane32_swap(__float_as_uint(m),__float_as_uint(m),false,false);
  return max2f(__uint_as_float(rr[0]),__uint_as_float(rr[1]));
}
__device__ __forceinline__ void pv(f32x16*o,int vb,bf16x8 pa0,bf16x8 pa1,bf16x8 pa2,bf16x8 pa3){
  #pragma unroll
  for(int d0=0;d0<2;++d0){s16x4 lo[4],hi[4];
    #pragma unroll
    for(int ks=0;ks<4;++ks){
      asm volatile("ds_read_b64_tr_b16 %0,%1 offset:%c2":"=&v"(lo[ks]):"v"(vb),"i"(d0*4096+ks*1024):"memory");
      asm volatile("ds_read_b64_tr_b16 %0,%1 offset:%c2":"=&v"(hi[ks]):"v"(vb),"i"(d0*4096+ks*1024+512):"memory");}
    asm volatile("s_waitcnt lgkmcnt(0)":::"memory");SBAR();
    #define PK(k) (bf16x8){lo[k][0],lo[k][1],lo[k][2],lo[k][3],hi[k][0],hi[k][1],hi[k][2],hi[k][3]}
    o[d0]=__builtin_amdgcn_mfma_f32_32x32x16_bf16(pa0,PK(0),o[d0],0,0,0);
    o[d0]=__builtin_amdgcn_mfma_f32_32x32x16_bf16(pa1,PK(1),o[d0],0,0,0);
    o[d0]=__builtin_amdgcn_mfma_f32_32x32x16_bf16(pa2,PK(2),o[d0],0,0,0);
    o[d0]=__builtin_amdgcn_mfma_f32_32x32x16_bf16(pa3,PK(3),o[d0],0,0,0);
    #undef PK
  }
}

#ifndef ATTN_STORE16
#define ATTN_STORE16(p,v) (*(u32x4*)(p)=(v))
#endif
template<int THRL> __device__ __forceinline__ void attn_unit(int b,int h,int qb,const bf16*Q,const bf16*__restrict__ K,const bf16*__restrict__ V,bf16*O,const float*__restrict__ CT,const float TH,char*shm,const int tid_in){
  int tid_=tid_in; asm volatile("":"+v"(tid_)); const int tid=tid_,lane=tid&63,r32=lane&31,hi=lane>>5; const int wid=__builtin_amdgcn_readfirstlane(tid>>6);
  const long rowbase=(long)b*SEQ; const int q0=qb*QB;
  const bf16*Qw=Q+(rowbase+q0+wid*QBLK)*PQ+h*D;
  const float*ctg=CT+(long)(b*NHEAD+h)*SEQ;
  int t0;
  { const int NTf=(q0+QB)/KVBLK; const float cq0=ctg[q0];
    const bool k0=(lane>=NTf-4)||!(cq0-ctg[64*lane+63]<-TH);
    const int l1=lane+64; const bool k1=(l1>=NTf-4)||!(cq0-ctg[64*(l1<NTf?l1:NTf-1)+63]<-TH);
    const unsigned long long m0=__ballot(k0),m1=__ballot(k1);
    const int first=m0?__builtin_ctzll(m0):64+(m1?__builtin_ctzll(m1):63);
    t0=__builtin_amdgcn_readfirstlane(first)&~1; if(t0>NTf-4)t0=NTf-4; }
  const int tbase=t0*KVBLK;
  const bf16*Kh=K+(rowbase+tbase)*PQ+h*D,*Vh=V+(rowbase+tbase)*PQ+h*D;
  const unsigned lds0=(unsigned)(uintptr_t)shm;
  float*wsf=(float*)(shm+LDS_WS)+wid*64;
  const unsigned koff=(unsigned)(lane*PQ+wid*8)*2u;
  const unsigned voff=(unsigned)((16*(wid&3)+(lane>>2))*PQ+(wid>>2)*32+(lane&3)*8)*2u;
  const unsigned kdst=lds0+LDS_K+wid*1024, vdst=lds0+LDS_V+wid*1024;
  #define DMA_K(t,slot) glds16(Kh+(long)(t)*KVBLK*PQ,koff,(unsigned)__builtin_amdgcn_readfirstlane(kdst+(slot)))
  #define DMA_V(t,slot) glds16(Vh+(long)(t)*KVBLK*PQ,voff,(unsigned)__builtin_amdgcn_readfirstlane(vdst+(slot)))
  const int vb0=(int)(lds0+LDS_V)+((lane>>4)&1)*32+(lane&3)*8+(4*hi+((lane&15)>>2))*64;
  const char*Kbase=shm+LDS_K; bf16x8 kf[8];
  const lds_cptr shm3=(lds_cptr)shm; const lds_cptr kp0=shm3+LDS_K+hi*1024+r32*16; const lds_cptr vp0=shm3+LDS_V+((lane>>4)&1)*32+(lane&3)*8+(4*hi+((lane&15)>>2))*64;
  const int NT=(q0+QB)/KVBLK-t0;
  { typedef __attribute__((address_space(3))) u32x4 lv4; const u32x4*src=(const u32x4*)(ctg+tbase); lv4*dst=(lv4*)(shm3+LDS_CT); const int n4=(q0+QB-tbase)/4;
    for(int i=tid;i<n4;i+=NW*64)dst[i]=src[i]; }
  const float ctl=ctg[q0+wid*QBLK+r32];
  const __attribute__((address_space(3))) float*ctab=(const __attribute__((address_space(3))) float*)(shm3+LDS_CT)+4*hi;
  DMA_K(0,0);DMA_V(0,0);DMA_K(1,SLOTB);
  bf16x8 qr[4];
  #pragma unroll
  for(int d0=0;d0<4;++d0)qr[d0]=*reinterpret_cast<const bf16x8*>(&Qw[(long)r32*PQ+d0*16+hi*8]);
  float mhat=-ctl,l_reg=0.f;     f32x16 o[2];o[0]=f32x16{};o[1]=f32x16{};f32x16 negm;
  _Pragma("unroll") for(int r=0;r<16;++r)negm[r]=ctl; asm volatile("":"+v"(negm));
  #define CBIAS(C0,C1,t) do{ const __attribute__((address_space(3))) float*tb_=ctab+64*(t); \
    _Pragma("unroll") for(int g_=0;g_<4;++g_){ const f32x4_t a_=*(const __attribute__((address_space(3))) f32x4_t*)(tb_+8*g_), b_=*(const __attribute__((address_space(3))) f32x4_t*)(tb_+32+8*g_); \
      _Pragma("unroll") for(int e_=0;e_<4;++e_){ C0[4*g_+e_]-=a_[e_]; C1[4*g_+e_]-=b_[e_]; } } }while(0)
  const int qrel=wid*QBLK+r32;
  #define CMASK(P0,P1,t) do{int jb_=(t)-(NT-4); if(jb_>=0)cmask(P0,P1,jb_,qrel,hi);}while(0)
  bool resc=false;
  #define START(P0,P1) do{ const float rm=rowmax(P0,P1); resc=false; \
    { const float dl=rm; mhat=fadd_s(mhat,dl); \
      _Pragma("unroll") for(int r=0;r<16;++r){P0[r]=fsub_s(P0[r],dl);P1[r]=fsub_s(P1[r],dl);} \
      _Pragma("unroll") for(int r=0;r<16;++r)negm[r]=-mhat; asm volatile("":"+v"(negm)); } \
    _Pragma("unroll") for(int r=0;r<16;++r)P0[r]=__builtin_amdgcn_exp2f(P0[r]); }while(0)
  #define RESC() do{ if(resc){ asm volatile("s_waitcnt lgkmcnt(0)":::"memory"); \
      _Pragma("unroll") for(int d_=0;d_<2;++d_) _Pragma("unroll") for(int r=0;r<16;++r)o[d_][r]*=wsf[crow(r,hi)]; } }while(0)
  f32x16 pA0,pA1,pB0,pB1;
  int sl_prev=0,sl_cur=0,sl_next=SLOTB;
  #define ROT() do{sl_prev=sl_cur;sl_cur=sl_next;sl_next=(sl_next==(NSLOT-1)*SLOTB)?0:sl_next+SLOTB;}while(0)
  DMA_K(2,2*SLOTB);
  WAIT_BAR(3);
  qkt(pA0,pA1,Kbase,qr,negm,r32,hi);asm volatile("s_nop 15\n\ts_nop 7":"+v"(pA0),"+v"(pA1));CBIAS(pA0,pA1,0);asm volatile("s_nop 1":"+v"(pA0),"+v"(pA1));CMASK(pA0,pA1,0);
  START(pA0,pA1);
  _Pragma("unroll") for(int r=0;r<16;++r)pA1[r]=__builtin_amdgcn_exp2f(pA1[r]);
  WAIT_BAR(0);
  DMA_K(3,0);DMA_V(1,SLOTB);
  ROT();
  kload8(kf,kp0+sl_cur);
  WAIT_BAR(2);
  s16x4 vlo[8],vhi[8]; u32x4 pw0,pw1,pw2,pw3;
  #define PKW(P,B) cvtpk_s(P[B],P[B+1])
  #define PAF(k) __builtin_bit_cast(bf16x8,pw##k)
  #define VFR(i) (bf16x8){vlo[i][0],vlo[i][1],vlo[i][2],vlo[i][3],vhi[i][0],vhi[i][1],vhi[i][2],vhi[i][3]}
  #define PIN(x) asm volatile("":"+v"(x))
  #define MX3(a,b,c) __builtin_fmaxf(__builtin_fmaxf((a),(b)),(c))
  #define GAPA(MF,A0,A1,A2,A3,W0,W1,PW) do{ MF; sacc+=A0; sacc+=A1; sacc+=A2; sacc+=A3; PIN(sacc); W0; W1; PIN(PW); SBAR(); }while(0)
  #define EX(v) __builtin_amdgcn_exp2f(v)
  #define GAPB(MF,X,B) do{ MF; X[B]=EX(X[B]); X[B+1]=EX(X[B+1]); X[B+2]=EX(X[B+2]); X[B+3]=EX(X[B+3]); PIN(X); SBAR(); }while(0)
  #define VRD(i) do{ vlo[i]=vtr(vp_+(((i)>>2)*4096+((i)&3)*1024)); vhi[i]=vtr(vp_+(((i)>>2)*4096+((i)&3)*1024+512)); }while(0)
  #define KRD(G,j) do{ if(G){ kload2(kf,kp0+sl_next,j); SBAR(); } }while(0)
  #define STEP(C0,C1,P0,P1,t,GK,GV,GL) do{ SBAR(); \
    const lds_cptr vp_=vp0+sl_prev; \
    VRD(0); SBAR(); float sacc=(P0[0]+P0[1]); \
    GAPA(C0=__builtin_amdgcn_mfma_f32_32x32x16_bf16(kf[0],qr[0],negm,0,0,0), P0[2],P0[3],P0[4],P0[5],     pw0[0]=PKW(P0,0), pw0[1]=PKW(P0,2), pw0); \
    VRD(4); SBAR(); GAPA(C1=__builtin_amdgcn_mfma_f32_32x32x16_bf16(kf[1],qr[0],negm,0,0,0), P0[6],P0[7],P0[8],P0[9],     pw0[2]=PKW(P0,4), pw0[3]=PKW(P0,6), pw0); \
    VRD(1); SBAR(); GAPA(C0=__builtin_amdgcn_mfma_f32_32x32x16_bf16(kf[2],qr[1],C0,0,0,0),   P0[10],P0[11],P0[12],P0[13], pw1[0]=PKW(P0,8), pw1[1]=PKW(P0,10), pw1); \
    VRD(5); SBAR(); GAPA(C1=__builtin_amdgcn_mfma_f32_32x32x16_bf16(kf[3],qr[1],C1,0,0,0),   P0[14],P0[15],P1[0],P1[1],   pw1[2]=PKW(P0,12),pw1[3]=PKW(P0,14), pw1); \
    VRD(2); SBAR(); GAPA(C0=__builtin_amdgcn_mfma_f32_32x32x16_bf16(kf[4],qr[2],C0,0,0,0),   P1[2],P1[3],P1[4],P1[5],     pw2[0]=PKW(P1,0), pw2[1]=PKW(P1,2), pw2); \
    VRD(6); SBAR(); GAPA(C1=__builtin_amdgcn_mfma_f32_32x32x16_bf16(kf[5],qr[2],C1,0,0,0),   P1[6],P1[7],P1[8],P1[9],     pw2[2]=PKW(P1,4), pw2[3]=PKW(P1,6), pw2); \
    VRD(3); SBAR(); GAPA(C0=__builtin_amdgcn_mfma_f32_32x32x16_bf16(kf[6],qr[3],C0,0,0,0),   P1[10],P1[11],P1[12],P1[13], pw3[0]=PKW(P1,8), pw3[1]=PKW(P1,10), pw3); \
    VRD(7); SBAR(); GAPA(C1=__builtin_amdgcn_mfma_f32_32x32x16_bf16(kf[7],qr[3],C1,0,0,0),   P1[14],P1[15],0.f,0.f,       pw3[2]=PKW(P1,12),pw3[3]=PKW(P1,14), pw3); \
    l_reg+=sacc; \
    if(GK){DMA_K((t)+3,sl_cur);} if(GV){DMA_V((t)+1,sl_next);} \
    CBIAS(C0,C1,t); CMASK(C0,C1,t); \
    { float a=MX3(C0[0],C0[1],C1[0]),b=MX3(C0[2],C0[3],C1[1]); a=MX3(a,C1[2],C1[3]); \
      _Pragma("unroll") for(int r=4;r<16;r+=4){a=MX3(a,C0[r],C0[r+1]);b=MX3(b,C0[r+2],C0[r+3]);a=MX3(a,C1[r],C1[r+1]);b=MX3(b,C1[r+2],C1[r+3]);} \
      float rm=__builtin_fmaxf(a,b); { auto rr=__builtin_amdgcn_permlane32_swap(__float_as_uint(rm),__float_as_uint(rm),false,false); rm=__builtin_fmaxf(__uint_as_float(rr[0]),__uint_as_float(rr[1])); } \
      resc=false; \
      if(__builtin_expect(__any(rm>(float)THRL),0)){ const float dl=__builtin_fmaxf(rm,0.f); mhat+=dl; \
        _Pragma("unroll") for(int r=0;r<16;++r){C0[r]-=dl;C1[r]-=dl;} \
        _Pragma("unroll") for(int r=0;r<16;++r)negm[r]=-mhat; asm volatile("":"+v"(negm)); \
        const float f=__builtin_amdgcn_exp2f(-dl); l_reg*=f; if(hi==0)wsf[r32]=f; resc=true; } } \
    SBAR(); \
    GAPB(o[0]=__builtin_amdgcn_mfma_f32_32x32x16_bf16(PAF(0),VFR(0),o[0],0,0,0), C0,0); \
    GAPB(o[1]=__builtin_amdgcn_mfma_f32_32x32x16_bf16(PAF(0),VFR(4),o[1],0,0,0), C0,4); \
    KRD(GL,0); GAPB(o[0]=__builtin_amdgcn_mfma_f32_32x32x16_bf16(PAF(1),VFR(1),o[0],0,0,0), C0,8); \
    KRD(GL,1); GAPB(o[1]=__builtin_amdgcn_mfma_f32_32x32x16_bf16(PAF(1),VFR(5),o[1],0,0,0), C0,12); \
    KRD(GL,2); GAPB(o[0]=__builtin_amdgcn_mfma_f32_32x32x16_bf16(PAF(2),VFR(2),o[0],0,0,0), C1,0); \
    KRD(GL,3); GAPB(o[1]=__builtin_amdgcn_mfma_f32_32x32x16_bf16(PAF(2),VFR(6),o[1],0,0,0), C1,4); \
    GAPB(o[0]=__builtin_amdgcn_mfma_f32_32x32x16_bf16(PAF(3),VFR(3),o[0],0,0,0), C1,8); \
    GAPB(o[1]=__builtin_amdgcn_mfma_f32_32x32x16_bf16(PAF(3),VFR(7),o[1],0,0,0), C1,12); \
    }while(0)
  int t=1;
  #undef CMASK
  #define CMASK(P0,P1,t) do{}while(0)
  for(;t+5<NT;t+=2){
    STEP(pB0,pB1,pA0,pA1,t,true,true,true);     WAIT_BAR(2); RESC(); ROT();
    STEP(pA0,pA1,pB0,pB1,t+1,true,true,true);   WAIT_BAR(2); RESC(); ROT();
  }
  #undef CMASK
  #define CMASK(P0,P1,t) do{int jb_=(t)-(NT-4); if(jb_>=0)cmask(P0,P1,jb_,qrel,hi);}while(0)
  #define ENDW(tt) do{ if((tt)+3<NT){WAIT_BAR(2);} else if((tt)+2<NT){WAIT_BAR(1);} else {WAIT_BAR(0);} }while(0)
  for(;t+1<NT;t+=2){
    STEP(pB0,pB1,pA0,pA1,t,(t+3<NT),(t+1<NT),(t+1<NT));       ENDW(t);   RESC(); ROT();
    STEP(pA0,pA1,pB0,pB1,t+1,(t+4<NT),(t+2<NT),(t+2<NT));     ENDW(t+1); RESC(); ROT();
  }
  STEP(pB0,pB1,pA0,pA1,NT-1,false,false,false); RESC();
  { float sacc=pB0[0]+pB0[1]; _Pragma("unroll") for(int r=2;r<16;++r)sacc+=pB0[r]; _Pragma("unroll") for(int r=0;r<16;++r)sacc+=pB1[r]; l_reg+=sacc;
    pw0=(u32x4){PKW(pB0,0),PKW(pB0,2),PKW(pB0,4),PKW(pB0,6)};pw1=(u32x4){PKW(pB0,8),PKW(pB0,10),PKW(pB0,12),PKW(pB0,14)};pw2=(u32x4){PKW(pB1,0),PKW(pB1,2),PKW(pB1,4),PKW(pB1,6)};pw3=(u32x4){PKW(pB1,8),PKW(pB1,10),PKW(pB1,12),PKW(pB1,14)};
    SBAR(); pv(o,vb0+sl_cur,PAF(0),PAF(1),PAF(2),PAF(3)); }
  #undef PKW
  #undef PAF
  #undef VFR
  #undef PIN
  #undef MX3
  #undef GAPA
  #undef GAPB
  #undef EX
  #undef VRD
  #undef KRD
  #undef STEP
  #undef ENDW
  {auto rr=__builtin_amdgcn_permlane32_swap(__float_as_uint(l_reg),__float_as_uint(l_reg),false,false);l_reg=__uint_as_float(rr[0])+__uint_as_float(rr[1]);}
  if(hi==0)wsf[32+r32]=l_reg;asm volatile("s_waitcnt lgkmcnt(0)":::"memory");
  float rli[16];
  #pragma unroll
  for(int r=0;r<16;++r)rli[r]=__builtin_amdgcn_rcpf(wsf[32+crow(r,hi)]);
  bf16*Ow=O+(rowbase+q0+wid*QBLK)*PO+h*D;
  { bf16*stg=(bf16*)(shm+LDS_OST)+wid*2048;
    #pragma unroll
    for(int r=0;r<16;++r){const int orow=crow(r,hi);
      #pragma unroll
      for(int d0=0;d0<2;++d0)stg[orow*64+d0*32+r32]=__float2bfloat16(o[d0][r]*rli[r]);}
    asm volatile("s_waitcnt lgkmcnt(0)":::"memory");
    #pragma unroll
    for(int i=0;i<4;++i){const int row=i*8+(lane>>3),ch=lane&7; const u32x4 v=*(const u32x4*)(stg+row*64+ch*8); ATTN_STORE16(Ow+(long)row*PO+ch*8,v);} }
  asm volatile("s_waitcnt lgkmcnt(0)\n\ts_barrier":::"memory");
  #undef DMA_K
  #undef DMA_V
  #undef CMASK
  #undef CBIAS
  #undef START
  #undef RESC
  #undef ROT
}
constexpr int ATTN_LDS_BYTES=LDS_BYTES;
struct AttnTensors { const bf16* Q; const bf16* K; const bf16* V; bf16* O; const float* CT; float TH; };
struct AttnUnit { int bh; int qb; };
struct StaticOrder {
  int vcu;
  __device__ __forceinline__ explicit StaticOrder(int grid,int block):vcu((block%8)*(grid/8)+block/8){}
  __device__ __forceinline__ bool next(int i,AttnUnit&u)const{ if(i>=4)return false; const int s=vcu&7; u.bh=vcu>>3; u.qb=(i==0)?s:(i==1)?15-s:(i==2)?16+s:31-s; return true; }
  __device__ __forceinline__ void a_ready(const AttnUnit&)const{}
  __device__ __forceinline__ void done(const AttnUnit&)const{}
};
template<class Sched,int THRL=8> __device__ __forceinline__ void attn_phase(char*lds,const AttnTensors&T,const Sched&S,const int tid_in){
  AttnUnit u;
  for(int i=0;S.next(i,u);++i){ S.a_ready(u); attn_unit<THRL>(u.bh/NHEAD,u.bh%NHEAD,u.qb,T.Q,T.K,T.V,T.O,T.CT,T.TH,lds,tid_in); S.done(u); }
}
#undef SBAR
#undef WAIT_BAR
}

constexpr int NWAVES = 8;
#ifndef MK_N_LAUNCHES
#define MK_N_LAUNCHES 1
#endif
enum Phase { PH_PRO = 0, PH_IN0, PH_MIX0, PH_OUT0, PH_XQ0, PH_XO0, PH_UP0, PH_DN0, PH_IN1, PH_MIX1, PH_OUT1, PH_XQ1, PH_XO1, PH_UP1, PH_DN1, N_PHASES };
constexpr int N_LAUNCHES = MK_N_LAUNCHES;
static_assert(N_LAUNCHES == 1 || N_LAUNCHES == N_PHASES, "MK_N_LAUNCHES is 1 or 15");

#ifndef MK_F8DN
#define MK_F8DN 2
#endif
#ifndef MK_F8XO
#define MK_F8XO 1
#endif
constexpr float F8_XOASCALE = 64.0f, F8_XOWSCALE = 512.0f;
constexpr float F8_HSCALE = 16.0f, F8_WSCALE = 1024.0f;
constexpr int BATCH = 4, SEQ = 8192, D = 1024, T = BATCH * SEQ;
constexpr int NMEM = 256, MROWS = BATCH * NMEM;
constexpr int EVEN_IN = 2568, N_IN0 = 2560, N_IN1 = 2048, DFF = 2816, XAW = 512;
constexpr int Z1P = 1536;
constexpr float EPS = 1e-6f, LOG2E = 1.4426950408889634f;
constexpr float FOX_C2 = 0.125f * LOG2E;
constexpr float XA_C2 = 0.08838834764831845f * LOG2E;

constexpr size_t MiB = 1u << 20;
constexpr size_t WS_CTL = 0, CTL_ZERO_BYTES = 64 * 1024;
constexpr size_t WS_WIN0 = 2 * MiB, WS_WOUT0 = 7 * MiB, WS_WIN1 = 9 * MiB, WS_WOUT1 = 13 * MiB;
constexpr size_t WS_LAYER = 15 * MiB, LAYER_STRIDE = 21 * MiB, L_WQ = 0, L_WKV = 1 * MiB, L_WO = 3 * MiB, L_WGU = 4 * MiB, L_WD = 15 * MiB;
constexpr size_t WS_WSP = 57 * MiB;
constexpr size_t WS_MEMN = 58 * MiB, WS_KVRAW = 60 * MiB, WS_KN = 64 * MiB, WS_VT = 66 * MiB;
constexpr size_t WS_LOGF = 68 * MiB, WS_CUM = 69 * MiB, WS_SSQ = 70 * MiB;
constexpr size_t WS_XB = 72 * MiB, WS_Y = 136 * MiB, WS_XQ = WS_Y, WS_XO = WS_Y + 32 * MiB, WS_BIG = 200 * MiB, WS_END = 376 * MiB;
constexpr int CW_TMO = 0, CW_CODE = 1;
constexpr int CW_BAR = 4096;
constexpr int CW_QX = 256, CW_G1 = 128;
constexpr int CW_Q0 = 64;

constexpr int RING_OFF = 0, RING_BYTES = 131072;
constexpr int XA_KROW = 272, XA_VROW = 528, XA_KBYTES = 256 * XA_KROW, XA_VBYTES = 128 * XA_VROW;
constexpr int LDSCTL_OFF = 139264, MISC_OFF = LDSCTL_OFF + 320;
constexpr int LDS_BYTES = 147456;
static_assert(XA_KBYTES + XA_VBYTES <= LDSCTL_OFF && MISC_OFF + 128 <= LDS_BYTES, "LDS map");
#define GAS __attribute__((address_space(1)))
#define LAS __attribute__((address_space(3)))
typedef unsigned short bf16;
typedef unsigned v4u __attribute__((ext_vector_type(4)));
typedef float f32x4 __attribute__((ext_vector_type(4)));
typedef short bf16x8 __attribute__((ext_vector_type(8)));
typedef GAS unsigned gu32;
typedef GAS unsigned long long gu64;
#define RLX_AGENT __ATOMIC_RELAXED, __HIP_MEMORY_SCOPE_AGENT
#define LDS_WAIT() asm volatile("s_waitcnt lgkmcnt(0)" ::: "memory")
#define VM_WAIT() asm volatile("s_waitcnt vmcnt(0)" ::: "memory")
__device__ __forceinline__ unsigned long long rt() { return __builtin_amdgcn_s_memrealtime(); }
__device__ __forceinline__ unsigned f2bf(float f) { unsigned u = __builtin_bit_cast(unsigned, f); return (u + 0x7fffu + ((u >> 16) & 1u)) >> 16; }
__device__ __forceinline__ unsigned pk2(float lo, float hi) { return f2bf(lo) | (f2bf(hi) << 16); }
typedef float pk_f32x2 __attribute__((ext_vector_type(2))); typedef __bf16 pk_bf16x2 __attribute__((ext_vector_type(2)));
__device__ __forceinline__ unsigned pk2h(float lo, float hi) { const pk_f32x2 v = {lo, hi}; return __builtin_bit_cast(unsigned, __builtin_convertvector(v, pk_bf16x2)); }

#define XB_TMO      128
#define XB_XCNT(j)  (256  + 64 * (j))
#define XB_XSUB(j)  (1280 + 64 * (j))
#define XB_XGEN(j)  (2304 + 64 * (j))
#define XB_TOP      3328
#define XB_TOPGEN   3392
#define XCD_BAR_WORDS 3456
#define XB_SPIN_CAP (1u << 18)

__device__ __forceinline__ unsigned xb_ld(unsigned* p)              { return __hip_atomic_load(p, __ATOMIC_RELAXED, __HIP_MEMORY_SCOPE_AGENT); }
__device__ __forceinline__ unsigned xb_add(unsigned* p, unsigned v) { return __hip_atomic_fetch_add(p, v, __ATOMIC_RELAXED, __HIP_MEMORY_SCOPE_AGENT); }
__device__ __forceinline__ unsigned xb_xcc_id() { return (unsigned)__builtin_amdgcn_s_getreg((3 << 11) | 20) & 0xFu; }
#define XB_SPIN(cond, bar) do { unsigned _sp = 0; while (cond) { __builtin_amdgcn_s_sleep(1); \
    if ((++_sp & 255u) == 0u) { if (xb_ld(&(bar)[XB_TMO])) break; if (_sp > XB_SPIN_CAP) { atomicAdd(&(bar)[XB_TMO], 1u); break; } } } } while (0)

struct XcdBarrier {
    unsigned* bar; unsigned x;
    volatile LAS unsigned* st;
};

__device__ __forceinline__ XcdBarrier xcd_barrier_post(unsigned* bar, volatile LAS unsigned* st, const int tid_in) {
    XcdBarrier b; b.bar = bar; b.x = xb_xcc_id(); b.st = st;
    if (tid_in == 0) (void)xb_add(&bar[XB_XCNT(b.x)], 1u);
    return b;
}
__device__ __forceinline__ void xcd_barrier_complete(unsigned* bar, unsigned x, unsigned& nloc, unsigned& nx) {
    const unsigned G = gridDim.x * gridDim.y * gridDim.z;
    unsigned sum, cnt, mine, sp = 0u;
    for (;;) {
        sum = 0u; cnt = 0u; mine = 0u;
#pragma unroll
        for (unsigned j = 0; j < 16; ++j) { const unsigned c = xb_ld(&bar[XB_XCNT(j)]); sum += c; cnt += (c > 0u) ? 1u : 0u; mine = (j == x) ? c : mine; }
        if (sum == G) break;
        __builtin_amdgcn_s_sleep(1);
        if ((++sp & 255u) == 0u) { if (xb_ld(&bar[XB_TMO])) break; if (sp > XB_SPIN_CAP) { atomicAdd(&bar[XB_TMO], 1u); break; } }
    }
    nloc = mine > 0u ? mine : 1u; nx = cnt > 0u ? cnt : 1u;
}

__device__ __forceinline__ void xcd_barrier(const XcdBarrier& b, const int tid_in) {
    asm volatile("s_waitcnt vmcnt(0)" ::: "memory");
    __syncthreads();
    int t0_ = tid_in; asm volatile("" : "+v"(t0_));
    if (t0_ == 0) {
        unsigned* bar = b.bar; asm volatile("" : "+v"(bar));
        __builtin_amdgcn_s_waitcnt(0);
        unsigned nloc = b.st[0], nx = b.st[1];
        if (nloc == 0u) { xcd_barrier_complete(bar, b.x, nloc, nx); b.st[0] = nloc; b.st[1] = nx; }
        const unsigned old = xb_add(&bar[XB_XSUB(b.x)], 1u);
        const unsigned gen = old / nloc;
        if (old + 1u == (gen + 1u) * nloc) {
            __builtin_amdgcn_fence(__ATOMIC_RELEASE, "agent");
            asm volatile("s_waitcnt vmcnt(0)" ::: "memory");
            const unsigned og = xb_add(&bar[XB_TOP], 1u);
            const unsigned tg = og / nx;
            if (og + 1u == (tg + 1u) * nx) xb_add(&bar[XB_TOPGEN], 1u);
            else XB_SPIN(xb_ld(&bar[XB_TOPGEN]) == tg, bar);
            __builtin_amdgcn_fence(__ATOMIC_ACQUIRE, "agent");
            xb_add(&bar[XB_XGEN(b.x)], 1u);
            asm volatile("s_waitcnt vmcnt(0)" ::: "memory");
        } else {
            XB_SPIN(xb_ld(&bar[XB_XGEN(b.x)]) == gen, bar);
            __builtin_amdgcn_fence(__ATOMIC_ACQUIRE, "agent");
            asm volatile("s_waitcnt vmcnt(0)" ::: "memory");
        }
    }
    __syncthreads();
}

typedef float f32x16 __attribute__((ext_vector_type(16)));
typedef unsigned u32x2 __attribute__((ext_vector_type(2)));
__device__ __forceinline__ float bf2f(short s) { return __builtin_bit_cast(float, (unsigned)(unsigned short)s << 16); }
__device__ __forceinline__ float bfu2f(unsigned u16) { return __builtin_bit_cast(float, u16 << 16); }
__device__ __forceinline__ float rsq(float x) { return __builtin_amdgcn_rsqf(x); }

typedef const float* cfp_t;
struct Frame {
    LAS unsigned char* lds;
    volatile LAS unsigned* MISC;
    gu32* ctl;
    int tid, lane, wave;
    int vcu, G;
    const __attribute__((address_space(4))) cfp_t* in;
    const float* x; float* out;
    unsigned char* ws;
    bf16 *XB, *Y, *XQ, *XO, *BIG, *MEMN, *KVRAW, *KN, *VT, *WSP;
    float *LOGF, *CUM, *SSQ;
};
__device__ __forceinline__ bf16* lw(Frame& F, int l, size_t off) { return (bf16*)(F.ws + WS_LAYER + (size_t)l * LAYER_STRIDE + off); }

__device__ __forceinline__ float wave_sum(float v) {
#pragma unroll
    for (int o = 1; o < 64; o <<= 1) v += __shfl_xor(v, o);
    return v;
}
typedef float f32x2 __attribute__((ext_vector_type(2)));
__device__ __forceinline__ int p0_drow(int n, int map) {
    if (map == 1) { if (n >= 1024 && n < 2048) { const int tile = n >> 8, ll = n & 255; return tile * 256 + 128 * ((ll >> 5) & 1) + 32 * (ll >> 6) + (ll & 31); } return n; }
    if (map == 2) return 256 * (n >> 7) + (n & 127);
    if (map == 3) return 256 * (n >> 7) + 128 + (n & 127);
    if (map == 4) {
        if (n < 512) return n; if (n < 1024) return 512 + 256 * ((n - 512) >> 7) + (n & 127); if (n < 1536) return 1536 + (n - 1024); return 512 + 256 * ((n - 1536) >> 7) + 128 + (n & 127); }
    return n;
}
__device__ __forceinline__ void p0_transpose_item(const float* W, int ldn, const float* ks, bf16* WT, int ldk, int koff, int k0, int n0, int map, LAS unsigned char* scr, int lane) {
    const float* src = W + (size_t)k0 * ldn + n0 + 2 * lane;
#pragma unroll
    for (int hh = 0; hh < 2; ++hh) {
        f32x2 v[32];
#pragma unroll
        for (int i = 0; i < 32; ++i) v[i] = __builtin_nontemporal_load((const GAS f32x2*)(src + (size_t)(32 * hh + i) * ldn));
#pragma unroll
        for (int i = 0; i < 32; i += 2) { const int kk = 32 * hh + i; float s0 = 1.f, s1 = 1.f; if (ks) { s0 = ks[k0 + kk]; s1 = ks[k0 + kk + 1]; }
            *(LAS unsigned*)(scr + (2 * lane) * 136 + kk * 2) = pk2h(v[i].x * s0, v[i + 1].x * s1);
            *(LAS unsigned*)(scr + (2 * lane + 1) * 136 + kk * 2) = pk2h(v[i].y * s0, v[i + 1].y * s1); }
    }
    LDS_WAIT(); asm volatile("" ::: "memory");
    const int c = lane & 7;
#pragma unroll
    for (int j = 0; j < 16; ++j) { const int n = (lane >> 3) + 8 * j; const LAS unsigned char* p = scr + n * 136 + c * 16;
        const u32x2 lo = *(const LAS u32x2*)p, hi = *(const LAS u32x2*)(p + 8);
        v4u o; o.x = lo.x; o.y = lo.y; o.z = hi.x; o.w = hi.y;
        *(GAS v4u*)(WT + (size_t)p0_drow(n0 + n, map) * ldk + koff + k0 + 8 * c) = o; }
    LDS_WAIT(); asm volatile("" ::: "memory");
}
__device__ __forceinline__ void p0_transpose_item8(const float* W, int ldn, float sc, unsigned char* WT, int ldk, int k0, int n0, LAS unsigned char* scr, int lane) {
    const float* src = W + (size_t)k0 * ldn + n0 + 2 * lane;
#pragma unroll
    for (int hh = 0; hh < 2; ++hh) {
        f32x2 v[32];
#pragma unroll
        for (int i = 0; i < 32; ++i) v[i] = __builtin_nontemporal_load((const GAS f32x2*)(src + (size_t)(32 * hh + i) * ldn));
#pragma unroll
        for (int i = 0; i < 32; i += 4) { const int kk = 32 * hh + i;
            *(LAS unsigned*)(scr + (2 * lane) * 72 + kk) = pg8::pk4_f8(v[i].x * sc, v[i + 1].x * sc, v[i + 2].x * sc, v[i + 3].x * sc);
            *(LAS unsigned*)(scr + (2 * lane + 1) * 72 + kk) = pg8::pk4_f8(v[i].y * sc, v[i + 1].y * sc, v[i + 2].y * sc, v[i + 3].y * sc); }
    }
    LDS_WAIT(); asm volatile("" ::: "memory");
    const int c = lane & 3;
#pragma unroll
    for (int j = 0; j < 8; ++j) { const int n = (lane >> 2) + 16 * j; const LAS unsigned char* p = scr + n * 72 + c * 16;
        const u32x2 lo = *(const LAS u32x2*)p, hi = *(const LAS u32x2*)(p + 8);
        v4u o; o.x = lo.x; o.y = lo.y; o.z = hi.x; o.w = hi.y;
        *(GAS v4u*)(WT + (size_t)(n0 + n) * ldk + k0 + 16 * c) = o; }
    LDS_WAIT(); asm volatile("" ::: "memory");
}
__device__ __forceinline__ bool p0_job8(int& r, const float* src, int ldn, int K, int N, float sc, unsigned char* dst, int ldk, LAS unsigned char* scr, int lane) {
    const int nblk = N / 128, items = (K / 64) * nblk;
    if (r >= items) { r -= items; return false; }
    const int kb = r / nblk, nb = r % nblk;
    p0_transpose_item8(src, ldn, sc, dst, ldk, 64 * kb, 128 * nb, scr, lane);
    return true;
}
__device__ __forceinline__ bool p0_job(int& r, const float* src, int ldn, int K, int N, const float* ks, bf16* dst, int ldk, int koff, int map, LAS unsigned char* scr, int lane) {
    const int nblk = N / 128, items = (K / 64) * nblk;
    if (r >= items) { r -= items; return false; }
    const int kb = r / nblk, nb = r % nblk;
    p0_transpose_item(src, ldn, ks, dst, ldk, koff, 64 * kb, 128 * nb, map, scr, lane);
    return true;
}
__device__ __forceinline__ void p0_prologue(Frame& F) {
    LAS unsigned char* scr = F.lds + RING_OFF + F.wave * 17408;
    const int gw = F.vcu * NWAVES + F.wave, NGW = F.G * NWAVES, lane = F.lane;
    const __attribute__((address_space(4))) cfp_t* in = F.in;
    constexpr int I_IN0 = 16 * 20, I_SQ = 16 * 8, I_IN1 = 16 * 16, I_O1 = 8 * 8, I_Q = 16 * 4, I_KV = 16 * 8, I_XO = 8 * 8, I_G = 16 * 22, I_DN = 44 * 8;
    constexpr int NITEMS = I_IN0 + I_SQ + I_IN1 + I_O1 + 2 * (I_Q + I_KV + I_XO + 2 * I_G + I_DN);
#ifdef PROBE_PHASE
#define P0REP(k) for (int prep_ = 0; prep_ < ((PROBE_PHASE == 100 + (k)) ? 2 : 1); ++prep_)
#else
#define P0REP(k)
#endif
    P0REP(1)
    for (int it = gw; it < NITEMS; it += NGW) {
        int r = it;
        if (p0_job(r, in[14], EVEN_IN, D, N_IN0, in[2], (bf16*)(F.ws + WS_WIN0), D, 0, 1, scr, lane)) continue;
        if (p0_job(r, in[21], D, D, D, nullptr, (bf16*)(F.ws + WS_WOUT0), D, 0, 0, scr, lane)) continue;
        if (p0_job(r, in[22], N_IN1, D, N_IN1, in[2] + D, (bf16*)(F.ws + WS_WIN1), D, 0, 4, scr, lane)) continue;
        if (p0_job(r, in[26] + (size_t)512 * D, D, 512, D, nullptr, (bf16*)(F.ws + WS_WOUT1), D, 512, 0, scr, lane)) continue;
        bool done = false;
#pragma unroll
        for (int l = 0; l < 2; ++l) {
            if (done) break;
            if (p0_job(r, in[5] + (size_t)l * D * XAW, XAW, D, XAW, in[3] + l * D, lw(F, l, L_WQ), D, 0, 0, scr, lane)) { done = true; break; }
            if (p0_job(r, in[6] + (size_t)l * D * D, D, D, D, in[4] + l * D, lw(F, l, L_WKV), D, 0, 0, scr, lane)) { done = true; break; }
            if (MK_F8XO) { if (p0_job8(r, in[7] + (size_t)l * XAW * D, D, XAW, D, F8_XOWSCALE, (unsigned char*)lw(F, l, L_WO), XAW, scr, lane)) { done = true; break; } }
            else if (p0_job(r, in[7] + (size_t)l * XAW * D, D, XAW, D, nullptr, lw(F, l, L_WO), XAW, 0, 0, scr, lane)) { done = true; break; }
            if (p0_job(r, in[11] + (size_t)l * D * DFF, DFF, D, DFF, in[10] + l * D, lw(F, l, L_WGU), D, 0, 2, scr, lane)) { done = true; break; }
            if (p0_job(r, in[12] + (size_t)l * D * DFF, DFF, D, DFF, in[10] + l * D, lw(F, l, L_WGU), D, 0, 3, scr, lane)) { done = true; break; }
            if ((MK_F8DN >> l) & 1) { if (p0_job8(r, in[13] + (size_t)l * DFF * D, D, DFF, D, F8_WSCALE, (unsigned char*)lw(F, l, L_WD), DFF, scr, lane)) { done = true; break; } }
            else if (p0_job(r, in[13] + (size_t)l * DFF * D, D, DFF, D, nullptr, lw(F, l, L_WD), DFF, 0, 0, scr, lane)) { done = true; break; }
        }
    }
    P0REP(2)
    for (int it = gw; it < 128 * 16; it += NGW) {
        const int kk0 = (it >> 4) * 4, n0 = (it & 15) * 64, g = kk0 >> 7;
        const float* wp = in[23] + (size_t)kk0 * 128; const float* sp = in[24] + g * 128; const float* wo = in[26] + (size_t)(g * 128) * D + n0 + lane;
        float acc[4];
#pragma unroll
        for (int j = 0; j < 4; ++j) acc[j] = 0.f;
#pragma unroll 32
        for (int d = 0; d < 128; ++d) { const float w = wo[(size_t)d * D] * sp[d];
#pragma unroll
            for (int j = 0; j < 4; ++j) acc[j] += wp[j * 128 + d] * w; }
        u32x2 o; o.x = pk2h(acc[0], acc[1]); o.y = pk2h(acc[2], acc[3]);
        *(GAS u32x2*)((bf16*)(F.ws + WS_WOUT1) + (size_t)(n0 + lane) * D + kk0) = o;
    }
    for (int i = gw * 64 + lane; i < 4 * 128 * 128; i += NGW * 64) { const int t = (i >> 7) & 127, s = i & 127; const float w = in[17][i]; F.WSP[i] = (bf16)f2bf((t >> 6) >= (s >> 6) ? w : 0.f); }
    for (int row = gw; row < MROWS; row += NGW) {
        const GAS f32x4* xr = (const GAS f32x4*)(in[1] + (size_t)row * D) + lane;
        f32x4 v[4]; float s = 0.f;
#pragma unroll
        for (int j = 0; j < 4; ++j) { v[j] = xr[64 * j]; s += (v[j].x * v[j].x + v[j].y * v[j].y) + (v[j].z * v[j].z + v[j].w * v[j].w); }
        const float rstd = rsq(wave_sum(s) * (1.f / D) + EPS);
        GAS unsigned long long* o8 = (GAS unsigned long long*)(F.MEMN + (size_t)row * D) + lane;
#pragma unroll
        for (int j = 0; j < 4; ++j) o8[64 * j] = (unsigned long long)pk2h(v[j].x * rstd, v[j].y * rstd) | ((unsigned long long)pk2h(v[j].z * rstd, v[j].w * rstd) << 32);
    }
    {
        LAS float* wl = (LAS float*)(F.lds + RING_OFF);
        __syncthreads();
#pragma unroll
        for (int r = 0; r < 2; ++r) { const int k = F.tid + 512 * r; const float g = in[2][k]; const float* p = in[14] + (size_t)k * EVEN_IN + N_IN0;
            const f32x4 a = *(const f32x4*)p, b = *(const f32x4*)(p + 4);
            wl[0 * 1024 + k] = a.x * g; wl[1 * 1024 + k] = a.y * g; wl[2 * 1024 + k] = a.z * g; wl[3 * 1024 + k] = a.w * g;
            wl[4 * 1024 + k] = b.x * g; wl[5 * 1024 + k] = b.y * g; wl[6 * 1024 + k] = b.z * g; wl[7 * 1024 + k] = b.w * g; }
        __syncthreads();
        float wf[8][16];
#pragma unroll
        for (int j = 0; j < 8; ++j)
#pragma unroll
            for (int jj = 0; jj < 4; ++jj) { const f32x4 w = *(const LAS f32x4*)(wl + j * 1024 + 4 * lane + 256 * jj); wf[j][jj * 4 + 0] = w.x; wf[j][jj * 4 + 1] = w.y; wf[j][jj * 4 + 2] = w.z; wf[j][jj * 4 + 3] = w.w; }
        const float bfl = in[15][lane & 7];
        P0REP(3) {
        int row = gw;
        f32x4 v[4], v1[4];
        if (row < T) { const GAS f32x4* xr = (const GAS f32x4*)(F.x + (size_t)row * D) + lane;
#pragma unroll
            for (int j = 0; j < 4; ++j) v[j] = __builtin_nontemporal_load(xr + 64 * j); }
        if (row + NGW < T) { const GAS f32x4* xr = (const GAS f32x4*)(F.x + (size_t)(row + NGW) * D) + lane;
#pragma unroll
            for (int j = 0; j < 4; ++j) v1[j] = __builtin_nontemporal_load(xr + 64 * j); }
        while (row < T) {
            const int nrow = row + NGW; f32x4 vn[4];
            if (nrow + NGW < T) { const GAS f32x4* xr = (const GAS f32x4*)(F.x + (size_t)(nrow + NGW) * D) + lane;
#pragma unroll
                for (int j = 0; j < 4; ++j) vn[j] = __builtin_nontemporal_load(xr + 64 * j); }
            float s = 0.f;
#pragma unroll
            for (int j = 0; j < 4; ++j) s += (v[j].x * v[j].x + v[j].y * v[j].y) + (v[j].z * v[j].z + v[j].w * v[j].w);
            float a[8];
#pragma unroll
            for (int j2 = 0; j2 < 8; ++j2) { float t = 0.f;
#pragma unroll
                for (int jj = 0; jj < 4; ++jj) t += (v[jj].x * wf[j2][jj * 4 + 0] + v[jj].y * wf[j2][jj * 4 + 1]) + (v[jj].z * wf[j2][jj * 4 + 2] + v[jj].w * wf[j2][jj * 4 + 3]);
                a[j2] = t; }
            float b4[4], b2[2], b1;
#pragma unroll
            for (int i = 0; i < 4; ++i) { const float keep = (lane & 1) ? a[2 * i + 1] : a[2 * i], give = (lane & 1) ? a[2 * i] : a[2 * i + 1]; b4[i] = keep + __shfl_xor(give, 1); }
#pragma unroll
            for (int i = 0; i < 2; ++i) { const float keep = (lane & 2) ? b4[2 * i + 1] : b4[2 * i], give = (lane & 2) ? b4[2 * i] : b4[2 * i + 1]; b2[i] = keep + __shfl_xor(give, 2); }
            { const float keep = (lane & 4) ? b2[1] : b2[0], give = (lane & 4) ? b2[0] : b2[1]; b1 = keep + __shfl_xor(give, 4); }
            b1 += __shfl_xor(b1, 8); b1 += __shfl_xor(b1, 16); b1 += __shfl_xor(b1, 32);
            s = wave_sum(s);
            const float rstd = rsq(s * (1.f / D) + EPS);
            if (lane < 16) F.SSQ[(size_t)row * 16 + lane] = (lane == 0) ? s : 0.f;
            GAS unsigned long long* o8 = (GAS unsigned long long*)(F.XB + (size_t)row * D) + lane;
#pragma unroll
            for (int j = 0; j < 4; ++j) o8[64 * j] = (unsigned long long)pk2h(v[j].x, v[j].y) | ((unsigned long long)pk2h(v[j].z, v[j].w) << 32);
            if (lane < 8) { const float fl = b1 * rstd + bfl; const float lf = fminf(fl, 0.f) - log1pf(expf(-fabsf(fl)));
                F.LOGF[((size_t)(row / SEQ) * 8 + lane) * SEQ + (row % SEQ)] = lf * LOG2E; }
#pragma unroll
            for (int j = 0; j < 4; ++j) { v[j] = v1[j]; v1[j] = vn[j]; }
            row = nrow;
        }
        }
    }
}
__device__ __forceinline__ void cumsum_seq(Frame& F, int bh) {
    const int tid = F.tid, lane = F.lane;
    const f32x4* src = (const f32x4*)(F.LOGF + (size_t)bh * SEQ + tid * 16);
    f32x4 q[4];
#pragma unroll
    for (int i = 0; i < 4; ++i) q[i] = src[i];
    float run = 0.f;
#pragma unroll
    for (int i = 0; i < 4; ++i) { q[i].x += run; q[i].y += q[i].x; q[i].z += q[i].y; q[i].w += q[i].z; run = q[i].w; }
    float incl = run;
#pragma unroll
    for (int o = 1; o < 64; o <<= 1) { const float t = __shfl_up(incl, o); if (lane >= o) incl += t; }
    LAS float* sc = (LAS float*)F.lds;
    __syncthreads();
    if (lane == 63) sc[F.wave] = incl;
    __syncthreads();
    float woff = 0.f;
#pragma unroll
    for (int w = 0; w < NWAVES; ++w) woff += (w < F.wave) ? sc[w] : 0.f;
    const float off = woff + (incl - run);
    f32x4* dst = (f32x4*)(F.CUM + (size_t)bh * SEQ + tid * 16);
#pragma unroll
    for (int i = 0; i < 4; ++i) dst[i] = q[i] + off;
    __syncthreads();
}
__device__ __forceinline__ void xa_kv_finalize(Frame& F, int item) {
    const int tid = F.tid, l = item >> 4, b = (item >> 2) & 3, h = item & 3;
    const int kvr = tid >> 1, half = tid & 1;
    const bf16* kp = F.KVRAW + (size_t)l * MROWS * D + (size_t)(b * NMEM + kvr) * D + h * 128 + 64 * half;
    const size_t obase = (size_t)((l * 4 + b) * 4 + h) * (NMEM * 128);
    bf16x8 x[8]; float ss = 0.f;
#pragma unroll
    for (int i = 0; i < 8; ++i) { x[i] = *(const GAS bf16x8*)(kp + 8 * i);
#pragma unroll
        for (int e = 0; e < 8; ++e) { const float f = bf2f(x[i][e]); ss += f * f; } }
    ss += __shfl_xor(ss, 1);
    const float rstd = rsq(ss * (1.f / 128.f) + EPS);
    const float* gk = F.in[9] + l * 128 + 64 * half;
    bf16* ko = F.KN + obase + (size_t)kvr * 128 + 64 * half;
#pragma unroll
    for (int i = 0; i < 8; ++i) { v4u o;
        o.x = pk2(bf2f(x[i][0]) * rstd * gk[8 * i + 0], bf2f(x[i][1]) * rstd * gk[8 * i + 1]); o.y = pk2(bf2f(x[i][2]) * rstd * gk[8 * i + 2], bf2f(x[i][3]) * rstd * gk[8 * i + 3]);
        o.z = pk2(bf2f(x[i][4]) * rstd * gk[8 * i + 4], bf2f(x[i][5]) * rstd * gk[8 * i + 5]); o.w = pk2(bf2f(x[i][6]) * rstd * gk[8 * i + 6], bf2f(x[i][7]) * rstd * gk[8 * i + 7]);
        *(GAS v4u*)(ko + 8 * i) = o; }
    const bf16* vp = kp + XAW;
    const int pk = (kvr & ~12) | ((kvr & 4) << 1) | ((kvr & 8) >> 1);
    LAS unsigned short* vl = (LAS unsigned short*)F.lds;
    __syncthreads();
#pragma unroll
    for (int i = 0; i < 8; ++i) { const bf16x8 v = *(const GAS bf16x8*)(vp + 8 * i);
#pragma unroll
        for (int e = 0; e < 8; ++e) vl[(64 * half + 8 * i + e) * NMEM + pk] = (unsigned short)v[e]; }
    __syncthreads();
    bf16* vo = F.VT + obase;
#pragma unroll
    for (int i = 0; i < 8; ++i) { const int id = tid + 512 * i; *(GAS v4u*)(vo + id * 8) = *(const LAS v4u*)(vl + id * 8); }
    __syncthreads();
}
__device__ __forceinline__ void gmlp_loads(Frame& F, int r0, int g, bf16x8 (&x)[4], v4u (&up)[4], float (&bp)[4]) {
    const int tid = F.tid, lane = F.lane; const bf16* Z = F.BIG;
    { const int row = tid >> 2, q = tid & 3; const bf16* vp = Z + (size_t)(r0 + row) * N_IN0 + 512 + g * 128 + 32 * q;
#pragma unroll
      for (int i = 0; i < 4; ++i) x[i] = __builtin_nontemporal_load((const GAS bf16x8*)(vp + 8 * i)); }
    const int tb = F.wave & 3, chh = F.wave >> 2;
#pragma unroll
    for (int i = 0; i < 4; ++i) { const int t = (lane >> 3) + 8 * i, ch = lane & 7, row = r0 + 32 * tb + t;
        up[i] = __builtin_nontemporal_load((const GAS v4u*)(Z + (size_t)row * N_IN0 + g * 128 + 64 * chh + 8 * ch)); bp[i] = F.in[18][g * 128 + 32 * tb + t]; }
}
__device__ __forceinline__ void gmlp_compute(Frame& F, int r0, int g, const bf16x8 (&x)[4], const v4u (&up)[4], const float (&bp)[4], bool has_next, bf16x8 (&nx)[4], v4u (&nup)[4], float (&nbp)[4]) {
    const int tid = F.tid, lane = F.lane, wid = F.wave, r32 = lane & 31, hi = lane >> 5;
    LAS unsigned char* vT = F.lds;
    __syncthreads();
    { const int row = tid >> 2, q = tid & 3; float ss = 0.f;
#pragma unroll
      for (int i = 0; i < 4; ++i)
#pragma unroll
          for (int e = 0; e < 8; ++e) { const float f = bf2f(x[i][e]); ss += f * f; }
      ss += __shfl_xor(ss, 1); ss += __shfl_xor(ss, 2);
      const float rstd = rsq(ss * (1.f / 128.f) + EPS);
      const float* gv = F.in[16] + g * 128 + 32 * q;
#pragma unroll
      for (int i = 0; i < 4; ++i)
#pragma unroll
          for (int e = 0; e < 8; e += 2) { const int c = 32 * q + 8 * i + e; const unsigned w = pk2h(bf2f(x[i][e]) * rstd * gv[8 * i + e], bf2f(x[i][e + 1]) * rstd * gv[8 * i + e + 1]);
              *(LAS unsigned short*)(vT + c * 272 + row * 2) = (unsigned short)(w & 0xffffu); *(LAS unsigned short*)(vT + (c + 1) * 272 + row * 2) = (unsigned short)(w >> 16); }
    }
    if (has_next) gmlp_loads(F, r0, g + 1, nx, nup, nbp);
    __syncthreads();
    const int tb = wid & 3, chh = wid >> 2;
    f32x16 acc[2]; acc[0] = f32x16{}; acc[1] = f32x16{};
    const bf16* Wg = F.WSP + (size_t)g * 128 * 128 + (size_t)(32 * tb + r32) * 128 + 8 * hi;
#pragma unroll
    for (int ks = 0; ks < 8; ++ks) { const bf16x8 bfr = *(const GAS bf16x8*)(Wg + 16 * ks);
#pragma unroll
        for (int c2 = 0; c2 < 2; ++c2) { const bf16x8 a = *(const LAS bf16x8*)(vT + (32 * (2 * chh + c2) + r32) * 272 + (16 * ks + 8 * hi) * 2);
            acc[c2] = __builtin_amdgcn_mfma_f32_32x32x16_bf16(a, bfr, acc[c2], 0, 0, 0); } }
    LAS unsigned char* stg = F.lds + 40960 + wid * (32 * 272);
#pragma unroll
    for (int c2 = 0; c2 < 2; ++c2)
#pragma unroll
        for (int g4 = 0; g4 < 4; ++g4) { const f32x4 v = (f32x4){acc[c2][4 * g4 + 0], acc[c2][4 * g4 + 1], acc[c2][4 * g4 + 2], acc[c2][4 * g4 + 3]};
            *(LAS f32x4*)(stg + r32 * 272 + (32 * c2 + 8 * g4 + 4 * hi) * 4) = v; }
    LDS_WAIT(); asm volatile("" ::: "memory");
#pragma unroll
    for (int i = 0; i < 4; ++i) { const int t = (lane >> 3) + 8 * i, ch = lane & 7, row = r0 + 32 * tb + t;
        const f32x4 s0 = *(const LAS f32x4*)(stg + t * 272 + ch * 32), s1 = *(const LAS f32x4*)(stg + t * 272 + ch * 32 + 16);
        const float bs = bp[i]; const v4u u = up[i];
        v4u o; o.x = pk2h(bfu2f(u.x & 0xffffu) * (s0.x + bs), bfu2f(u.x >> 16) * (s0.y + bs)); o.y = pk2h(bfu2f(u.y & 0xffffu) * (s0.z + bs), bfu2f(u.y >> 16) * (s0.w + bs));
        o.z = pk2h(bfu2f(u.z & 0xffffu) * (s1.x + bs), bfu2f(u.z >> 16) * (s1.y + bs)); o.w = pk2h(bfu2f(u.w & 0xffffu) * (s1.z + bs), bfu2f(u.w >> 16) * (s1.w + bs));
        *(GAS v4u*)(F.Y + (size_t)row * D + g * 128 + 64 * chh + 8 * ch) = o; }
}
__device__ __forceinline__ void gmlp_item(Frame& F, int blk) {
    const int r0 = blk * 128;
    bf16x8 xa[4], xb[4]; v4u ua[4], ub[4]; float ba[4], bb[4];
    gmlp_loads(F, r0, 0, xa, ua, ba);
    gmlp_compute(F, r0, 0, xa, ua, ba, true, xb, ub, bb);
    gmlp_compute(F, r0, 1, xb, ub, bb, true, xa, ua, ba);
    gmlp_compute(F, r0, 2, xa, ua, ba, true, xb, ub, bb);
    gmlp_compute(F, r0, 3, xb, ub, bb, false, xa, ua, ba);
}
__device__ __forceinline__ void mix1_phase(Frame& F) {
    const bf16* Z = F.BIG;
    const int tid = F.tid;
    for (int it = F.vcu; it < T / 128; it += F.G) {
        const int rc = it * 4 + (tid >> 7), cc = tid & 127, t0 = rc * 32, pos0 = t0 % SEQ;
        if (cc < 64) {
            const int w = 2 << (cc >> 4); const bf16* zp = Z + (size_t)t0 * Z1P + 8 * cc; bf16* yp = F.Y + (size_t)t0 * D + 8 * cc;
            float s[8];
#pragma unroll
            for (int e = 0; e < 8; ++e) s[e] = 0.f;
            for (int j = 1; j < w; ++j) if (pos0 - j >= 0) { const bf16x8 z = *(const GAS bf16x8*)(zp - (size_t)j * Z1P);
#pragma unroll
                for (int e = 0; e < 8; ++e) s[e] += bf2f(z[e]); }
            for (int i = 0; i < 32; ++i) { const int pos = pos0 + i; const bf16x8 z = *(const GAS bf16x8*)(zp + (size_t)i * Z1P);
                float zf[8];
#pragma unroll
                for (int e = 0; e < 8; ++e) { zf[e] = bf2f(z[e]); s[e] += zf[e]; }
                const float inv = 1.0f / (float)((pos + 1 < w) ? pos + 1 : w);
                v4u o; o.x = pk2h(s[0] * inv - zf[0], s[1] * inv - zf[1]); o.y = pk2h(s[2] * inv - zf[2], s[3] * inv - zf[3]); o.z = pk2h(s[4] * inv - zf[4], s[5] * inv - zf[5]); o.w = pk2h(s[6] * inv - zf[6], s[7] * inv - zf[7]);
                *(GAS v4u*)(yp + (size_t)i * D) = o;
                if (pos + 1 >= w) { const bf16x8 zo = *(const GAS bf16x8*)(zp + (long)(i - w + 1) * Z1P);
#pragma unroll
                    for (int e = 0; e < 8; ++e) s[e] -= bf2f(zo[e]); } }
        } else {
            const int c8 = (cc - 64) * 8; const bf16* xp = Z + (size_t)t0 * Z1P + 512 + c8; bf16* yp = F.Y + (size_t)t0 * D + 512 + c8;
            const float* cw = F.in[25];
            float w0[8], w1[8], w2[8], x1[8], x2[8];
#pragma unroll
            for (int e = 0; e < 8; ++e) { w0[e] = cw[c8 + e]; w1[e] = cw[512 + c8 + e]; w2[e] = cw[1024 + c8 + e]; x1[e] = 0.f; x2[e] = 0.f; }
            if (pos0 >= 2) { const bf16x8 a2 = *(const GAS bf16x8*)(xp - 2 * (size_t)Z1P), a1 = *(const GAS bf16x8*)(xp - (size_t)Z1P);
#pragma unroll
                for (int e = 0; e < 8; ++e) { x2[e] = bf2f(a2[e]); x1[e] = bf2f(a1[e]); } }
            for (int i = 0; i < 32; ++i) { const bf16* p = xp + (size_t)i * Z1P; const bf16x8 xv = __builtin_nontemporal_load((const GAS bf16x8*)p), gb = __builtin_nontemporal_load((const GAS bf16x8*)(p + 512));
                float y[8];
#pragma unroll
                for (int e = 0; e < 8; ++e) { const float x0 = bf2f(xv[e]); y[e] = bf2f(gb[e]) * (w0[e] * x2[e] + w1[e] * x1[e] + w2[e] * x0); x2[e] = x1[e]; x1[e] = x0; }
                v4u o; o.x = pk2h(y[0], y[1]); o.y = pk2h(y[2], y[3]); o.z = pk2h(y[4], y[5]); o.w = pk2h(y[6], y[7]);
                *(GAS v4u*)(yp + (size_t)i * D) = o; }
        }
    }
}
__device__ __forceinline__ void xa_attn_unit(Frame& F, int l, int pm, int pn) {
    const int b = pm / (SEQ / 256);
    for (int hh = 0; hh < 2; ++hh) {
        int tid = F.tid; asm volatile("" : "+v"(tid));
        const int lane = tid & 63, wid = F.wave, r32 = lane & 31, hi = lane >> 5;
        LAS unsigned char* Kl = F.lds; LAS unsigned char* Vl = F.lds + XA_KBYTES;
        const unsigned q = (unsigned)(pm * 256 + wid * 32 + r32);
        const int h = 2 * pn + hh;
        const bf16* Kg = F.KN + (size_t)((l * 4 + b) * 4 + h) * (NMEM * 128);
        const bf16* Vg = F.VT + (size_t)((l * 4 + b) * 4 + h) * (NMEM * 128);
        const bf16* Qp = F.XQ + (q * XAW + h * 128 + 8 * hi);
        bf16x8 qf[8];
#pragma unroll
        for (int ks = 0; ks < 8; ++ks) qf[ks] = *(const GAS bf16x8*)(Qp + 16 * ks);
        __syncthreads();
#pragma unroll
        for (int i = 0; i < 8; ++i) { const int id = tid + 512 * i, row = id >> 4, ch = id & 15; const v4u x = *(const GAS v4u*)(Kg + row * 128 + ch * 8); *(LAS v4u*)(Kl + row * XA_KROW + ch * 16) = x; }
#pragma unroll
        for (int i = 0; i < 8; ++i) { const int id = tid + 512 * i, row = id >> 5, ch = id & 31; const v4u x = *(const GAS v4u*)(Vg + row * 256 + ch * 8); *(LAS v4u*)(Vl + row * XA_VROW + ch * 16) = x; }
        float ss = 0.f;
#pragma unroll
        for (int ks = 0; ks < 8; ++ks)
#pragma unroll
            for (int e = 0; e < 8; ++e) { const float f = bf2f(qf[ks][e]); ss += f * f; }
        ss += __shfl_xor(ss, 32);
        const float sc = rsq(ss * (1.f / 128.f) + EPS) * XA_C2;
        const float* gq = F.in[8] + l * 128 + 8 * hi;
#pragma unroll
        for (int ks = 0; ks < 8; ++ks) { const f32x4 ga = *(const f32x4*)(gq + 16 * ks), gb = *(const f32x4*)(gq + 16 * ks + 4);
            v4u w; w.x = pk2(bf2f(qf[ks][0]) * sc * ga.x, bf2f(qf[ks][1]) * sc * ga.y); w.y = pk2(bf2f(qf[ks][2]) * sc * ga.z, bf2f(qf[ks][3]) * sc * ga.w);
            w.z = pk2(bf2f(qf[ks][4]) * sc * gb.x, bf2f(qf[ks][5]) * sc * gb.y); w.w = pk2(bf2f(qf[ks][6]) * sc * gb.z, bf2f(qf[ks][7]) * sc * gb.w);
            qf[ks] = __builtin_bit_cast(bf16x8, w); }
        __syncthreads();
        f32x16 s[8];
#pragma unroll
        for (int kvb = 0; kvb < 8; ++kvb) s[kvb] = f32x16{};
        const LAS unsigned char* kbase = Kl + r32 * XA_KROW + hi * 16;
        bf16x8 fa[4], fb[4];
#define XA_LDK(dst, st) do { _Pragma("unroll") for (int j_ = 0; j_ < 4; ++j_) dst[j_] = *(const LAS bf16x8*)(kbase + ((st) >> 1) * (32 * XA_KROW) + (4 * ((st) & 1) + j_) * 32); } while (0)
#define XA_MMK(src, st) do { _Pragma("unroll") for (int j_ = 0; j_ < 4; ++j_) s[(st) >> 1] = __builtin_amdgcn_mfma_f32_32x32x16_bf16(src[j_], qf[4 * ((st) & 1) + j_], s[(st) >> 1], 0, 0, 0); } while (0)
        XA_LDK(fa, 0);
#pragma unroll
        for (int st = 0; st < 16; st += 2) {
            XA_LDK(fb, st + 1); XA_MMK(fa, st); __builtin_amdgcn_sched_barrier(0);
            if (st + 2 < 16) XA_LDK(fa, st + 2);
            XA_MMK(fb, st + 1); __builtin_amdgcn_sched_barrier(0);
        }
#undef XA_LDK
#undef XA_MMK
        __syncthreads();
        float m = -INFINITY;
#pragma unroll
        for (int kvb = 0; kvb < 8; ++kvb)
#pragma unroll
            for (int r = 0; r < 16; ++r) m = fmaxf(m, s[kvb][r]);
        m = fmaxf(m, __shfl_xor(m, 32));
        float lsum = 0.f;
        bf16x8 pf[8][2];
#pragma unroll
        for (int kvb = 0; kvb < 8; ++kvb) {
#pragma unroll
            for (int r = 0; r < 16; ++r) { const float p = __builtin_amdgcn_exp2f(s[kvb][r] - m); s[kvb][r] = p; lsum += p; }
#pragma unroll
            for (int s2 = 0; s2 < 2; ++s2) { v4u w; w.x = pk2h(s[kvb][8 * s2 + 0], s[kvb][8 * s2 + 1]); w.y = pk2h(s[kvb][8 * s2 + 2], s[kvb][8 * s2 + 3]); w.z = pk2h(s[kvb][8 * s2 + 4], s[kvb][8 * s2 + 5]); w.w = pk2h(s[kvb][8 * s2 + 6], s[kvb][8 * s2 + 7]);
                pf[kvb][s2] = __builtin_bit_cast(bf16x8, w); } }
        lsum += __shfl_xor(lsum, 32);
        f32x16 o[4];
#pragma unroll
        for (int db = 0; db < 4; ++db) o[db] = f32x16{};
        const LAS unsigned char* vbase = Vl + r32 * XA_VROW + hi * 16;
#define XA_LDV(dst, st) do { _Pragma("unroll") for (int j_ = 0; j_ < 4; ++j_) dst[j_] = *(const LAS bf16x8*)(vbase + j_ * (32 * XA_VROW) + (st) * 32); } while (0)
#define XA_MMV(src, st) do { _Pragma("unroll") for (int j_ = 0; j_ < 4; ++j_) o[j_] = __builtin_amdgcn_mfma_f32_32x32x16_bf16(src[j_], pf[(st) >> 1][(st) & 1], o[j_], 0, 0, 0); } while (0)
        XA_LDV(fa, 0);
#pragma unroll
        for (int st = 0; st < 16; st += 2) {
            XA_LDV(fb, st + 1); XA_MMV(fa, st); __builtin_amdgcn_sched_barrier(0);
            if (st + 2 < 16) XA_LDV(fa, st + 2);
            XA_MMV(fb, st + 1); __builtin_amdgcn_sched_barrier(0);
        }
#undef XA_LDV
#undef XA_MMV
        LAS unsigned char* stg = Kl + wid * (32 * XA_KROW);
        if constexpr (MK_F8XO) {
            const float inv = F8_XOASCALE / lsum;
#pragma unroll
            for (int db = 0; db < 4; ++db)
#pragma unroll
                for (int g4 = 0; g4 < 4; ++g4) { const int d0 = 32 * db + 8 * g4 + 4 * hi;
                    *(LAS unsigned*)(stg + r32 * 144 + d0) = pg8::pk4_f8(o[db][4 * g4 + 0] * inv, o[db][4 * g4 + 1] * inv, o[db][4 * g4 + 2] * inv, o[db][4 * g4 + 3] * inv); }
            LDS_WAIT(); asm volatile("" ::: "memory");
            unsigned char* Ob8 = (unsigned char*)F.XO + ((unsigned)(pm * 256 + wid * 32) * XAW + h * 128);
#pragma unroll
            for (int i = 0; i < 4; ++i) { const int row = 8 * i + (lane >> 3), ch = lane & 7; const v4u v = *(const LAS v4u*)(stg + row * 144 + ch * 16); *(GAS v4u*)(Ob8 + row * XAW + ch * 16) = v; }
            continue;
        }
        const float inv = 1.0f / lsum;
#pragma unroll
        for (int db = 0; db < 4; ++db)
#pragma unroll
            for (int g4 = 0; g4 < 4; ++g4) { const int d0 = 32 * db + 8 * g4 + 4 * hi; u32x2 w; w.x = pk2(o[db][4 * g4 + 0] * inv, o[db][4 * g4 + 1] * inv); w.y = pk2(o[db][4 * g4 + 2] * inv, o[db][4 * g4 + 3] * inv);
                *(LAS u32x2*)(stg + r32 * XA_KROW + d0 * 2) = w; }
        LDS_WAIT(); asm volatile("" ::: "memory");
        bf16* Ob = F.XO + ((unsigned)(pm * 256 + wid * 32) * XAW + h * 128);
#pragma unroll
        for (int i = 0; i < 8; ++i) { const int row = 4 * i + (lane >> 4), ch = lane & 15; const v4u v = *(const LAS v4u*)(stg + row * XA_KROW + ch * 16); *(GAS v4u*)(Ob + row * XAW + ch * 8) = v; }
    }
}

constexpr int RS_OFF = 131072;
template <class Sched> __device__ __forceinline__ const LAS float* rs_prepare(Frame& F, const Sched& S) {
    LAS float* t = (LAS float*)(F.lds + RS_OFF);
    int p0 = -1, p1 = -1, p2 = -1, p3 = -1; pg8::Unit u;
    for (int i = 0; S.next(i, u); ++i) { const int pm = u.pm; if (pm == p0 || pm == p1 || pm == p2 || pm == p3) continue; if (p0 < 0) p0 = pm; else if (p1 < 0) p1 = pm; else if (p2 < 0) p2 = pm; else if (p3 < 0) p3 = pm; }
    __syncthreads();
    if (F.tid < 4) t[F.tid] = __builtin_bit_cast(float, F.tid == 0 ? p0 : F.tid == 1 ? p1 : F.tid == 2 ? p2 : p3);
#pragma unroll
    for (int pass = 0; pass < 2; ++pass) { const int sl = 2 * pass + (F.tid >> 8); const int pm = sl == 0 ? p0 : sl == 1 ? p1 : sl == 2 ? p2 : p3;
        if (pm >= 0) t[16 + 256 * sl + (F.tid & 255)] = pg8::row_rstd(F.SSQ, pm * 256 + (F.tid & 255)); }
    __syncthreads();
    return t;
}

struct Args { cfp_t in[27]; float* out; unsigned char* ws; int ph_lo, ph_hi, li, pad; };
#define MKFRAME() do { int t_; asm volatile("v_mbcnt_lo_u32_b32 %0, -1, 0\n\tv_mbcnt_hi_u32_b32 %0, -1, %0\n\tv_lshl_add_u32 %0, %1, 6, %0" : "=&v"(t_) : "s"(wave_s));     \
    const __attribute__((address_space(4))) Args* ap_ = (const __attribute__((address_space(4))) Args*)__builtin_amdgcn_kernarg_segment_ptr(); asm volatile("" : "+s"(ap_)); unsigned char* ws_ = ap_->ws; \
    F.lds = (LAS unsigned char*)lds; F.MISC = (volatile LAS unsigned*)(F.lds + MISC_OFF); \
    F.tid = t_; F.lane = F.tid & 63; F.wave = __builtin_amdgcn_readfirstlane(F.tid >> 6); \
    F.G = gridDim.x; { const int bx = blockIdx.x; F.vcu = (F.G % 8 == 0) ? (bx % 8) * (F.G / 8) + bx / 8 : bx; } \
    F.ws = ws_; F.in = ap_->in; F.x = ap_->in[0]; F.out = ap_->out; F.ctl = (gu32*)(ws_ + WS_CTL); \
    F.XB = (bf16*)(ws_ + WS_XB); F.Y = (bf16*)(ws_ + WS_Y); F.XQ = (bf16*)(ws_ + WS_XQ); F.XO = (bf16*)(ws_ + WS_XO); F.BIG = (bf16*)(ws_ + WS_BIG); \
    F.MEMN = (bf16*)(ws_ + WS_MEMN); F.KVRAW = (bf16*)(ws_ + WS_KVRAW); F.KN = (bf16*)(ws_ + WS_KN); F.VT = (bf16*)(ws_ + WS_VT); F.WSP = (bf16*)(ws_ + WS_WSP); \
    F.LOGF = (float*)(ws_ + WS_LOGF); F.CUM = (float*)(ws_ + WS_CUM); F.SSQ = (float*)(ws_ + WS_SSQ); } while (0)
#define GRID_BAR() do { if (N_LAUNCHES == 1) { MKFRAME(); XcdBarrier b_; b_.bar = (unsigned*)(F.ctl + CW_BAR); b_.x = xb_xcc_id(); b_.st = F.MISC + 8; xcd_barrier(b_, F.tid); } } while (0)
#define IN(k) (lo <= (k) && (k) < hi)
#ifdef PROBE_PHASE
#define PROBE_REPS(k) (((k) == PROBE_PHASE) ? 2 : 1)
#else
#define PROBE_REPS(k) 1
#endif
#ifdef PROBE_XA_PHASE
#define PROBE_XA(k) (((k) == PROBE_XA_PHASE) ? 2 : 1)
#else
#define PROBE_XA(k) 1
#endif
#ifdef PROBE_EPI_PHASE
#define PROBE_EPI(k) (((k) == PROBE_EPI_PHASE) ? 2 : 1)
#else
#define PROBE_EPI(k) 1
#endif
#define BOTH(k) (IN(k) && IN((k) + 1))
template <int l> __device__ __forceinline__ void layer_phases(const int lo, const int hi, const int wave_s) {
    extern __shared__ __attribute__((aligned(16))) unsigned char lds[];
    Frame F; unsigned char* ws;
        const int pb = (l == 0) ? PH_IN0 : PH_IN1;
        if (IN(pb)) for (int rep_ = 0; rep_ < PROBE_REPS(pb); ++rep_) { MKFRAME(); ws = F.ws;
            if (l == 0) {
                if (blockIdx.x < 32) cumsum_seq(F, blockIdx.x);
                { pg8::Gemm g{F.XB, (const bf16*)(ws + WS_WIN0), T, N_IN0, D}; pg8::StaticOrder S; S.init(T, N_IN0, F.G, (int)blockIdx.x);
                  pg8::EpiIn0 E{F.BIG, N_IN0, rs_prepare(F, S), F.in[19], F.in[20], FOX_C2};
                  pg8::gemm_phase<pg8::EpiIn0, pg8::StaticOrder, PG8_ALIGN, PG8_SP2>(F.lds + RING_OFF, g, S, E, F.tid); }
            } else {
                pg8::Gemm g{F.XB, (const bf16*)(ws + WS_WIN1), T, N_IN1, D}; pg8::StaticOrder S; S.init(T, N_IN1, F.G, (int)blockIdx.x);
                pg8::EpiIn1 E{F.BIG, Z1P, rs_prepare(F, S)};
                pg8::gemm_phase<pg8::EpiIn1, pg8::StaticOrder, PG8_ALIGN, PG8_SP2>(F.lds + RING_OFF, g, S, E, F.tid);
            }
            if (BOTH(pb)) GRID_BAR();
        }
        if (IN(pb + 1)) for (int rep_ = 0; rep_ < PROBE_REPS(pb + 1); ++rep_) { MKFRAME(); ws = F.ws;
            if (l == 0) {
                int stage = 0;
                const int xme = (int)(xb_xcc_id() & 7u);
                for (;;) {
                    MKFRAME();
                    volatile LAS unsigned* mail = F.MISC + 16;
                    __syncthreads();
                    if (F.tid == 0) {
                        unsigned item = 0xffffffffu; int st = stage;
                        if (st == 0) { const unsigned q = __hip_atomic_fetch_add((unsigned*)(F.ctl + CW_Q0), 1u, __ATOMIC_RELAXED, __HIP_MEMORY_SCOPE_AGENT); st = 1; if (q < 32u) item = q; }
                        if (item == 0xffffffffu && st == 1) { const unsigned q = __hip_atomic_fetch_add((unsigned*)(F.ctl + CW_QX + 64 * xme), 1u, __ATOMIC_RELAXED, __HIP_MEMORY_SCOPE_AGENT);
                            if (q < 128u) item = 32u + 128u * (unsigned)xme + q; else st = 2; }
                        while (item == 0xffffffffu && st == 2) {
                            unsigned c[8];
#pragma unroll
                            for (int y = 0; y < 8; ++y) c[y] = __hip_atomic_load((unsigned*)(F.ctl + CW_QX + 64 * y), __ATOMIC_RELAXED, __HIP_MEMORY_SCOPE_AGENT);
                            int pick = -1;
#pragma unroll
                            for (int s_ = 7; s_ >= 1; --s_) { const int y = (xme + s_) & 7; unsigned cy = c[0];
#pragma unroll
                                for (int k = 1; k < 8; ++k) cy = (y == k) ? c[k] : cy;
                                if (cy < 128u) pick = y; }
                            if (pick < 0) { st = 3; break; }
                            const unsigned q = __hip_atomic_fetch_add((unsigned*)(F.ctl + CW_QX + 64 * pick), 1u, __ATOMIC_RELAXED, __HIP_MEMORY_SCOPE_AGENT);
                            if (q < 128u) item = 32u + 128u * (unsigned)pick + q;
                        }
                        if (item == 0xffffffffu && st == 3) { const unsigned q = __hip_atomic_fetch_add((unsigned*)(F.ctl + CW_G1), 1u, __ATOMIC_RELAXED, __HIP_MEMORY_SCOPE_AGENT); item = (q < 256u) ? 32u + 1024u + q : 0xfffffffeu; }
                        mail[0] = item; mail[1] = (unsigned)st; }
                    __syncthreads();
                    const int it = __builtin_amdgcn_readfirstlane((int)mail[0]); stage = __builtin_amdgcn_readfirstlane((int)mail[1]);
                    if (it < 0) break;
                    if (it < 32) {
                        const int l2 = it >> 4;
                        pg8::Gemm g{F.MEMN, lw(F, l2, L_WKV), MROWS, D, D}; pg8::OneUnit S; S.u.pm = (it >> 2) & 3; S.u.pn = it & 3;
                        pg8::EpiPlain E{F.KVRAW + (size_t)l2 * MROWS * D, D, nullptr};
                        pg8::gemm_phase<pg8::EpiPlain, pg8::OneUnit, PG8_ALIGN, PG8_SP2>(F.lds + RING_OFF, g, S, E, F.tid);
                    } else if (it < 32 + 1024) {
                        const int j = it - 32, y = j >> 7, idx = j & 127, b = y >> 1, hs = idx >> 5, qb = 31 - (idx & 31);
                        const int hh = (y & 1) ? (hs == 0 ? 6 : hs == 1 ? 5 : hs == 2 ? 1 : 0) : (hs == 0 ? 7 : hs == 1 ? 4 : hs == 2 ? 3 : 2);
                        float th;
                        { const float gm = fabsf(F.in[19][F.lane] * F.in[20][F.lane]); float mx = gm;
        #pragma unroll
                          for (int o = 1; o < 64; o <<= 1) mx = fmaxf(mx, __shfl_xor(mx, o));
                          th = 2.0f * (64.0f * FOX_C2 * mx * 1.02f) + 40.0f; }
                        attn_body::attn_unit<8>(b, hh, qb, (const attn_body::bf16*)(F.BIG + 1024), (const attn_body::bf16*)(F.BIG + 1536), (const attn_body::bf16*)(F.BIG + 2048), (attn_body::bf16*)(F.Y + 512), F.CUM, th, (char*)lds + RING_OFF, F.tid);
                    } else {
                        const int blk = it - 1056;
                        gmlp_item(F, blk);
                    }
                }
            } else {
                mix1_phase(F);
            }
            if (BOTH(pb + 1)) GRID_BAR();
        }
        if (IN(pb + 2)) for (int rep_ = 0; rep_ < PROBE_REPS(pb + 2); ++rep_) { MKFRAME(); ws = F.ws;
            if (l == 0 && blockIdx.x < 32) xa_kv_finalize(F, blockIdx.x);
            pg8::Gemm g{F.Y, (const bf16*)(ws + (l == 0 ? WS_WOUT0 : WS_WOUT1)), T, D, D}; pg8::StaticOrder S; S.init(T, D, F.G, (int)blockIdx.x);
            pg8::EpiRes E{nullptr, F.XB, nullptr, F.SSQ, D, 1.0f};
            pg8::gemm_phase<pg8::EpiRes, pg8::StaticOrder, PG8_ALIGN, PG8_SP2>(F.lds + RING_OFF, g, S, E, F.tid, PROBE_EPI(pb + 2));
            if (BOTH(pb + 2)) GRID_BAR();
        }
        if (IN(pb + 3)) for (int rep_ = 0; rep_ < PROBE_REPS(pb + 3); ++rep_) { MKFRAME(); ws = F.ws;
            pg8::Gemm g{F.XB, lw(F, l, L_WQ), T, XAW, D}; pg8::StaticOrder S; S.init(T, XAW, F.G, (int)blockIdx.x);
            pg8::EpiPlain E{F.XQ, XAW, rs_prepare(F, S)};
            pg8::gemm_phase<pg8::EpiPlain, pg8::StaticOrder, PG8_ALIGN, PG8_SP2>(F.lds + RING_OFF, g, S, E, F.tid);
            VM_WAIT(); __syncthreads();
            __builtin_amdgcn_fence(__ATOMIC_ACQUIRE, "agent"); VM_WAIT(); __syncthreads();
            pg8::Unit u;
            for (int i = 0; S.next(i, u); ++i) for (int xr_ = 0; xr_ < PROBE_XA(pb + 3); ++xr_) xa_attn_unit(F, l, u.pm, u.pn);
            if (BOTH(pb + 3)) GRID_BAR();
        }
        if (IN(pb + 4)) for (int rep_ = 0; rep_ < PROBE_REPS(pb + 4); ++rep_) { MKFRAME(); ws = F.ws;
            constexpr bool f8 = MK_F8XO != 0;
            pg8::Gemm g{F.XO, lw(F, l, L_WO), T, D, f8 ? XAW / 2 : XAW}; pg8::StaticOrder S; S.init(T, D, F.G, (int)blockIdx.x);
            pg8::EpiResT<f8> E{nullptr, F.XB, nullptr, F.SSQ, D, f8 ? 1.0f / (F8_XOASCALE * F8_XOWSCALE) : 1.0f};
            pg8::gemm_phase<pg8::EpiResT<f8>, pg8::StaticOrder, PG8_ALIGN, PG8_SP2>(F.lds + RING_OFF, g, S, E, F.tid);
            if (BOTH(pb + 4)) GRID_BAR();
        }
        if (IN(pb + 5)) for (int rep_ = 0; rep_ < PROBE_REPS(pb + 5); ++rep_) { MKFRAME(); ws = F.ws;
            pg8::Gemm g{F.XB, lw(F, l, L_WGU), T, 2 * DFF, D}; pg8::StaticOrder S; S.init(T, 2 * DFF, F.G, (int)blockIdx.x);
            constexpr bool f8 = (MK_F8DN >> l) & 1;
            pg8::EpiSwigluT<f8> E{F.BIG, DFF, rs_prepare(F, S), F8_HSCALE};
            pg8::gemm_phase<pg8::EpiSwigluT<f8>, pg8::StaticOrder, PG8_ALIGN, PG8_SP2>(F.lds + RING_OFF, g, S, E, F.tid, PROBE_EPI(pb + 5));
            if (BOTH(pb + 5)) GRID_BAR();
        }
        if (IN(pb + 6)) for (int rep_ = 0; rep_ < PROBE_REPS(pb + 6); ++rep_) { MKFRAME(); ws = F.ws;
            constexpr bool f8 = (MK_F8DN >> l) & 1;
            pg8::Gemm g{F.BIG, lw(F, l, L_WD), T, D, f8 ? DFF / 2 : DFF}; pg8::StaticOrder S; S.init(T, D, F.G, (int)blockIdx.x);
            pg8::EpiResT<f8> E{nullptr, F.XB, l == 0 ? nullptr : F.out, F.SSQ, D, 1.0f / (F8_HSCALE * F8_WSCALE)};
            pg8::gemm_phase<pg8::EpiResT<f8>, pg8::StaticOrder, PG8_ALIGN, PG8_SP2>(F.lds + RING_OFF, g, S, E, F.tid);
            if (BOTH(pb + 6)) GRID_BAR();
        }
    }
__global__ void __launch_bounds__(NWAVES * 64, 2) mk_fwd(Args args) {
    extern __shared__ __attribute__((aligned(16))) unsigned char lds[];
    int wave_s = __builtin_amdgcn_readfirstlane((int)threadIdx.x >> 6); asm volatile("" : "+s"(wave_s));
    Frame F;
    MKFRAME();
    for (int u = F.tid; u < (LDS_BYTES - LDSCTL_OFF) / 4; u += NWAVES * 64) ((LAS unsigned*)(F.lds + LDSCTL_OFF))[u] = 0u;
    __syncthreads();
    if (N_LAUNCHES == 1) (void)xcd_barrier_post((unsigned*)(F.ctl + CW_BAR), F.MISC + 8, F.tid);
    const int lo = args.ph_lo, hi = args.ph_hi;
    if (IN(PH_PRO)) for (int rep_ = 0; rep_ < PROBE_REPS(PH_PRO); ++rep_) { MKFRAME(); p0_prologue(F); if (BOTH(PH_PRO)) GRID_BAR(); }
    layer_phases<0>(lo, hi, wave_s);
    layer_phases<1>(lo, hi, wave_s);
#ifdef PROBE_BARS
    for (int pb_ = 0; pb_ < PROBE_BARS; ++pb_) { MKFRAME(); GRID_BAR(); }
#endif
}
#undef MKFRAME
#undef IN
#undef BOTH
#undef GRID_BAR

extern "C" void kernel_launch(void* const* d_in, const int* in_sizes, int n_in, void* d_out, int out_size, void* d_ws, size_t ws_size, hipStream_t stream) {
    static int grid = 0;
    if (grid == 0) {
        if (n_in != 27 || in_sizes[0] != T * D || out_size != T * D || ws_size < WS_END) { fprintf(stderr, "kernel_launch: built for 27 inputs, x and out of %d floats, >= %zu bytes of workspace; got n_in %d, in0 %d, out %d, ws %zu; nothing launched\n", T * D, (size_t)WS_END, n_in, n_in > 0 ? in_sizes[0] : -1, out_size, ws_size); grid = -1; return; }
        int dev = 0, cus = 0, per_cu = 0;
        if (hipGetDevice(&dev) != hipSuccess || hipDeviceGetAttribute(&cus, hipDeviceAttributeMultiprocessorCount, dev) != hipSuccess) { fprintf(stderr, "kernel_launch: hipGetDevice / hipDeviceGetAttribute failed; nothing launched\n"); grid = -1; return; }
        if (hipFuncSetAttribute((const void*)mk_fwd, hipFuncAttributeMaxDynamicSharedMemorySize, LDS_BYTES) != hipSuccess) { fprintf(stderr, "kernel_launch: hipFuncSetAttribute failed\n"); grid = -1; return; }
        if (hipOccupancyMaxActiveBlocksPerMultiprocessor(&per_cu, (const void*)mk_fwd, NWAVES * 64, LDS_BYTES) != hipSuccess || per_cu < 1)
            fprintf(stderr, "kernel_launch: note: the occupancy query reports %d workgroups per CU\n", per_cu);
        (void)hipGetLastError();
        grid = cus;
        if (grid != 256) fprintf(stderr, "kernel_launch: %d CUs; the attention schedule is built for 256\n", grid);
    }
    if (grid < 0) return;
    if (hipMemsetAsync((char*)d_ws + WS_CTL, 0, CTL_ZERO_BYTES, stream) != hipSuccess) { fprintf(stderr, "kernel_launch: hipMemsetAsync of the control words failed; nothing launched\n"); return; }
    Args a{};
    for (int i = 0; i < 27; ++i) a.in[i] = (const float*)d_in[i];
    a.out = (float*)d_out; a.ws = (unsigned char*)d_ws;
    for (int li = 0; li < N_LAUNCHES; ++li) {
        a.ph_lo = (N_LAUNCHES == 1) ? 0 : li; a.ph_hi = (N_LAUNCHES == 1) ? N_PHASES : li + 1; a.li = li;
        hipLaunchKernelGGL(mk_fwd, dim3(grid), dim3(NWAVES * 64), LDS_BYTES, stream, a);
        const hipError_t le = hipPeekAtLastError();
        if (le != hipSuccess) { fprintf(stderr, "kernel_launch: launch %d failed: %s\n", li, hipGetErrorName(le)); break; }
    }
}
```
